# Optimizing an MI355X kernel written in HIP

```python
import jax, jax.numpy as jnp
from jax import lax
import numpy as np

D_MODEL = 2048
BATCH = 1
SEQ = 8192
DEPTH = 1

N_HEADS = 8
HEAD_DIM = 128
KV_LATENT = 256
IDX_HEADS = 16
IDX_DIM = 64
TOPK_MAX = 256
Q_BLOCK = 128
ATTN_WIDTH = N_HEADS * HEAD_DIM
GMLP_GROUPS = 8
GMLP_GROUP_DIM = 128
GMLP_WIDTH = GMLP_GROUPS * GMLP_GROUP_DIM
CHUNK = 128
SPLIT_SIZES = (
    ATTN_WIDTH,
    KV_LATENT,
    IDX_HEADS * IDX_DIM,
    IDX_DIM,
    IDX_HEADS,
    2 * GMLP_WIDTH,
    2 * D_MODEL,
)
IN_COLS = int(sum(SPLIT_SIZES))
SPLIT_POINTS = tuple(int(v) for v in np.cumsum(SPLIT_SIZES)[:-1])
N_GROUPS = 8
EXPERTS_PER_GROUP = 8
N_EXPERTS = N_GROUPS * EXPERTS_PER_GROUP
TOPK_IN_GROUP = 2
EXPERT_FF = D_MODEL // 4
EPS = 1e-6

kernel_name = "hybrid_dsa_gmlp_hiermoe_block"


def rms_norm(x, g):
    xf = x.astype(jnp.float32)
    y = xf * lax.rsqrt(jnp.mean(xf * xf, axis=-1, keepdims=True) + EPS)
    return (y * g.astype(jnp.float32)).astype(x.dtype)


def layer_norm(x, g, b):
    xf = x.astype(jnp.float32)
    mu = jnp.mean(xf, axis=-1, keepdims=True)
    var = jnp.mean(jnp.square(xf - mu), axis=-1, keepdims=True)
    y = (xf - mu) * lax.rsqrt(var + EPS)
    return (y * g.astype(jnp.float32) + b.astype(jnp.float32)).astype(x.dtype)


def sparse_mla_attention(q, c_kv, q_idx, k_idx, w_idx, w_uk, w_uv):
    B, S = q.shape[0], q.shape[1]
    topk = min(TOPK_MAX, S // 4)
    nb = S // Q_BLOCK
    scale = HEAD_DIM ** -0.5
    q_abs = jnp.einsum('bthd,hdc->bthc', q, w_uk)

    def to_blocks(a):
        return a.reshape((B, nb, Q_BLOCK) + a.shape[2:]).swapaxes(0, 1)

    s_pos = jnp.arange(S)

    def block(args):
        i, qa, qi, wi = args
        t_pos = i * Q_BLOCK + jnp.arange(Q_BLOCK)
        dots = jnp.einsum('bthd,bsd->bths', qi, k_idx).astype(jnp.float32)
        score = jnp.einsum('bth,bths->bts', wi.astype(jnp.float32), jax.nn.relu(dots))
        causal = s_pos[None, :] <= t_pos[:, None]
        score = jnp.where(causal[None], score, -jnp.inf)
        _, idx = lax.top_k(score, topk)
        valid = idx <= t_pos[None, :, None]
        c_sel = jax.vmap(lambda c, ix: c[ix])(c_kv, idx)
        logits = jnp.einsum('bthc,btkc->bthk', qa, c_sel).astype(jnp.float32) * scale
        logits = jnp.where(valid[:, :, None, :], logits, -jnp.inf)
        p = jax.nn.softmax(logits, axis=-1).astype(c_sel.dtype)
        return jnp.einsum('bthk,btkc->bthc', p, c_sel)

    o = lax.map(block, (jnp.arange(nb), to_blocks(q_abs), to_blocks(q_idx), to_blocks(w_idx)))
    o = o.swapaxes(0, 1).reshape(B, S, N_HEADS, KV_LATENT)
    o = jnp.einsum('bthc,hcd->bthd', o, w_uv)
    return o.reshape(B, S, ATTN_WIDTH)


def chunked_spatial_gating(uv, w_s, b_s, ln_g, ln_b):
    B, S = uv.shape[0], uv.shape[1]
    z = jax.nn.gelu(uv)
    u, v = jnp.split(z, 2, axis=-1)
    v = layer_norm(v, ln_g, ln_b)
    v = v.reshape(B, S // CHUNK, CHUNK, GMLP_GROUPS, GMLP_GROUP_DIM)
    causal = jnp.tril(jnp.ones((CHUNK, CHUNK), dtype=w_s.dtype))
    y = jnp.einsum('gts,bnsgc->bntgc', w_s * causal[None], v) + b_s.T[None, None, :, :, None]
    return u * y.reshape(B, S, GMLP_WIDTH)


def hybrid_mixer(h, w_in, kv_norm_g, w_uk, w_uv, gmlp_ws, gmlp_bs, ln_v_g, ln_v_b,
                 w_br_attn, w_br_gmlp, w_out):
    B, S, _ = h.shape
    proj = jnp.einsum('bsd,de->bse', h, w_in)
    q, c_kv, q_idx, k_idx, w_idx, uv, gates = jnp.split(proj, SPLIT_POINTS, axis=-1)
    q = q.reshape(B, S, N_HEADS, HEAD_DIM)
    c_kv = rms_norm(c_kv, kv_norm_g)
    q_idx = q_idx.reshape(B, S, IDX_HEADS, IDX_DIM) * (IDX_DIM ** -0.5)
    w_idx = w_idx * (IDX_HEADS ** -0.5)
    a = sparse_mla_attention(q, c_kv, q_idx, k_idx, w_idx, w_uk, w_uv)
    m = chunked_spatial_gating(uv, gmlp_ws, gmlp_bs, ln_v_g, ln_v_b)
    g_a, g_b = jnp.split(gates, 2, axis=-1)
    merged = (jax.nn.sigmoid(g_a) * jnp.einsum('bsa,ad->bsd', a, w_br_attn)
              + jax.nn.sigmoid(g_b) * jnp.einsum('bsm,md->bsd', m, w_br_gmlp))
    return jnp.einsum('bsd,de->bse', merged, w_out)


def hierarchical_moe(h, w_group, b_group, w_router, b_router, w_e_gate, w_e_up, w_e_down):
    B, S, D = h.shape
    xt = h.reshape(B * S, D)
    n_tok = xt.shape[0]
    g_logits = jnp.einsum('nd,dg->ng', xt, w_group).astype(jnp.float32) + b_group.astype(jnp.float32)
    g_prob = jax.nn.softmax(g_logits, axis=-1)
    g_val, g_idx = lax.top_k(g_prob, 1)
    g_onehot = jax.nn.one_hot(g_idx[:, 0], N_GROUPS, dtype=jnp.float32)
    e_logits = (jnp.einsum('nd,de->ne', xt, w_router).astype(jnp.float32)
                + b_router.astype(jnp.float32)).reshape(n_tok, N_GROUPS, EXPERTS_PER_GROUP)
    sel = jnp.einsum('ng,nge->ne', g_onehot, e_logits)
    top_v, top_i = lax.top_k(sel, TOPK_IN_GROUP)
    q = jax.nn.softmax(top_v, axis=-1)
    within = jnp.sum(jax.nn.one_hot(top_i, EXPERTS_PER_GROUP, dtype=jnp.float32) * q[..., None], axis=1)
    combine = (g_onehot[:, :, None] * g_val[:, :, None] * within[:, None, :])
    combine = combine.reshape(n_tok, N_EXPERTS).astype(h.dtype)
    out = jnp.zeros_like(xt)
    for g in range(N_GROUPS):
        sl = slice(g * EXPERTS_PER_GROUP, (g + 1) * EXPERTS_PER_GROUP)
        hid = (jax.nn.silu(jnp.einsum('nd,edf->nef', xt, w_e_gate[sl]))
               * jnp.einsum('nd,edf->nef', xt, w_e_up[sl]) * combine[:, sl, None])
        out = out + jnp.einsum('nef,efd->nd', hid, w_e_down[sl])
    return out.reshape(B, S, D)


def setup_inputs(seed: int = 0) -> dict:
    key = jax.random.key(seed)
    ks = jax.random.split(key, 24)
    f32 = jnp.float32

    def nrm(k, shape, scale):
        return jax.random.normal(k, shape, f32) * scale

    return {
        "x": nrm(ks[0], (BATCH, SEQ, D_MODEL), 1.0),
        "norm1_g": 1.0 + nrm(ks[1], (D_MODEL,), 0.02),
        "w_in": nrm(ks[2], (D_MODEL, IN_COLS), D_MODEL ** -0.5),
        "kv_norm_g": 1.0 + nrm(ks[3], (KV_LATENT,), 0.02),
        "w_uk": nrm(ks[4], (N_HEADS, HEAD_DIM, KV_LATENT), KV_LATENT ** -0.5),
        "w_uv": nrm(ks[5], (N_HEADS, KV_LATENT, HEAD_DIM), KV_LATENT ** -0.5),
        "gmlp_ws": nrm(ks[6], (GMLP_GROUPS, CHUNK, CHUNK), CHUNK ** -0.5),
        "gmlp_bs": 1.0 + nrm(ks[7], (GMLP_GROUPS, CHUNK), 0.1),
        "ln_v_g": 1.0 + nrm(ks[8], (GMLP_WIDTH,), 0.02),
        "ln_v_b": nrm(ks[9], (GMLP_WIDTH,), 0.02),
        "w_br_attn": nrm(ks[10], (ATTN_WIDTH, D_MODEL), ATTN_WIDTH ** -0.5),
        "w_br_gmlp": nrm(ks[11], (GMLP_WIDTH, D_MODEL), GMLP_WIDTH ** -0.5),
        "w_out": nrm(ks[12], (D_MODEL, D_MODEL), D_MODEL ** -0.5),
        "norm2_g": 1.0 + nrm(ks[13], (D_MODEL,), 0.02),
        "w_group": nrm(ks[14], (D_MODEL, N_GROUPS), D_MODEL ** -0.5),
        "b_group": nrm(ks[15], (N_GROUPS,), 0.01),
        "w_router": nrm(ks[16], (D_MODEL, N_EXPERTS), D_MODEL ** -0.5),
        "b_router": nrm(ks[17], (N_EXPERTS,), 0.01),
        "w_e_gate": nrm(ks[18], (N_EXPERTS, D_MODEL, EXPERT_FF), D_MODEL ** -0.5),
        "w_e_up": nrm(ks[19], (N_EXPERTS, D_MODEL, EXPERT_FF), D_MODEL ** -0.5),
        "w_e_down": nrm(ks[20], (N_EXPERTS, EXPERT_FF, D_MODEL), EXPERT_FF ** -0.5),
        "norm_f_g": 1.0 + nrm(ks[21], (D_MODEL,), 0.02),
    }


def reference(x, norm1_g, w_in, kv_norm_g, w_uk, w_uv, gmlp_ws, gmlp_bs, ln_v_g, ln_v_b,
              w_br_attn, w_br_gmlp, w_out, norm2_g, w_group, b_group, w_router, b_router,
              w_e_gate, w_e_up, w_e_down, norm_f_g):
    h = x
    for _ in range(DEPTH):
        h = h + hybrid_mixer(rms_norm(h, norm1_g), w_in, kv_norm_g, w_uk, w_uv, gmlp_ws, gmlp_bs,
                             ln_v_g, ln_v_b, w_br_attn, w_br_gmlp, w_out)
        h = h + hierarchical_moe(rms_norm(h, norm2_g), w_group, b_group, w_router, b_router,
                                 w_e_gate, w_e_up, w_e_down)
    return rms_norm(h, norm_f_g)
```

```cpp
#include <hip/hip_runtime.h>
#include <cstdio>
#include <cstdint>
namespace pg8 {
#define PG8_LAS __attribute__((address_space(3)))
typedef unsigned short bf16_t;
typedef short bf16x8 __attribute__((ext_vector_type(8)));
typedef float f32x4 __attribute__((ext_vector_type(4)));
typedef unsigned u32x4 __attribute__((ext_vector_type(4)));
constexpr int BM = 256, BK = 64, HALF = 128, HTB = HALF * BK * 2  , STAGE_BYTES = 8 * HTB, NXCD = 8, WGM = 8;

__host__ __device__ __forceinline__ int lds_byte(int r, int c) { const int st = (r >> 4) * 2 + (c >> 5), rr = r & 15, cc = c & 31, ob = rr * 64 + cc * 2; return st * 1024 + (ob ^ (((ob >> 9) & 1) << 5)); }
__host__ __device__ __forceinline__ void stage_rc(int b, int& R, int& C) { const int st = b / 1024, sb = b % 1024, swz = sb ^ (((sb >> 9) & 1) << 5); R = (st >> 1) * 16 + swz / 64; C = (st & 1) * 32 + (swz % 64) / 2; }
__host__ __device__ __forceinline__ int perm32(int rho) { const int n = rho >> 4, i = rho & 15; return 8 * (i >> 2) + 4 * n + (i & 3); }

struct Unit { int pm, pn; };
struct Gemm { const bf16_t* A; const bf16_t* Bt; int M, N, K; };

struct StaticOrder {
    int nM, nN, nwg, G, c;
    __host__ __device__ void init(int M, int N, int G_, int c_) { nM = M / BM; nN = N / BM; nwg = nM * nN; G = G_; c = c_; }
    __host__ __device__ bool next(int i, Unit& u) const {
        const long L = (long)i * G + c; if (L >= nwg) return false;
        int wgid = (int)L; { const int q = nwg / NXCD, r = nwg % NXCD, xcd = wgid % NXCD, off = wgid / NXCD; wgid = (xcd < r ? xcd * (q + 1) : r * (q + 1) + (xcd - r) * q) + off; }
        const int nig = WGM * nN, gid = wgid / nig, fm = gid * WGM, gsz = (nM - fm) < WGM ? (nM - fm) : WGM;
        u.pm = fm + ((wgid % nig) % gsz); u.pn = (wgid % nig) / gsz; return true;
    }
    __device__ __forceinline__ void a_ready(const Unit&) const {}
    __device__ __forceinline__ void done(const Unit&) const {}
};

template <class Epi, class Sched, bool ALIGN_EPI = false, bool SP2 = false>
__device__ __forceinline__ void gemm_phase(PG8_LAS unsigned char* lds, const Gemm g, const Sched& S, const Epi& E) {
    const int tid = threadIdx.x, wid = __builtin_amdgcn_readfirstlane(tid >> 6), lane = tid & 63, wr = wid >> 2, wc = wid & 3, fr = lane & 15, fq = lane >> 4;
    const int K = g.K, nt = K / BK;
    unsigned voffA[2], voffB[2];
#pragma unroll
    for (int i = 0; i < 2; ++i) { int R, C; stage_rc(tid * 16 + i * 8192, R, C); const int Rb = Epi::PERM ? ((R & ~31) + perm32(R & 31)) : R;
        voffA[i] = (unsigned)(R * K + C) * 2u; voffB[i] = (unsigned)(Rb * K + C) * 2u; }
    const size_t kstep = (size_t)(BK * 2);
    const size_t hstep = (size_t)HALF * K * 2;
    const size_t tstep = 2 * hstep;
    const unsigned ldsw = (unsigned)wid * 1024u;
    const int aoff = lds_byte(wr * 64 + fr, fq * 8), boff = lds_byte(wc * 32 + fr, fq * 8);
#define PG8_SA(b, h) (((b) * 2 + (h)) * HTB)
#define PG8_SB(b, h) ((4 + (b) * 2 + (h)) * HTB)
#define PG8_STAGE(bufoff, gbase, voff) do { _Pragma("unroll") for (int _i = 0; _i < 2; ++_i) \
        __builtin_amdgcn_global_load_lds((const unsigned*)((const char*)(gbase) + (voff)[_i]), (PG8_LAS unsigned*)(lds + (bufoff) + ldsw + _i * 8192), 16, 0, 0); } while (0)
#define PG8_LDA(dst, b, h) do { _Pragma("unroll") for (int m = 0; m < 4; ++m) _Pragma("unroll") for (int k = 0; k < 2; ++k) dst[m][k] = *(const PG8_LAS bf16x8*)(lds + PG8_SA(b, h) + aoff + m * 2048 + k * 1024); } while (0)
#define PG8_LDB(dst, b, h) do { _Pragma("unroll") for (int n = 0; n < 2; ++n) _Pragma("unroll") for (int k = 0; k < 2; ++k) dst[n][k] = *(const PG8_LAS bf16x8*)(lds + PG8_SB(b, h) + boff + n * 2048 + k * 1024); } while (0)
#define PG8_MMA(ai, bj, At, Bt) do { __builtin_amdgcn_s_setprio(1); _Pragma("unroll") for (int m = 0; m < 4; ++m) _Pragma("unroll") for (int n = 0; n < 2; ++n) _Pragma("unroll") for (int k = 0; k < 2; ++k) \
        acc[ai][bj][m][n] = __builtin_amdgcn_mfma_f32_16x16x32_bf16(Bt[n][k], At[m][k], acc[ai][bj][m][n], 0, 0, 0); __builtin_amdgcn_s_setprio(0); } while (0)
#define PG8_WAIT_V(n) asm volatile("s_waitcnt vmcnt(" #n ")" ::: "memory")
#define PG8_WAIT_L(n) asm volatile("s_waitcnt lgkmcnt(" #n ")" ::: "memory")
#define PG8_BAR __builtin_amdgcn_s_barrier()
#define PG8_SCHED __builtin_amdgcn_sched_barrier(0)
    Unit cur, nxt; int ui = 0;
    if (!S.next(0, cur)) return;
    f32x4 acc[2][2][4][2];
#pragma unroll
    for (int a = 0; a < 2; ++a)
#pragma unroll
        for (int b = 0; b < 2; ++b)
#pragma unroll
            for (int m = 0; m < 4; ++m)
#pragma unroll
                for (int n = 0; n < 2; ++n) acc[a][b][m][n] = (f32x4){0.f, 0.f, 0.f, 0.f};
    bf16x8 At[4][2], B0[2][2], B1[2][2];
    const char* cA = (const char*)g.A + (size_t)cur.pm * tstep; const char* cB = (const char*)g.Bt + (size_t)cur.pn * tstep;
    S.a_ready(cur);
    if constexpr (SP2) {
        PG8_STAGE(PG8_SB(0, 0), cB, voffB); PG8_STAGE(PG8_SB(0, 1), cB + hstep, voffB); PG8_STAGE(PG8_SA(0, 0), cA, voffA); PG8_STAGE(PG8_SA(0, 1), cA + hstep, voffA);
        if (wr == 1) PG8_BAR;
        PG8_WAIT_V(2); PG8_BAR;
        PG8_STAGE(PG8_SB(1, 0), cB + kstep, voffB); PG8_STAGE(PG8_SA(1, 0), cA + kstep, voffA); PG8_STAGE(PG8_SB(1, 1), cB + hstep + kstep, voffB);
        PG8_WAIT_V(6); PG8_BAR;
    } else {
        PG8_STAGE(PG8_SB(0, 0), cB, voffB); PG8_STAGE(PG8_SA(0, 0), cA, voffA); PG8_STAGE(PG8_SB(0, 1), cB + hstep, voffB); PG8_STAGE(PG8_SA(0, 1), cA + hstep, voffA);
        if (wr == 1) PG8_BAR;
        PG8_WAIT_V(4); PG8_BAR;
        PG8_STAGE(PG8_SB(1, 0), cB + kstep, voffB); PG8_STAGE(PG8_SA(1, 0), cA + kstep, voffA); PG8_STAGE(PG8_SB(1, 1), cB + hstep + kstep, voffB);
        PG8_WAIT_V(6); PG8_BAR;
    }
    for (;;) {
        const bool has_next = S.next(ui + 1, nxt);
        const char* nA = has_next ? (const char*)g.A + (size_t)nxt.pm * tstep : cA; const char* nB = has_next ? (const char*)g.Bt + (size_t)nxt.pn * tstep : cB;
        for (int t = 0; t < nt; t += 2) {
            const bool last = (t == nt - 2);
            const char* a1 = cA + (size_t)(t + 1) * kstep;
            const char* a2 = last ? nA : cA + (size_t)(t + 2) * kstep; const char* b2 = last ? nB : cB + (size_t)(t + 2) * kstep;
            const char* a3 = a2 + kstep; const char* b3 = b2 + kstep;
            if (last && has_next) S.a_ready(nxt);
            if constexpr (SP2) {
            PG8_LDB(B0, 0, 0); PG8_LDB(B1, 0, 1); PG8_SCHED; PG8_LDA(At, 0, 0); PG8_STAGE(PG8_SA(1, 1), a1 + hstep, voffA);
            PG8_WAIT_V(8); PG8_WAIT_L(0); PG8_BAR; PG8_MMA(0, 0, At, B0); PG8_MMA(0, 1, At, B1); PG8_BAR; PG8_SCHED;
            PG8_LDA(At, 0, 1); PG8_STAGE(PG8_SB(0, 0), b2, voffB); PG8_STAGE(PG8_SB(0, 1), b2 + hstep, voffB); PG8_STAGE(PG8_SA(0, 0), a2, voffA);
            PG8_WAIT_V(8); PG8_WAIT_L(0); PG8_BAR; PG8_MMA(1, 0, At, B0); PG8_MMA(1, 1, At, B1); PG8_BAR; PG8_SCHED;
            PG8_LDB(B0, 1, 0); PG8_LDB(B1, 1, 1); PG8_SCHED; PG8_LDA(At, 1, 0); PG8_STAGE(PG8_SA(0, 1), a2 + hstep, voffA);
            PG8_WAIT_V(8); PG8_WAIT_L(0); PG8_BAR; PG8_MMA(0, 0, At, B0); PG8_MMA(0, 1, At, B1); PG8_BAR; PG8_SCHED;
            PG8_LDA(At, 1, 1); PG8_STAGE(PG8_SB(1, 0), b3, voffB); PG8_STAGE(PG8_SB(1, 1), b3 + hstep, voffB); PG8_STAGE(PG8_SA(1, 0), a3, voffA);
            PG8_WAIT_V(8); PG8_WAIT_L(0); PG8_BAR; PG8_MMA(1, 0, At, B0); PG8_MMA(1, 1, At, B1); PG8_BAR; PG8_SCHED;
            } else {
            PG8_LDB(B0, 0, 0); PG8_SCHED; PG8_LDA(At, 0, 0); PG8_STAGE(PG8_SA(1, 1), a1 + hstep, voffA);
            PG8_WAIT_L(8); PG8_BAR; PG8_WAIT_L(0); PG8_MMA(0, 0, At, B0); PG8_BAR; PG8_SCHED;
            PG8_LDB(B1, 0, 1); PG8_STAGE(PG8_SB(0, 0), b2, voffB);
            PG8_BAR; PG8_WAIT_L(0); PG8_MMA(0, 1, At, B1); PG8_BAR;
            PG8_LDA(At, 0, 1); PG8_STAGE(PG8_SA(0, 0), a2, voffA);
            PG8_BAR; PG8_WAIT_L(0); PG8_MMA(1, 0, At, B0); PG8_BAR; PG8_SCHED;
            PG8_STAGE(PG8_SB(0, 1), b2 + hstep, voffB);
            PG8_WAIT_V(6); PG8_BAR; PG8_MMA(1, 1, At, B1); PG8_BAR;
            PG8_LDB(B0, 1, 0); PG8_SCHED; PG8_LDA(At, 1, 0); PG8_STAGE(PG8_SA(0, 1), a2 + hstep, voffA);
            PG8_WAIT_L(8); PG8_BAR; PG8_WAIT_L(0); PG8_MMA(0, 0, At, B0); PG8_BAR; PG8_SCHED;
            PG8_LDB(B1, 1, 1); PG8_STAGE(PG8_SB(1, 0), b3, voffB);
            PG8_BAR; PG8_WAIT_L(0); PG8_MMA(0, 1, At, B1); PG8_BAR;
            PG8_LDA(At, 1, 1); PG8_STAGE(PG8_SA(1, 0), a3, voffA);
            PG8_BAR; PG8_WAIT_L(0); PG8_MMA(1, 0, At, B0); PG8_BAR; PG8_SCHED;
            PG8_STAGE(PG8_SB(1, 1), b3 + hstep, voffB);
            PG8_WAIT_V(6); PG8_BAR; PG8_MMA(1, 1, At, B1); PG8_BAR;
            }
        }
        if constexpr (ALIGN_EPI) { if (wr == 0) PG8_BAR; }
        if constexpr (!Epi::AFTER_DRAIN) { E(acc, cur, wr, wc, fr, fq); S.done(cur); }
        if (!has_next) break;
#pragma unroll
        for (int a = 0; a < 2; ++a)
#pragma unroll
            for (int b = 0; b < 2; ++b)
#pragma unroll
                for (int m = 0; m < 4; ++m)
#pragma unroll
                    for (int n = 0; n < 2; ++n) acc[a][b][m][n] = (f32x4){0.f, 0.f, 0.f, 0.f};
        cur = nxt; cA = nA; cB = nB; ++ui;
        if constexpr (ALIGN_EPI) { if (wr == 1) PG8_BAR; }
    }
    PG8_WAIT_V(0);
    if constexpr (!ALIGN_EPI) { if (wr == 0) PG8_BAR; }
    PG8_BAR;
    if constexpr (Epi::AFTER_DRAIN) { E.fused(acc, cur, wr, wc, fr, fq, lds, wid, lane); S.done(cur); }
#undef PG8_SA
#undef PG8_SB
#undef PG8_STAGE
#undef PG8_LDA
#undef PG8_LDB
#undef PG8_MMA
#undef PG8_WAIT_V
#undef PG8_WAIT_L
#undef PG8_BAR
#undef PG8_SCHED
}
}
#define LAS __attribute__((address_space(3)))
#define XB_TMO      128
#define XB_XCNT(j)  (256  + 64 * (j))
#define XB_XSUB(j)  (1280 + 64 * (j))
#define XB_XGEN(j)  (2304 + 64 * (j))
#define XB_TOP      3328
#define XB_TOPGEN   3392
#define XCD_BAR_WORDS 3456
#define XB_SPIN_CAP (1u << 22)

__device__ __forceinline__ unsigned xb_ld(unsigned* p)              { return __hip_atomic_load(p, __ATOMIC_RELAXED, __HIP_MEMORY_SCOPE_AGENT); }
__device__ __forceinline__ unsigned xb_add(unsigned* p, unsigned v) { return __hip_atomic_fetch_add(p, v, __ATOMIC_RELAXED, __HIP_MEMORY_SCOPE_AGENT); }
__device__ __forceinline__ unsigned xb_xcc_id() { return (unsigned)__builtin_amdgcn_s_getreg((3 << 11) | 20) & 0xFu; }
#define XB_SPIN(cond, bar) do { unsigned _sp = 0; while (cond) { __builtin_amdgcn_s_sleep(1); \
    if ((++_sp & 255u) == 0u) { if (xb_ld(&(bar)[XB_TMO])) break; if (_sp > XB_SPIN_CAP) { atomicAdd(&(bar)[XB_TMO], 1u); break; } } } } while (0)

struct XcdBarrier {
    unsigned* bar; unsigned x;
    volatile LAS unsigned* st;
};

__device__ __forceinline__ XcdBarrier xcd_barrier_post(unsigned* bar, volatile LAS unsigned* st) {
    XcdBarrier b; b.bar = bar; b.x = xb_xcc_id(); b.st = st;
    if (threadIdx.x == 0) (void)xb_add(&bar[XB_XCNT(b.x)], 1u);
    return b;
}
__device__ __forceinline__ void xcd_barrier_complete(unsigned* bar, unsigned x, unsigned& nloc, unsigned& nx) {
    const unsigned G = gridDim.x * gridDim.y * gridDim.z;
    unsigned sum, cnt, mine, sp = 0u;
    for (;;) {
        sum = 0u; cnt = 0u; mine = 0u;
#pragma unroll
        for (unsigned j = 0; j < 16; ++j) { const unsigned c = xb_ld(&bar[XB_XCNT(j)]); sum += c; cnt += (c > 0u) ? 1u : 0u; mine = (j == x) ? c : mine; }
        if (sum == G) break;
        __builtin_amdgcn_s_sleep(1);
        if ((++sp & 255u) == 0u) { if (xb_ld(&bar[XB_TMO])) break; if (sp > XB_SPIN_CAP) { atomicAdd(&bar[XB_TMO], 1u); break; } }
    }
    nloc = mine > 0u ? mine : 1u; nx = cnt > 0u ? cnt : 1u;
}

__device__ __forceinline__ void xcd_barrier(const XcdBarrier& b) {
    asm volatile("s_waitcnt vmcnt(0)" ::: "memory");
    __syncthreads();
    if (threadIdx.x == 0) {
        unsigned* bar = b.bar;
        __builtin_amdgcn_s_waitcnt(0);
        unsigned nloc = b.st[0], nx = b.st[1];
        if (nloc == 0u) { xcd_barrier_complete(bar, b.x, nloc, nx); b.st[0] = nloc; b.st[1] = nx; }
        const unsigned old = xb_add(&bar[XB_XSUB(b.x)], 1u);
        const unsigned gen = old / nloc;
        if (old + 1u == (gen + 1u) * nloc) {
            __builtin_amdgcn_fence(__ATOMIC_RELEASE, "agent");
            asm volatile("s_waitcnt vmcnt(0)" ::: "memory");
            const unsigned og = xb_add(&bar[XB_TOP], 1u);
            const unsigned tg = og / nx;
            if (og + 1u == (tg + 1u) * nx) xb_add(&bar[XB_TOPGEN], 1u);
            else XB_SPIN(xb_ld(&bar[XB_TOPGEN]) == tg, bar);
            __builtin_amdgcn_fence(__ATOMIC_ACQUIRE, "agent");
            xb_add(&bar[XB_XGEN(b.x)], 1u);
            asm volatile("s_waitcnt vmcnt(0)" ::: "memory");
        } else {
            XB_SPIN(xb_ld(&bar[XB_XGEN(b.x)]) == gen, bar);
            __builtin_amdgcn_fence(__ATOMIC_ACQUIRE, "agent");
            asm volatile("s_waitcnt vmcnt(0)" ::: "memory");
        }
    }
    __syncthreads();
}

namespace mk {
using pg8::bf16_t; using pg8::bf16x8; using pg8::f32x4; using pg8::u32x4;

#define GAS __attribute__((address_space(1)))
typedef float f32x2 __attribute__((ext_vector_type(2)));
typedef float f32x16 __attribute__((ext_vector_type(16)));
typedef unsigned u32x2 __attribute__((ext_vector_type(2)));
typedef short s16x4 __attribute__((ext_vector_type(4)));
typedef __bf16 bf16x2_t __attribute__((ext_vector_type(2)));
typedef unsigned char uchar;

constexpr int S = 8192, D = 2048, NH = 8, HD = 128, CKV = 256, IH = 16, IDM = 64, TOPK = 256;
constexpr int GW = 1024, CHUNK = 128, NGRP = 8;
constexpr int NSRC = 8528, NPROJ = 8704;
constexpr int NE = 64, FF = 512;
constexpr float EPS = 1e-6f, LOG2E = 1.4426950408889634f;
constexpr int NTHR = 512, NWAVE = 8;
constexpr int MAXROWS = 32768;

constexpr size_t MiB = 1u << 20;
constexpr size_t WS_CTL = 0, CTL_BYTES = 1 * MiB;
constexpr size_t WS_WINT = 1 * MiB, WS_WAT = 35 * MiB, WS_WBT = 39 * MiB, WS_WOT = 43 * MiB, WS_WUK = 51 * MiB, WS_WUV = 51 * MiB + 512 * 1024, WS_WSM = 52 * MiB;
constexpr size_t WS_WE1 = 53 * MiB, WS_WE2 = 309 * MiB;
constexpr size_t WS_N1 = 437 * MiB;
constexpr size_t WS_Q = 469 * MiB, WS_CKVF = 485 * MiB, WS_CKV = 493 * MiB, WS_QI = 497 * MiB, WS_KIDX = 513 * MiB, WS_WIDX = 514 * MiB;
constexpr size_t WS_UV = 515 * MiB;
constexpr size_t WS_LNS = 547 * MiB, WS_GATE = 548 * MiB;
constexpr size_t WS_QABS = 612 * MiB, WS_OB = 644 * MiB;
constexpr size_t WS_MB = 676 * MiB, WS_IDX = 692 * MiB, WS_AB = 700 * MiB, WS_ROUTE = 716 * MiB;
constexpr size_t WS_SC = 717 * MiB;
constexpr size_t WS_END = 973 * MiB;
constexpr size_t RT_EID = 0, RT_POS = 65536, RT_WGT = 131072, RT_ROW = 196608, RT_CW = 262144;
constexpr int CW_BAR = 4096, CW_CNT = 65536;

constexpr int LDS_BYTES = 155648;
constexpr int LDS_X = 131072;
constexpr int LDS_MISC = LDS_BYTES - 256;

__device__ __forceinline__ unsigned pk2(float lo, float hi) { f32x2 v = {lo, hi}; return __builtin_bit_cast(unsigned, __builtin_convertvector(v, bf16x2_t)); }
__device__ __forceinline__ float bf_lo(unsigned u) { return __uint_as_float(u << 16); }
__device__ __forceinline__ float bf_hi(unsigned u) { return __uint_as_float(u & 0xffff0000u); }
__device__ __forceinline__ float bf1(bf16_t b) { return __uint_as_float(((unsigned)b) << 16); }
__device__ __forceinline__ float wave_sum(float v) {
#pragma unroll
    for (int o = 1; o < 64; o <<= 1) v += __shfl_xor(v, o);
    return v;
}
__device__ __forceinline__ float ex2(float x) { return __builtin_amdgcn_exp2f(x); }
__device__ __forceinline__ float sigm(float x) { return __builtin_amdgcn_rcpf(1.f + ex2(-x * LOG2E)); }
__device__ __forceinline__ float gelu_t(float x) { const float u = 0.7978845608028654f * (x + 0.044715f * x * x * x); return x * __builtin_amdgcn_rcpf(1.f + ex2(-2.f * LOG2E * u)); }
__device__ __forceinline__ float silu_(float x) { return x * sigm(x); }

struct Ctx {
    LAS uchar* lds; int tid, lane, wave, G, bid;
    const float* in[22]; float* out; uchar* ws;
};
#define WSP(T, off) ((T*)(C.ws + (off)))
enum { I_X = 0, I_N1G, I_WIN, I_KVG, I_WUK, I_WUV, I_GWS, I_GBS, I_LNG, I_LNB, I_WBA, I_WBG, I_WOUT, I_N2G, I_WGRP, I_BGRP, I_WRT, I_BRT, I_WEG, I_WEU, I_WED, I_NFG };

__device__ __forceinline__ int proj_src_col(int n) {
    if (n < 2304) return n;
    if (n < 8448) return n + 80;
    if (n < 8528) return n - 8448 + 2304;
    return -1;
}
__device__ __forceinline__ void tc_item(const float* __restrict__ W, size_t ldw, int srccol, bf16_t* WT, size_t K, int dstrow0, int k0, LAS float* scr, int lane) {
#pragma unroll 8
    for (int i = 0; i < 32; ++i) { const int kk = 2 * i + (lane >> 5); scr[kk * 33 + (lane & 31)] = srccol >= 0 ? W[(size_t)(k0 + kk) * ldw + srccol] : 0.f; }
    asm volatile("s_waitcnt lgkmcnt(0)" ::: "memory");
    const int c = lane & 7;
#pragma unroll
    for (int j = 0; j < 4; ++j) { const int n = (lane >> 3) + 8 * j; const LAS float* s = scr + (8 * c) * 33 + n;
        u32x4 o; o.x = pk2(s[0 * 33], s[1 * 33]); o.y = pk2(s[2 * 33], s[3 * 33]); o.z = pk2(s[4 * 33], s[5 * 33]); o.w = pk2(s[6 * 33], s[7 * 33]);
        *(u32x4*)(WT + (size_t)(dstrow0 + n) * K + k0 + 8 * c) = o; }
    asm volatile("s_waitcnt lgkmcnt(0)" ::: "memory");
}
__device__ __forceinline__ void p0_prologue(const Ctx& C) {
    LAS float* scr = (LAS float*)(C.lds + C.wave * 16384);
    const int gw = C.bid * NWAVE + C.wave, NGW = C.G * NWAVE, lane = C.lane;
    constexpr int I_IN = (NPROJ / 32) * (D / 64);
    constexpr int I_BA = (D / 32) * (1024 / 64);
    constexpr int I_OUT = (D / 32) * (D / 64);
    constexpr int I_E1 = NE * 32 * 32;
    constexpr int I_E2 = NE * 64 * 8;
    constexpr int NITEMS = I_IN + 2 * I_BA + I_OUT + I_E1 + I_E2;
    for (int it = gw; it < NITEMS; it += NGW) {
        int r = it;
        if (r < I_IN) { const int nb = r % (NPROJ / 32), kb = r / (NPROJ / 32); tc_item(C.in[I_WIN], NSRC, proj_src_col(32 * nb + (lane & 31)), WSP(bf16_t, WS_WINT), D, 32 * nb, 64 * kb, scr, lane); continue; } r -= I_IN;
        if (r < I_BA) { const int nb = r % 64, kb = r / 64; tc_item(C.in[I_WBA], D, 32 * nb + (lane & 31), WSP(bf16_t, WS_WAT), 1024, 32 * nb, 64 * kb, scr, lane); continue; } r -= I_BA;
        if (r < I_BA) { const int nb = r % 64, kb = r / 64; tc_item(C.in[I_WBG], D, 32 * nb + (lane & 31), WSP(bf16_t, WS_WBT), 1024, 32 * nb, 64 * kb, scr, lane); continue; } r -= I_BA;
        if (r < I_OUT) { const int nb = r % 64, kb = r / 64; tc_item(C.in[I_WOUT], D, 32 * nb + (lane & 31), WSP(bf16_t, WS_WOT), D, 32 * nb, 64 * kb, scr, lane); continue; } r -= I_OUT;
        if (r < I_E1) { const int e = r / 1024, q = r % 1024, nb = q % 32, kb = q / 32, j = nb >> 3, rb = nb & 7;
            const float* src = (rb < 4 ? C.in[I_WEG] : C.in[I_WEU]) + (size_t)e * D * FF;
            tc_item(src, FF, 128 * j + 32 * (rb & 3) + (lane & 31), WSP(bf16_t, WS_WE1), D, e * 1024 + 32 * nb, 64 * kb, scr, lane); continue; } r -= I_E1;
        { const int e = r / 512, q = r % 512, nb = q % 64, kb = q / 64;
            tc_item(C.in[I_WED] + (size_t)e * FF * D, D, 32 * nb + (lane & 31), WSP(bf16_t, WS_WE2), FF, e * 2048 + 32 * nb, 64 * kb, scr, lane); }
    }
    const int gt = C.bid * NTHR + C.tid, NGT = C.G * NTHR;
    for (int i = gt; i < 262144 / 4; i += NGT) {
        const f32x4 a = ((const f32x4*)C.in[I_WUK])[i], b = ((const f32x4*)C.in[I_WUV])[i];
        u32x2 oa, ob; oa.x = pk2(a.x, a.y); oa.y = pk2(a.z, a.w); ob.x = pk2(b.x, b.y); ob.y = pk2(b.z, b.w);
        WSP(u32x2, WS_WUK)[i] = oa; WSP(u32x2, WS_WUV)[i] = ob;
    }
    for (int i = gt; i < 131072 / 4; i += NGT) {
        const f32x4 a = ((const f32x4*)C.in[I_GWS])[i]; const int e = 4 * i, s0 = e & 127, t = (e >> 7) & 127;
        u32x2 o; o.x = pk2(s0 <= t ? a.x : 0.f, s0 + 1 <= t ? a.y : 0.f); o.y = pk2(s0 + 2 <= t ? a.z : 0.f, s0 + 3 <= t ? a.w : 0.f);
        WSP(u32x2, WS_WSM)[i] = o;
    }
    for (int m = gw; m < S; m += NGW) {
        const f32x4* xr = (const f32x4*)(C.in[I_X] + (size_t)m * D) + lane; const f32x4* gr = (const f32x4*)C.in[I_N1G] + lane;
        f32x4 v[8]; float ss = 0.f;
#pragma unroll
        for (int j = 0; j < 8; ++j) { v[j] = xr[64 * j]; ss += (v[j].x * v[j].x + v[j].y * v[j].y) + (v[j].z * v[j].z + v[j].w * v[j].w); }
        const float rstd = 1.0f / sqrtf(wave_sum(ss) * (1.f / D) + EPS);
        u32x2* o = WSP(u32x2, WS_N1) + (size_t)m * (D / 4) + lane;
#pragma unroll
        for (int j = 0; j < 8; ++j) { const f32x4 g = gr[64 * j]; u32x2 w; w.x = pk2(v[j].x * rstd * g.x, v[j].y * rstd * g.y); w.y = pk2(v[j].z * rstd * g.z, v[j].w * rstd * g.w); o[64 * j] = w; }
    }
}

struct EpiProj {
    static constexpr bool PERM = true, AFTER_DRAIN = false;
    bf16_t *Q, *QI, *UV, *GATE, *KIDX; float *CKVF, *LNS, *WIDX;
    template <int ACT> __device__ __forceinline__ void st_bf16(const f32x4 (&acc)[2][2][4][2], bf16_t* base, int ld, int row0, int col0, float sc) const {
#pragma unroll
        for (int ai = 0; ai < 2; ++ai)
#pragma unroll
            for (int m = 0; m < 4; ++m) { bf16_t* rowp = base + (size_t)(row0 + ai * 128 + m * 16) * ld + col0;
#pragma unroll
                for (int bj = 0; bj < 2; ++bj) { f32x4 v0 = acc[ai][bj][m][0], v1 = acc[ai][bj][m][1];
                    if (ACT == 0) { v0 *= sc; v1 *= sc; }
                    if (ACT == 1) {
#pragma unroll
                        for (int j = 0; j < 4; ++j) { v0[j] = gelu_t(v0[j]); v1[j] = gelu_t(v1[j]); } }
                    if (ACT == 2) {
#pragma unroll
                        for (int j = 0; j < 4; ++j) { v0[j] = sigm(v0[j]); v1[j] = sigm(v1[j]); } }
                    u32x4 w; w.x = pk2(v0[0], v0[1]); w.y = pk2(v0[2], v0[3]); w.z = pk2(v1[0], v1[1]); w.w = pk2(v1[2], v1[3]);
                    *(u32x4*)(rowp + bj * 128) = w; } }
    }
    __device__ __forceinline__ void operator()(const f32x4 (&acc)[2][2][4][2], const pg8::Unit& u, int wr, int wc, int fr, int fq) const {
        const int pn = u.pn, row0 = u.pm * 256 + wr * 64 + fr, cl = wc * 32 + 8 * fq;
        if (pn < 4) st_bf16<0>(acc, Q, 1024, row0, pn * 256 + cl, 1.f);
        else if (pn == 4) {
#pragma unroll
            for (int ai = 0; ai < 2; ++ai)
#pragma unroll
                for (int m = 0; m < 4; ++m) { float* rowp = CKVF + (size_t)(row0 + ai * 128 + m * 16) * 256 + cl;
#pragma unroll
                    for (int bj = 0; bj < 2; ++bj) { *(f32x4*)(rowp + bj * 128) = acc[ai][bj][m][0]; *(f32x4*)(rowp + bj * 128 + 4) = acc[ai][bj][m][1]; } }
        }
        else if (pn < 9) st_bf16<0>(acc, QI, 1024, row0, (pn - 5) * 256 + cl, 0.125f);
        else if (pn < 13) st_bf16<1>(acc, UV, 2048, row0, (pn - 9) * 256 + cl, 1.f);
        else if (pn < 17) {
#pragma unroll
            for (int ai = 0; ai < 2; ++ai)
#pragma unroll
                for (int m = 0; m < 4; ++m) { const int row = row0 + ai * 128 + m * 16; bf16_t* rowp = UV + (size_t)row * 2048 + (pn - 9) * 256 + cl; float s = 0.f, ss = 0.f;
#pragma unroll
                    for (int bj = 0; bj < 2; ++bj) { f32x4 v0 = acc[ai][bj][m][0], v1 = acc[ai][bj][m][1];
#pragma unroll
                        for (int j = 0; j < 4; ++j) { v0[j] = gelu_t(v0[j]); v1[j] = gelu_t(v1[j]); s += v0[j] + v1[j]; ss += v0[j] * v0[j] + v1[j] * v1[j]; }
                        u32x4 w; w.x = pk2(v0[0], v0[1]); w.y = pk2(v0[2], v0[3]); w.z = pk2(v1[0], v1[1]); w.w = pk2(v1[2], v1[3]);
                        *(u32x4*)(rowp + bj * 128) = w; }
                    s += __shfl_xor(s, 16); s += __shfl_xor(s, 32); ss += __shfl_xor(ss, 16); ss += __shfl_xor(ss, 32);
                    if (fq == 0) *(f32x2*)(LNS + (size_t)row * 32 + ((pn - 13) * 4 + wc) * 2) = (f32x2){s, ss}; }
        }
        else if (pn < 33) st_bf16<2>(acc, GATE, 4096, row0, (pn - 17) * 256 + cl, 1.f);
        else {
#pragma unroll
            for (int ai = 0; ai < 2; ++ai)
#pragma unroll
                for (int m = 0; m < 4; ++m) { const int row = row0 + ai * 128 + m * 16; const f32x4 v0 = acc[ai][0][m][0], v1 = acc[ai][0][m][1];
                    if (wc < 2) { u32x4 w; w.x = pk2(v0[0], v0[1]); w.y = pk2(v0[2], v0[3]); w.z = pk2(v1[0], v1[1]); w.w = pk2(v1[2], v1[3]); *(u32x4*)(KIDX + (size_t)row * 64 + cl) = w; }
                    else if (wc == 2 && fq < 2) { float* p = WIDX + (size_t)row * 16 + 8 * fq; *(f32x4*)p = v0 * 0.25f; *(f32x4*)(p + 4) = v1 * 0.25f; } }
        }
    }
};

__device__ __forceinline__ unsigned imgb_off(unsigned row, unsigned ch) { return 256u * row + 16u * (ch ^ (((row & 3u) << 2) | ((row >> 2) & 3u))); }
__device__ __forceinline__ unsigned imgb_row16(unsigned lane, unsigned rb, unsigned s) { return imgb_off((lane & 15u) + 16u * rb, 4u * s + (lane >> 4)); }
__device__ __forceinline__ unsigned imgb_tr16(unsigned lane, unsigned c, unsigned ks, unsigned t) { const unsigned g = lane >> 4, q = (lane & 15u) >> 2, p = lane & 3u; return imgb_off(32u * ks + 8u * g + 4u * t + q, 2u * c + (p >> 1)) + 8u * (p & 1u); }
__device__ __forceinline__ bf16x8 trrd8(LAS uchar* p0, LAS uchar* p1) {
    const s16x4 b0 = __builtin_amdgcn_ds_read_tr16_b64_v4i16((LAS s16x4*)p0), b1 = __builtin_amdgcn_ds_read_tr16_b64_v4i16((LAS s16x4*)p1);
    return __builtin_shufflevector(b0, b1, 0, 1, 2, 3, 4, 5, 6, 7);
}
#define MFMA16(a, b, c) __builtin_amdgcn_mfma_f32_16x16x32_bf16((a), (b), (c), 0, 0, 0)
__device__ __forceinline__ void load_img128(LAS uchar* img, const bf16_t* src, size_t ld, int tid) {
#pragma unroll
    for (int i = 0; i < 4; ++i) { const int q = tid + NTHR * i, row = q >> 4, ch = q & 15; *(LAS u32x4*)(img + imgb_off(row, ch)) = *(const u32x4*)(src + (size_t)row * ld + ch * 8); }
}
__device__ __forceinline__ void trgemm(LAS uchar* imgA, LAS uchar* imgB, int lane, int w, f32x4 (&acc)[8]) {
#pragma unroll
    for (int ks = 0; ks < 4; ++ks) {
        const bf16x8 a = *(LAS bf16x8*)(imgA + imgb_row16(lane, w, ks));
#pragma unroll
        for (int c = 0; c < 8; ++c) { const bf16x8 b = trrd8(imgB + imgb_tr16(lane, c, ks, 0), imgB + imgb_tr16(lane, c, ks, 1)); acc[c] = MFMA16(a, b, acc[c]); }
    }
}
constexpr int STG_LD = 132;
__device__ __forceinline__ void stage_acc(LAS float* stg, const f32x4 (&acc)[8], int lane) {
    const int col = lane & 15, g = lane >> 4;
#pragma unroll
    for (int c = 0; c < 8; ++c)
#pragma unroll
        for (int r = 0; r < 4; ++r) stg[(4 * g + r) * STG_LD + 16 * c + col] = acc[c][r];
}
__device__ __forceinline__ void stage_store_bf16(LAS float* stg, const f32x4 (&acc)[8], bf16_t* orow, size_t ld, int lane) {
    stage_acc(stg, acc, lane);
#pragma unroll
    for (int i = 0; i < 4; ++i) { const int q = lane + 64 * i, row = q >> 4, ch = q & 15; const LAS float* s = stg + row * STG_LD + 8 * ch;
        u32x4 o; o.x = pk2(s[0], s[1]); o.y = pk2(s[2], s[3]); o.z = pk2(s[4], s[5]); o.w = pk2(s[6], s[7]);
        *(u32x4*)(orow + (size_t)row * ld + 8 * ch) = o; }
}
#define ZERO8(a) do { _Pragma("unroll") for (int _c = 0; _c < 8; ++_c) a[_c] = (f32x4){0.f, 0.f, 0.f, 0.f}; } while (0)

__device__ __forceinline__ void p2_ckv_norm(const Ctx& C) {
    const int gw = C.bid * NWAVE + C.wave, NGW = C.G * NWAVE, lane = C.lane;
    const f32x4 g = ((const f32x4*)C.in[I_KVG])[lane];
    for (int m = gw; m < S; m += NGW) {
        const f32x4 v = ((const f32x4*)(WSP(float, WS_CKVF) + (size_t)m * CKV))[lane];
        const float ss = wave_sum((v.x * v.x + v.y * v.y) + (v.z * v.z + v.w * v.w));
        const float rstd = 1.0f / sqrtf(ss * (1.f / CKV) + EPS);
        u32x2 o; o.x = pk2(v.x * rstd * g.x, v.y * rstd * g.y); o.y = pk2(v.z * rstd * g.z, v.w * rstd * g.w);
        (WSP(u32x2, WS_CKV) + (size_t)m * (CKV / 4))[lane] = o;
    }
}
__device__ __forceinline__ void p2_qabs(const Ctx& C) {
    LAS uchar* imgA = C.lds; LAS uchar* imgB = C.lds + 32768;
    LAS float* stg = (LAS float*)(C.lds) + C.wave * 16 * STG_LD;
    const int lane = C.lane, w = C.wave;
#pragma unroll 1
    for (int u = C.bid; u < 64 * NH * 2; u += C.G) {
        const int half = u & 1, h = (u >> 1) & 7, t0 = (u >> 4) * 128;
        __syncthreads();
        load_img128(imgA, WSP(bf16_t, WS_Q) + (size_t)t0 * 1024 + h * 128, 1024, C.tid);
        load_img128(imgB, WSP(bf16_t, WS_WUK) + (size_t)h * 128 * 256 + half * 128, 256, C.tid);
        __syncthreads();
        f32x4 acc[8]; ZERO8(acc);
        trgemm(imgA, imgB, lane, w, acc);
        __syncthreads();
        stage_store_bf16(stg, acc, WSP(bf16_t, WS_QABS) + (size_t)(t0 + 16 * w) * 2048 + h * 256 + half * 128, 2048, lane);
    }
    __syncthreads();
}
__device__ __forceinline__ void p2_gmlp(const Ctx& C) {
    LAS uchar* imgA = C.lds; LAS uchar* imgB = C.lds + 32768; LAS f32x2* stat = (LAS f32x2*)(C.lds + 65536);
    LAS float* stg = (LAS float*)(C.lds) + C.wave * 16 * STG_LD;
    const int lane = C.lane, w = C.wave, tid = C.tid;
    const bf16_t* UV = WSP(bf16_t, WS_UV);
    for (int u = C.bid; u < 64 * NGRP; u += C.G) {
        const int g = u & 7, t0 = (u >> 3) * 128;
        __syncthreads();
        if (tid < 128) { const float* p = WSP(float, WS_LNS) + (size_t)(t0 + tid) * 32; float s = 0.f, ss = 0.f;
#pragma unroll
            for (int j = 0; j < 16; ++j) { s += p[2 * j]; ss += p[2 * j + 1]; }
            const float mean = s * (1.f / GW), var = fmaxf(ss * (1.f / GW) - mean * mean, 0.f);
            stat[tid] = (f32x2){mean, 1.0f / sqrtf(var + EPS)}; }
        load_img128(imgA, WSP(bf16_t, WS_WSM) + (size_t)g * 128 * 128, 128, tid);
        __syncthreads();
#pragma unroll
        for (int i = 0; i < 4; ++i) { const int q = tid + NTHR * i, row = q >> 4, ch = q & 15; const f32x2 st = stat[row];
            const u32x4 v = *(const u32x4*)(UV + (size_t)(t0 + row) * 2048 + 1024 + g * 128 + ch * 8);
            const float* lg = C.in[I_LNG] + g * 128 + ch * 8; const float* lb = C.in[I_LNB] + g * 128 + ch * 8;
            const unsigned vv[4] = {v.x, v.y, v.z, v.w}; unsigned o[4];
#pragma unroll
            for (int j = 0; j < 4; ++j) { const float a = (bf_lo(vv[j]) - st.x) * st.y * lg[2 * j] + lb[2 * j], b = (bf_hi(vv[j]) - st.x) * st.y * lg[2 * j + 1] + lb[2 * j + 1]; o[j] = pk2(a, b); }
            *(LAS u32x4*)(imgB + imgb_off(row, ch)) = (u32x4){o[0], o[1], o[2], o[3]}; }
        __syncthreads();
        f32x4 acc[8]; ZERO8(acc);
        trgemm(imgA, imgB, lane, w, acc);
        __syncthreads();
        stage_acc(stg, acc, lane);
#pragma unroll
        for (int i = 0; i < 4; ++i) { const int q = lane + 64 * i, row = q >> 4, ch = q & 15; const LAS float* s = stg + row * STG_LD + 8 * ch;
            const int tl = 16 * w + row; const float bias = C.in[I_GBS][g * 128 + tl];
            const u32x4 uu = *(const u32x4*)(UV + (size_t)(t0 + tl) * 2048 + g * 128 + ch * 8);
            u32x4 o; o.x = pk2(bf_lo(uu.x) * (s[0] + bias), bf_hi(uu.x) * (s[1] + bias)); o.y = pk2(bf_lo(uu.y) * (s[2] + bias), bf_hi(uu.y) * (s[3] + bias));
            o.z = pk2(bf_lo(uu.z) * (s[4] + bias), bf_hi(uu.z) * (s[5] + bias)); o.w = pk2(bf_lo(uu.w) * (s[6] + bias), bf_hi(uu.w) * (s[7] + bias));
            *(u32x4*)(WSP(bf16_t, WS_MB) + (size_t)(t0 + tl) * 1024 + g * 128 + ch * 8) = o; }
    }
    __syncthreads();
}

#define MFMA32(a, b, c) __builtin_amdgcn_mfma_f32_32x32x16_bf16((a), (b), (c), 0, 0, 0)
__device__ __forceinline__ float ldsc(const float* p) { return __hip_atomic_load(p, __ATOMIC_RELAXED, __HIP_MEMORY_SCOPE_AGENT); }
__device__ __forceinline__ void idx_scores_pair(const Ctx& C, int tA) {
    const int lane = C.lane, r = lane & 31, hh = lane >> 5;
    const int tau = (r >> 2) & 1, eta = (r & 3) + 4 * (r >> 3);
    const bf16_t* QI = WSP(bf16_t, WS_QI); const bf16_t* KI = WSP(bf16_t, WS_KIDX); const float* WI = WSP(float, WS_WIDX);
    bf16x8 a[4];
#pragma unroll
    for (int ks = 0; ks < 4; ++ks) a[ks] = *(const bf16x8*)(QI + (size_t)(tA + tau) * 1024 + eta * 64 + 16 * ks + 8 * hh);
    f32x4 wv[4];
#pragma unroll
    for (int i = 0; i < 4; ++i) wv[i] = *(const f32x4*)(WI + (size_t)(tA + hh) * 16 + 4 * i);
    float* sc = WSP(float, WS_SC);
    const int t = tA + hh, ntile = ((tA + 1) >> 5) + 1;
    for (int tile = 0; tile < ntile; ++tile) {
        const int s = 32 * tile + r;
        bf16x8 b[4];
#pragma unroll
        for (int ks = 0; ks < 4; ++ks) b[ks] = *(const bf16x8*)(KI + (size_t)s * 64 + 16 * ks + 8 * hh);
        f32x16 acc;
#pragma unroll
        for (int i = 0; i < 16; ++i) acc[i] = 0.f;
#pragma unroll
        for (int ks = 0; ks < 4; ++ks) acc = MFMA32(a[ks], b[ks], acc);
        float v = 0.f;
#pragma unroll
        for (int i = 0; i < 16; ++i) v += wv[i >> 2][i & 3] * fmaxf(acc[i], 0.f);
        if (s <= t) sc[(size_t)t * S + s] = v;
    }
}
__device__ __forceinline__ unsigned f2key(float x) { const unsigned u = __float_as_uint(x); return (u & 0x80000000u) ? ~u : (u | 0x80000000u); }
__device__ __forceinline__ int sbucket(float x) { float f = (x + 8.f) * 128.f; f = fminf(fmaxf(f, 0.f), 2047.f); return (int)f; }
__device__ __forceinline__ unsigned lds_inc(LAS unsigned* p) { return __hip_atomic_fetch_add(p, 1u, __ATOMIC_RELAXED, __HIP_MEMORY_SCOPE_WORKGROUP); }
__device__ __forceinline__ unsigned suffix_incl(unsigned v, int lane) {
#pragma unroll
    for (int o = 1; o < 64; o <<= 1) { const unsigned x = __shfl_down(v, o); if (lane + o < 64) v += x; }
    return v;
}
__device__ __forceinline__ void select_row(const Ctx& C, int t, LAS unsigned* hist) {
    const int lane = C.lane, n = t + 1; int* out = WSP(int, WS_IDX) + (size_t)t * TOPK;
    if (n <= TOPK) { for (int j = lane; j < TOPK; j += 64) out[j] = j < n ? j : -1; return; }
    const float* row = WSP(float, WS_SC) + (size_t)t * S;
#pragma unroll
    for (int i = 0; i < 32; ++i) hist[lane + 64 * i] = 0u;
    for (int i = lane; i < n; i += 64) lds_inc(&hist[sbucket(ldsc(row + i))]);
    unsigned tot = 0;
#pragma unroll
    for (int j = 0; j < 32; ++j) tot += hist[32 * lane + ((j + lane) & 31)];
    unsigned incl = suffix_incl(tot, lane), above = incl - tot;
    bool mine = above < (unsigned)TOPK && incl >= (unsigned)TOPK;
    int bstar = 0; unsigned krem = 0;
    if (mine) { unsigned cum = above; for (int b = 32 * lane + 31; b >= 32 * lane; --b) { const unsigned hh = hist[b]; if (cum + hh >= (unsigned)TOPK) { bstar = b; krem = (unsigned)TOPK - cum; break; } cum += hh; } }
    { const unsigned long long mk = __ballot(mine); const int src = __ffsll((long long)mk) - 1; bstar = __shfl(bstar, src); krem = __shfl(krem, src); }
    unsigned prefix = 0u;
#pragma unroll 1
    for (int pass = 0; pass < 4; ++pass) {
        const int shift = 24 - 8 * pass;
#pragma unroll
        for (int i = 0; i < 4; ++i) hist[lane + 64 * i] = 0u;
        for (int i = lane; i < n; i += 64) { const float x = ldsc(row + i);
            if (sbucket(x) == bstar) { const unsigned key = f2key(x); if (pass == 0 || (key >> (shift + 8)) == (prefix >> (shift + 8))) lds_inc(&hist[(key >> shift) & 255u]); } }
        unsigned h4[4]; unsigned tt = 0;
#pragma unroll
        for (int j = 0; j < 4; ++j) { h4[j] = hist[4 * lane + j]; tt += h4[j]; }
        const unsigned in2 = suffix_incl(tt, lane), ab2 = in2 - tt;
        const bool m2 = ab2 < krem && in2 >= krem;
        int d = 0; unsigned nk = 0;
        if (m2) { unsigned cum = ab2;
#pragma unroll
            for (int j = 3; j >= 0; --j) { if (nk == 0u) { if (cum + h4[j] >= krem) { d = 4 * lane + j; nk = krem - cum; } else cum += h4[j]; } } }
        const unsigned long long mk = __ballot(m2); const int src = __ffsll((long long)mk) - 1; d = __shfl(d, src); krem = __shfl(nk, src);
        prefix |= (unsigned)d << shift;
    }
    const unsigned long long lt = (1ull << lane) - 1ull;
    unsigned cnt = 0, eqc = 0;
    for (int base = 0; base < n; base += 64) { const int i = base + lane; const bool valid = i < n; const float x = valid ? ldsc(row + i) : 0.f;
        const int b = sbucket(x); const unsigned key = f2key(x);
        const bool gt = valid && (b > bstar || (b == bstar && key > prefix)), eq = valid && b == bstar && key == prefix;
        const unsigned long long em = __ballot(eq); const unsigned rank = eqc + (unsigned)__popcll(em & lt);
        const bool take = gt || (eq && rank < krem);
        const unsigned long long tm = __ballot(take); const unsigned pos = cnt + (unsigned)__popcll(tm & lt);
        if (take && pos < (unsigned)TOPK) out[pos] = i;
        cnt += (unsigned)__popcll(tm); eqc += (unsigned)__popcll(em); }
}
__device__ __forceinline__ void p2_indexer(const Ctx& C) {
    LAS unsigned* hist = (LAS unsigned*)(C.lds + C.wave * 8192);
    for (int i = C.bid; i < 256; i += C.G) {
#pragma unroll 1
        for (int half = 0; half < 2; ++half) {
            const int u = half ? 511 - i : i, tA = 16 * u + 2 * C.wave;
            idx_scores_pair(C, tA);
            asm volatile("s_waitcnt vmcnt(0)" ::: "memory");
            select_row(C, tA, hist); select_row(C, tA + 1, hist);
        }
    }
}

__device__ __forceinline__ void p3_attention(const Ctx& C) {
    const int lane = C.lane, w = C.wave, g = lane >> 4, h = lane & 15;
    LAS uchar* img = C.lds;
    LAS float* mx = (LAS float*)(C.lds + LDS_X);
    LAS float* ls = mx + 128;
    LAS uchar* pf = C.lds + LDS_X + 1024;
    const bf16_t* CK = WSP(bf16_t, WS_CKV);
    const float scale = 0.08838834764831845f;
    for (int t = C.bid; t < S; t += C.G) {
        const int myidx = WSP(int, WS_IDX)[(size_t)t * TOPK + 32 * w + (lane & 31)];
#pragma unroll
        for (int i = 0; i < 16; ++i) { const int rl = 2 * i + (lane >> 5); const int key = __shfl(myidx, rl); const int kk = (key < 0 || key > t) ? 0 : key; const int ch32 = lane & 31;
            const u32x4 v = *(const u32x4*)(CK + (size_t)kk * CKV + ch32 * 8);
            *(LAS u32x4*)(img + (ch32 >> 4) * 65536 + imgb_off(32 * w + rl, ch32 & 15)) = v; }
        bf16x8 bq[8]; const bf16_t* qa = WSP(bf16_t, WS_QABS) + (size_t)t * 2048 + (h & 7) * 256 + 8 * g;
#pragma unroll
        for (int kc = 0; kc < 8; ++kc) { bq[kc] = *(const bf16x8*)(qa + 32 * kc); if (h >= 8) bq[kc] = (bf16x8){0, 0, 0, 0, 0, 0, 0, 0}; }
        f32x4 x0 = {0.f, 0.f, 0.f, 0.f}, x1 = {0.f, 0.f, 0.f, 0.f};
        const unsigned rho0 = 32u * w + 8u * (h >> 2) + (h & 3);
#pragma unroll
        for (int kc = 0; kc < 8; ++kc) { const unsigned ch = (4u * kc + g) & 15u; LAS uchar* ib = img + (kc >> 2) * 65536;
            const bf16x8 a0 = *(LAS bf16x8*)(ib + imgb_off(rho0, ch)), a1 = *(LAS bf16x8*)(ib + imgb_off(rho0 + 4u, ch));
            x0 = MFMA16(a0, bq[kc], x0); x1 = MFMA16(a1, bq[kc], x1); }
        float lg[8]; float m = -1e30f;
#pragma unroll
        for (int r = 0; r < 4; ++r) { const int k0 = __shfl(myidx, 8 * g + r), k1 = __shfl(myidx, 8 * g + 4 + r); const bool v0 = k0 >= 0 && k0 <= t, v1 = k1 >= 0 && k1 <= t;
            lg[r] = v0 ? x0[r] * scale : -1e30f; lg[4 + r] = v1 ? x1[r] * scale : -1e30f; m = fmaxf(m, fmaxf(lg[r], lg[4 + r])); }
        m = fmaxf(m, __shfl_xor(m, 16)); m = fmaxf(m, __shfl_xor(m, 32));
        if (g == 0) mx[w * 16 + h] = m;
        __syncthreads();
        float M = mx[h];
#pragma unroll
        for (int ww = 1; ww < 8; ++ww) M = fmaxf(M, mx[ww * 16 + h]);
        float p[8], sum = 0.f;
#pragma unroll
        for (int j = 0; j < 8; ++j) { p[j] = ex2((lg[j] - M) * LOG2E); sum += p[j]; }
        sum += __shfl_xor(sum, 16); sum += __shfl_xor(sum, 32);
        if (g == 0) ls[w * 16 + h] = sum;
        { u32x4 pk; pk.x = pk2(p[0], p[1]); pk.y = pk2(p[2], p[3]); pk.z = pk2(p[4], p[5]); pk.w = pk2(p[6], p[7]); *(LAS u32x4*)(pf + (w * 64 + lane) * 16) = pk; }
        __syncthreads();
        float L = ls[h];
#pragma unroll
        for (int ww = 1; ww < 8; ++ww) L += ls[ww * 16 + h];
        f32x4 z0 = {0.f, 0.f, 0.f, 0.f}, z1 = {0.f, 0.f, 0.f, 0.f};
#pragma unroll
        for (int ks = 0; ks < 8; ++ks) { const bf16x8 a = *(LAS bf16x8*)(pf + (ks * 64 + lane) * 16);
            { const unsigned cc = 2u * w; LAS uchar* ib = img + (cc >> 3) * 65536; const bf16x8 b = trrd8(ib + imgb_tr16(lane, cc & 7u, ks, 0), ib + imgb_tr16(lane, cc & 7u, ks, 1)); z0 = MFMA16(a, b, z0); }
            { const unsigned cc = 2u * w + 1u; LAS uchar* ib = img + (cc >> 3) * 65536; const bf16x8 b = trrd8(ib + imgb_tr16(lane, cc & 7u, ks, 0), ib + imgb_tr16(lane, cc & 7u, ks, 1)); z1 = MFMA16(a, b, z1); } }
        float rl[4];
#pragma unroll
        for (int r = 0; r < 4; ++r) rl[r] = 1.0f / __shfl(L, (4 * g + r) & 15);
        if (g < 2) { bf16_t* o = WSP(bf16_t, WS_OB) + (size_t)t * 2048 + 32 * w + h;
#pragma unroll
            for (int r = 0; r < 4; ++r) { o[(4 * g + r) * 256] = (bf16_t)(pk2(z0[r] * rl[r], 0.f) & 0xffffu); o[(4 * g + r) * 256 + 16] = (bf16_t)(pk2(z1[r] * rl[r], 0.f) & 0xffffu); } }
        __syncthreads();
    }
}
__device__ __forceinline__ void p3_wuv(const Ctx& C) {
    LAS uchar* imgA0 = C.lds; LAS uchar* imgA1 = C.lds + 32768; LAS uchar* imgB0 = C.lds + 65536; LAS uchar* imgB1 = C.lds + 98304;
    LAS float* stg = (LAS float*)(C.lds) + C.wave * 16 * STG_LD;
    const int lane = C.lane, w = C.wave;
    for (int u = C.bid; u < 64 * NH; u += C.G) {
        const int h = u & 7, t0 = (u >> 3) * 128;
        __syncthreads();
        load_img128(imgA0, WSP(bf16_t, WS_OB) + (size_t)t0 * 2048 + h * 256, 2048, C.tid);
        load_img128(imgA1, WSP(bf16_t, WS_OB) + (size_t)t0 * 2048 + h * 256 + 128, 2048, C.tid);
        load_img128(imgB0, WSP(bf16_t, WS_WUV) + (size_t)h * 256 * 128, 128, C.tid);
        load_img128(imgB1, WSP(bf16_t, WS_WUV) + (size_t)h * 256 * 128 + 128 * 128, 128, C.tid);
        __syncthreads();
        f32x4 acc[8]; ZERO8(acc);
        trgemm(imgA0, imgB0, lane, w, acc); trgemm(imgA1, imgB1, lane, w, acc);
        __syncthreads();
        stage_store_bf16(stg, acc, WSP(bf16_t, WS_AB) + (size_t)(t0 + 16 * w) * 1024 + h * 128, 1024, lane);
    }
    __syncthreads();
}

struct EpiGateA {
    static constexpr bool PERM = true, AFTER_DRAIN = false;
    float* TMP; const bf16_t* GATE;
    __device__ __forceinline__ void operator()(const f32x4 (&acc)[2][2][4][2], const pg8::Unit& u, int wr, int wc, int fr, int fq) const {
        const int row0 = u.pm * 256 + wr * 64 + fr, col0 = u.pn * 256 + wc * 32 + 8 * fq;
#pragma unroll
        for (int ai = 0; ai < 2; ++ai)
#pragma unroll
            for (int m = 0; m < 4; ++m) { const size_t row = (size_t)(row0 + ai * 128 + m * 16);
#pragma unroll
                for (int bj = 0; bj < 2; ++bj) { const u32x4 gv = *(const u32x4*)(GATE + row * 4096 + col0 + bj * 128); const f32x4 v0 = acc[ai][bj][m][0], v1 = acc[ai][bj][m][1];
                    float* p = TMP + row * D + col0 + bj * 128;
                    *(f32x4*)p = (f32x4){v0[0] * bf_lo(gv.x), v0[1] * bf_hi(gv.x), v0[2] * bf_lo(gv.y), v0[3] * bf_hi(gv.y)};
                    *(f32x4*)(p + 4) = (f32x4){v1[0] * bf_lo(gv.z), v1[1] * bf_hi(gv.z), v1[2] * bf_lo(gv.w), v1[3] * bf_hi(gv.w)}; } }
    }
};
struct EpiGateB {
    static constexpr bool PERM = true, AFTER_DRAIN = false;
    const float* TMP; const bf16_t* GATE; bf16_t* MG;
    __device__ __forceinline__ void operator()(const f32x4 (&acc)[2][2][4][2], const pg8::Unit& u, int wr, int wc, int fr, int fq) const {
        const int row0 = u.pm * 256 + wr * 64 + fr, col0 = u.pn * 256 + wc * 32 + 8 * fq;
#pragma unroll
        for (int ai = 0; ai < 2; ++ai)
#pragma unroll
            for (int m = 0; m < 4; ++m) { const size_t row = (size_t)(row0 + ai * 128 + m * 16);
#pragma unroll
                for (int bj = 0; bj < 2; ++bj) { const u32x4 gv = *(const u32x4*)(GATE + row * 4096 + 2048 + col0 + bj * 128); const f32x4 v0 = acc[ai][bj][m][0], v1 = acc[ai][bj][m][1];
                    const float* p = TMP + row * D + col0 + bj * 128; const f32x4 t0 = *(const f32x4*)p, t1 = *(const f32x4*)(p + 4);
                    u32x4 w; w.x = pk2(t0[0] + v0[0] * bf_lo(gv.x), t0[1] + v0[1] * bf_hi(gv.x)); w.y = pk2(t0[2] + v0[2] * bf_lo(gv.y), t0[3] + v0[3] * bf_hi(gv.y));
                    w.z = pk2(t1[0] + v1[0] * bf_lo(gv.z), t1[1] + v1[1] * bf_hi(gv.z)); w.w = pk2(t1[2] + v1[2] * bf_lo(gv.w), t1[3] + v1[3] * bf_hi(gv.w));
                    *(u32x4*)(MG + row * D + col0 + bj * 128) = w; } }
    }
};
struct EpiRes {
    static constexpr bool PERM = false, AFTER_DRAIN = false;
    const float* X; float* H;
    __device__ __forceinline__ void operator()(const f32x4 (&acc)[2][2][4][2], const pg8::Unit& u, int wr, int wc, int fr, int fq) const {
        const int row0 = u.pm * 256 + wr * 64 + fr, col0 = u.pn * 256 + wc * 32 + 4 * fq;
#pragma unroll
        for (int ai = 0; ai < 2; ++ai)
#pragma unroll
            for (int m = 0; m < 4; ++m) { const size_t off = (size_t)(row0 + ai * 128 + m * 16) * D + col0;
#pragma unroll
                for (int bj = 0; bj < 2; ++bj)
#pragma unroll
                    for (int n = 0; n < 2; ++n) *(f32x4*)(H + off + bj * 128 + n * 16) = *(const f32x4*)(X + off + bj * 128 + n * 16) + acc[ai][bj][m][n]; }
    }
};
struct MoeOrder {
    int G, c, ntn, ntiles; const LAS int* tile2e;
    __device__ __forceinline__ bool next(int i, pg8::Unit& u) const { const int L = i * G + c; if (L >= ntiles * ntn) return false; const int tile = L / ntn, j = L - tile * ntn; u.pm = tile; u.pn = tile2e[tile] * ntn + j; return true; }
    __device__ __forceinline__ void a_ready(const pg8::Unit&) const {}
    __device__ __forceinline__ void done(const pg8::Unit&) const {}
};
struct EpiMoe1 {
    static constexpr bool PERM = true, AFTER_DRAIN = false;
    bf16_t* HID; const float* CW;
    __device__ __forceinline__ void operator()(const f32x4 (&acc)[2][2][4][2], const pg8::Unit& u, int wr, int wc, int fr, int fq) const {
        const int row0 = u.pm * 256 + wr * 64 + fr, col0 = (u.pn & 3) * 128 + wc * 32 + 8 * fq;
#pragma unroll
        for (int ai = 0; ai < 2; ++ai)
#pragma unroll
            for (int m = 0; m < 4; ++m) { const size_t row = (size_t)(row0 + ai * 128 + m * 16); const float cw = CW[row];
                const f32x4 g0 = acc[ai][0][m][0], g1 = acc[ai][0][m][1], u0 = acc[ai][1][m][0], u1 = acc[ai][1][m][1];
                u32x4 w; w.x = pk2(silu_(g0[0]) * u0[0] * cw, silu_(g0[1]) * u0[1] * cw); w.y = pk2(silu_(g0[2]) * u0[2] * cw, silu_(g0[3]) * u0[3] * cw);
                w.z = pk2(silu_(g1[0]) * u1[0] * cw, silu_(g1[1]) * u1[1] * cw); w.w = pk2(silu_(g1[2]) * u1[2] * cw, silu_(g1[3]) * u1[3] * cw);
                *(u32x4*)(HID + row * FF + col0) = w; }
    }
};
struct EpiMoe2 {
    static constexpr bool PERM = true, AFTER_DRAIN = false;
    bf16_t* YS;
    __device__ __forceinline__ void operator()(const f32x4 (&acc)[2][2][4][2], const pg8::Unit& u, int wr, int wc, int fr, int fq) const {
        const int row0 = u.pm * 256 + wr * 64 + fr, col0 = (u.pn & 7) * 256 + wc * 32 + 8 * fq;
#pragma unroll
        for (int ai = 0; ai < 2; ++ai)
#pragma unroll
            for (int m = 0; m < 4; ++m) { bf16_t* rowp = YS + (size_t)(row0 + ai * 128 + m * 16) * D + col0;
#pragma unroll
                for (int bj = 0; bj < 2; ++bj) { const f32x4 v0 = acc[ai][bj][m][0], v1 = acc[ai][bj][m][1];
                    u32x4 w; w.x = pk2(v0[0], v0[1]); w.y = pk2(v0[2], v0[3]); w.z = pk2(v1[0], v1[1]); w.w = pk2(v1[2], v1[3]); *(u32x4*)(rowp + bj * 128) = w; } }
    }
};
constexpr int LDS_TOFF = LDS_X + 8192, LDS_T2E = LDS_X + 8192 + 512;
__device__ __forceinline__ void build_tile_table(const Ctx& C) {
    LAS int* toff = (LAS int*)(C.lds + LDS_TOFF); LAS int* t2e = (LAS int*)(C.lds + LDS_T2E);
    const unsigned* cnt = WSP(unsigned, WS_CTL) + CW_CNT;
    __syncthreads();
    if (C.tid == 0) { int acc = 0; for (int e = 0; e < NE; ++e) { toff[e] = acc; const int nt = (int)((cnt[e] + 255u) >> 8); for (int i = 0; i < nt && acc + i < 128; ++i) t2e[acc + i] = e; acc += nt; } toff[NE] = acc; }
    __syncthreads();
}
constexpr int XS_LD = 2052;
__device__ __forceinline__ void p6_router(const Ctx& C) {
    LAS float* xs = (LAS float*)C.lds;
    LAS float* lgt = (LAS float*)(C.lds + LDS_X + 1024);
    const int lane = C.lane, w = C.wave, tid = C.tid;
    const float* H = C.out; const float* WG = C.in[I_WGRP]; const float* WR = C.in[I_WRT];
    unsigned* cnt = WSP(unsigned, WS_CTL) + CW_CNT;
    for (int u = C.bid; u < S / 16; u += C.G) {
        const int t0 = 16 * u;
        __syncthreads();
#pragma unroll 1
        for (int rr = 0; rr < 2; ++rr) { const int row = 2 * w + rr, t = t0 + row;
            const f32x4* hr = (const f32x4*)(H + (size_t)t * D) + lane; const f32x4* gr = (const f32x4*)C.in[I_N2G] + lane;
            f32x4 v[8]; float ss = 0.f;
#pragma unroll
            for (int j = 0; j < 8; ++j) { v[j] = hr[64 * j]; ss += (v[j].x * v[j].x + v[j].y * v[j].y) + (v[j].z * v[j].z + v[j].w * v[j].w); }
            const float rstd = 1.0f / sqrtf(wave_sum(ss) * (1.f / D) + EPS);
            u32x2* o = WSP(u32x2, WS_N1) + (size_t)t * (D / 4) + lane;
#pragma unroll
            for (int j = 0; j < 8; ++j) { const f32x4 g = gr[64 * j]; const f32x4 n = {v[j].x * rstd * g.x, v[j].y * rstd * g.y, v[j].z * rstd * g.z, v[j].w * rstd * g.w};
                u32x2 ww; ww.x = pk2(n.x, n.y); ww.y = pk2(n.z, n.w); o[64 * j] = ww;
                *(LAS f32x4*)(xs + row * XS_LD + 4 * (64 * j + lane)) = n; } }
        __syncthreads();
        if (w < 5) {
            f32x4 acc = {0.f, 0.f, 0.f, 0.f}; const int c = lane & 15, kq = lane >> 4;
            const LAS float* ap = xs + c * XS_LD + kq;
            const float* bp = (w == 0) ? WG + (size_t)kq * 8 + (c & 7) : WR + (size_t)kq * 64 + (w - 1) * 16 + c;
            const size_t bstep = (w == 0) ? 32 : 256;
            const bool bz = (w == 0) && c >= 8;
#pragma unroll 8
            for (int k0 = 0; k0 < D; k0 += 4) { float b = bp[(size_t)(k0 >> 2) * bstep]; if (bz) b = 0.f; acc = __builtin_amdgcn_mfma_f32_16x16x4f32(ap[k0], b, acc, 0, 0, 0); }
#pragma unroll
            for (int i = 0; i < 4; ++i) lgt[(4 * kq + i) * 80 + 16 * w + c] = acc[i];
        }
        __syncthreads();
        if (tid < 16) { const int t = t0 + tid; const LAS float* l = lgt + tid * 80;
            int gi = 0; float gm = l[0] + C.in[I_BGRP][0];
#pragma unroll
            for (int i = 1; i < 8; ++i) { const float v = l[i] + C.in[I_BGRP][i]; if (v > gm) { gm = v; gi = i; } }
            float den = 0.f;
#pragma unroll
            for (int i = 0; i < 8; ++i) den += __expf(l[i] + C.in[I_BGRP][i] - gm);
            const float gval = 1.0f / den;
            const LAS float* el = l + 16 + 8 * gi; const float* be = C.in[I_BRT] + 8 * gi;
            int i0 = 0; float v0 = el[0] + be[0];
#pragma unroll
            for (int i = 1; i < 8; ++i) { const float v = el[i] + be[i]; if (v > v0) { v0 = v; i0 = i; } }
            int i1 = -1; float v1 = -3.0e38f;
#pragma unroll
            for (int i = 0; i < 8; ++i) { const float v = el[i] + be[i]; if (i != i0 && v > v1) { v1 = v; i1 = i; } }
            const float q0 = 1.0f / (1.0f + __expf(v1 - v0)), q1 = 1.0f - q0;
            const int e0 = 8 * gi + i0, e1 = 8 * gi + i1;
            const int p0 = (int)atomicAdd(cnt + e0, 1u), p1 = (int)atomicAdd(cnt + e1, 1u);
            int* eid = (int*)(C.ws + WS_ROUTE + RT_EID) + 2 * t; int* pos = (int*)(C.ws + WS_ROUTE + RT_POS) + 2 * t; float* wg = (float*)(C.ws + WS_ROUTE + RT_WGT) + 2 * t;
            eid[0] = e0; eid[1] = e1; pos[0] = p0; pos[1] = p1; wg[0] = gval * q0; wg[1] = gval * q1; }
    }
    __syncthreads();
}
__device__ __forceinline__ void p7_gather(const Ctx& C) {
    build_tile_table(C);
    const LAS int* toff = (const LAS int*)(C.lds + LDS_TOFF);
    const int gw = C.bid * NWAVE + C.wave, NGW = C.G * NWAVE, lane = C.lane;
    for (int t = gw; t < S; t += NGW) {
        const u32x4* src = WSP(u32x4, WS_N1) + (size_t)t * (D / 8) + lane;
        u32x4 v[4];
#pragma unroll
        for (int j = 0; j < 4; ++j) v[j] = src[64 * j];
#pragma unroll
        for (int sl = 0; sl < 2; ++sl) {
            const int e = ((const int*)(C.ws + WS_ROUTE + RT_EID))[2 * t + sl], p = ((const int*)(C.ws + WS_ROUTE + RT_POS))[2 * t + sl];
            const int r = toff[e] * 256 + p;
            u32x4* dst = WSP(u32x4, WS_SC) + (size_t)r * (D / 8) + lane;
#pragma unroll
            for (int j = 0; j < 4; ++j) dst[64 * j] = v[j];
            if (lane == 0) { ((float*)(C.ws + WS_ROUTE + RT_CW))[r] = ((const float*)(C.ws + WS_ROUTE + RT_WGT))[2 * t + sl]; ((int*)(C.ws + WS_ROUTE + RT_ROW))[2 * t + sl] = r; }
        }
    }
}
__device__ __forceinline__ void p9_final(const Ctx& C) {
    const int gw = C.bid * NWAVE + C.wave, NGW = C.G * NWAVE, lane = C.lane;
    const bf16_t* YS = WSP(bf16_t, WS_SC + 128 * MiB);
    for (int t = gw; t < S; t += NGW) {
        const int r0 = ((const int*)(C.ws + WS_ROUTE + RT_ROW))[2 * t], r1 = ((const int*)(C.ws + WS_ROUTE + RT_ROW))[2 * t + 1];
        f32x4* hr = (f32x4*)(C.out + (size_t)t * D) + lane; const f32x4* gr = (const f32x4*)C.in[I_NFG] + lane;
        const u32x2* y0 = (const u32x2*)(YS + (size_t)r0 * D) + lane; const u32x2* y1 = (const u32x2*)(YS + (size_t)r1 * D) + lane;
        f32x4 v[8]; float ss = 0.f;
#pragma unroll
        for (int j = 0; j < 8; ++j) { const f32x4 hv = hr[64 * j]; const u32x2 a = y0[64 * j], b = y1[64 * j];
            v[j] = (f32x4){hv.x + (bf_lo(a.x) + bf_lo(b.x)), hv.y + (bf_hi(a.x) + bf_hi(b.x)), hv.z + (bf_lo(a.y) + bf_lo(b.y)), hv.w + (bf_hi(a.y) + bf_hi(b.y))};
            ss += (v[j].x * v[j].x + v[j].y * v[j].y) + (v[j].z * v[j].z + v[j].w * v[j].w); }
        const float rstd = 1.0f / sqrtf(wave_sum(ss) * (1.f / D) + EPS);
#pragma unroll
        for (int j = 0; j < 8; ++j) { const f32x4 g = gr[64 * j]; hr[64 * j] = (f32x4){v[j].x * rstd * g.x, v[j].y * rstd * g.y, v[j].z * rstd * g.z, v[j].w * rstd * g.w}; }
    }
}

struct Args { const float* in[22]; float* out; unsigned char* ws; int lo, hi, li, pad; };
constexpr int NPHASE = 12;
}

__global__ void __launch_bounds__(512, 2) mk_fwd(mk::Args a) {
    using namespace mk;
    extern __shared__ __attribute__((aligned(16))) unsigned char lds_raw[];
    Ctx C; C.lds = (LAS uchar*)lds_raw; C.tid = threadIdx.x; C.lane = C.tid & 63; C.wave = __builtin_amdgcn_readfirstlane(C.tid >> 6); C.G = gridDim.x; C.bid = blockIdx.x;
#pragma unroll
    for (int i = 0; i < 22; ++i) C.in[i] = a.in[i];
    C.out = a.out; C.ws = a.ws;
    volatile LAS unsigned* misc = (volatile LAS unsigned*)(C.lds + LDS_MISC);
    if (C.tid < 64) misc[C.tid] = 0u;
    __syncthreads();
    XcdBarrier bar = xcd_barrier_post((unsigned*)(C.ws + WS_CTL) + CW_BAR + a.li * XCD_BAR_WORDS, misc + 8);
    const int lo = a.lo, hi = a.hi;
#define IN(k) (lo <= (k) && (k) < hi)
#define SEAM(k) do { if (IN(k) && IN((k) + 1)) xcd_barrier(bar); } while (0)
    LAS unsigned char* stage = (LAS unsigned char*)lds_raw;

    if (IN(0)) p0_prologue(C);
    SEAM(0);
    if (IN(1)) {
        pg8::Gemm g{WSP(bf16_t, WS_N1), WSP(bf16_t, WS_WINT), S, NPROJ, D}; pg8::StaticOrder so; so.init(S, NPROJ, C.G, C.bid);
        EpiProj E{WSP(bf16_t, WS_Q), WSP(bf16_t, WS_QI), WSP(bf16_t, WS_UV), WSP(bf16_t, WS_GATE), WSP(bf16_t, WS_KIDX), WSP(float, WS_CKVF), WSP(float, WS_LNS), WSP(float, WS_WIDX)};
        pg8::gemm_phase<EpiProj, pg8::StaticOrder, true, true>(stage, g, so, E);
    }
    SEAM(1);
    if (IN(2)) { p2_ckv_norm(C); p2_qabs(C); p2_gmlp(C); p2_indexer(C); }
    SEAM(2);
    if (IN(3)) p3_attention(C);
    SEAM(3);
    if (IN(4)) p3_wuv(C);
    SEAM(4);
    if (IN(5)) {
        { pg8::Gemm g{WSP(bf16_t, WS_AB), WSP(bf16_t, WS_WAT), S, D, 1024}; pg8::StaticOrder so; so.init(S, D, C.G, C.bid);
          EpiGateA E{WSP(float, WS_QABS), WSP(bf16_t, WS_GATE)};
          pg8::gemm_phase<EpiGateA, pg8::StaticOrder, true, true>(stage, g, so, E); }
        __syncthreads();
        { pg8::Gemm g{WSP(bf16_t, WS_MB), WSP(bf16_t, WS_WBT), S, D, 1024}; pg8::StaticOrder so; so.init(S, D, C.G, C.bid);
          EpiGateB E{WSP(float, WS_QABS), WSP(bf16_t, WS_GATE), WSP(bf16_t, WS_N1)};
          pg8::gemm_phase<EpiGateB, pg8::StaticOrder, true, true>(stage, g, so, E); }
    }
    SEAM(5);
    if (IN(6)) {
        pg8::Gemm g{WSP(bf16_t, WS_N1), WSP(bf16_t, WS_WOT), S, D, D}; pg8::StaticOrder so; so.init(S, D, C.G, C.bid);
        EpiRes E{C.in[I_X], C.out};
        pg8::gemm_phase<EpiRes, pg8::StaticOrder, true, true>(stage, g, so, E);
    }
    SEAM(6);
    if (IN(7)) p6_router(C);
    SEAM(7);
    if (IN(8)) p7_gather(C);
    SEAM(8);
    if (IN(9)) {
        build_tile_table(C);
        MoeOrder mo{C.G, C.bid, 4, ((const LAS int*)(C.lds + LDS_TOFF))[NE], (const LAS int*)(C.lds + LDS_T2E)};
        pg8::Gemm g{WSP(bf16_t, WS_SC), WSP(bf16_t, WS_WE1), MAXROWS, NE * 1024, D};
        EpiMoe1 E{WSP(bf16_t, WS_UV), (const float*)(C.ws + WS_ROUTE + RT_CW)};
        pg8::gemm_phase<EpiMoe1, MoeOrder, true, true>(stage, g, mo, E);
    }
    SEAM(9);
    if (IN(10)) {
        build_tile_table(C);
        MoeOrder mo{C.G, C.bid, 8, ((const LAS int*)(C.lds + LDS_TOFF))[NE], (const LAS int*)(C.lds + LDS_T2E)};
        pg8::Gemm g{WSP(bf16_t, WS_UV), WSP(bf16_t, WS_WE2), MAXROWS, NE * 2048, FF};
        EpiMoe2 E{WSP(bf16_t, WS_SC + 128 * MiB)};
        pg8::gemm_phase<EpiMoe2, MoeOrder, true, true>(stage, g, mo, E);
    }
    SEAM(10);
    if (IN(11)) p9_final(C);
#undef IN
#undef SEAM
}

#ifndef MK_SPLIT
#define MK_SPLIT 0
#endif
extern "C" void kernel_launch(void* const* d_in, const int* in_sizes, int n_in, void* d_out, int out_size, void* d_ws, size_t ws_size, hipStream_t stream) {
    using namespace mk;
    static int grid = 0;
    if (grid == 0) {
        int dev = 0, cus = 0, per_cu = 0;
        if (n_in != 22 || ws_size < WS_END) { fprintf(stderr, "kernel_launch: unexpected n_in %d / ws_size %zu (need %zu)\n", n_in, ws_size, (size_t)WS_END); }
        if (hipGetDevice(&dev) != hipSuccess || hipDeviceGetAttribute(&cus, hipDeviceAttributeMultiprocessorCount, dev) != hipSuccess) { fprintf(stderr, "kernel_launch: device query failed\n"); grid = -1; return; }
        if (hipFuncSetAttribute((const void*)mk_fwd, hipFuncAttributeMaxDynamicSharedMemorySize, LDS_BYTES) != hipSuccess) { fprintf(stderr, "kernel_launch: hipFuncSetAttribute failed\n"); grid = -1; return; }
        if (hipOccupancyMaxActiveBlocksPerMultiprocessor(&per_cu, (const void*)mk_fwd, NTHR, LDS_BYTES) != hipSuccess || per_cu < 1) fprintf(stderr, "kernel_launch: occupancy query reports %d\n", per_cu);
        (void)hipGetLastError();
        grid = cus;
    }
    if (grid < 0) return;
    (void)hipMemsetAsync((char*)d_ws + WS_CTL, 0, CTL_BYTES, stream);
    Args a{};
    for (int i = 0; i < 22; ++i) a.in[i] = (const float*)d_in[i];
    a.out = (float*)d_out; a.ws = (unsigned char*)d_ws; a.pad = 0;
#if MK_SPLIT
    for (int p = 0; p < NPHASE; ++p) { a.lo = p; a.hi = p + 1; a.li = 0; hipLaunchKernelGGL(mk_fwd, dim3(grid), dim3(NTHR), LDS_BYTES, stream, a); }
#else
    a.lo = 0; a.hi = NPHASE; a.li = 0;
    hipLaunchKernelGGL(mk_fwd, dim3(grid), dim3(NTHR), LDS_BYTES, stream, a);
#endif
}
```

```cpp
#include <hip/hip_runtime.h>
#include <cstdio>
#include <cstdint>
namespace pg8 {
#define PG8_LAS __attribute__((address_space(3)))
typedef unsigned short bf16_t;
typedef short bf16x8 __attribute__((ext_vector_type(8)));
typedef float f32x4 __attribute__((ext_vector_type(4)));
typedef unsigned u32x4 __attribute__((ext_vector_type(4)));
constexpr int BM = 256, BK = 64, HALF = 128, HTB = HALF * BK * 2  , STAGE_BYTES = 8 * HTB, NXCD = 8, WGM = 8;

__host__ __device__ __forceinline__ int lds_byte(int r, int c) { const int st = (r >> 4) * 2 + (c >> 5), rr = r & 15, cc = c & 31, ob = rr * 64 + cc * 2; return st * 1024 + (ob ^ (((ob >> 9) & 1) << 5)); }
__host__ __device__ __forceinline__ void stage_rc(int b, int& R, int& C) { const int st = b / 1024, sb = b % 1024, swz = sb ^ (((sb >> 9) & 1) << 5); R = (st >> 1) * 16 + swz / 64; C = (st & 1) * 32 + (swz % 64) / 2; }
__host__ __device__ __forceinline__ int perm32(int rho) { const int n = rho >> 4, i = rho & 15; return 8 * (i >> 2) + 4 * n + (i & 3); }

struct Unit { int pm, pn; };
struct Gemm { const bf16_t* A; const bf16_t* Bt; int M, N, K; };

struct StaticOrder {
    int nM, nN, nwg, G, c;
    __host__ __device__ void init(int M, int N, int G_, int c_) { nM = M / BM; nN = N / BM; nwg = nM * nN; G = G_; c = c_; }
    __host__ __device__ bool next(int i, Unit& u) const {
        const long L = (long)i * G + c; if (L >= nwg) return false;
        int wgid = (int)L; { const int q = nwg / NXCD, r = nwg % NXCD, xcd = wgid % NXCD, off = wgid / NXCD; wgid = (xcd < r ? xcd * (q + 1) : r * (q + 1) + (xcd - r) * q) + off; }
        const int nig = WGM * nN, gid = wgid / nig, fm = gid * WGM, gsz = (nM - fm) < WGM ? (nM - fm) : WGM;
        u.pm = fm + ((wgid % nig) % gsz); u.pn = (wgid % nig) / gsz; return true;
    }
    __device__ __forceinline__ void a_ready(const Unit&) const {}
    __device__ __forceinline__ void done(const Unit&) const {}
};

template <class Epi, class Sched, bool ALIGN_EPI = false, bool SP2 = false>
__device__ __forceinline__ void gemm_phase(PG8_LAS unsigned char* lds, const Gemm g, const Sched& S, const Epi& E) {
    const int tid = threadIdx.x, wid = __builtin_amdgcn_readfirstlane(tid >> 6), lane = tid & 63, wr = wid >> 2, wc = wid & 3, fr = lane & 15, fq = lane >> 4;
    const int K = g.K, nt = K / BK;
    unsigned voffA[2], voffB[2];
#pragma unroll
    for (int i = 0; i < 2; ++i) { int R, C; stage_rc(tid * 16 + i * 8192, R, C); const int Rb = Epi::PERM ? ((R & ~31) + perm32(R & 31)) : R;
        voffA[i] = (unsigned)(R * K + C) * 2u; voffB[i] = (unsigned)(Rb * K + C) * 2u; }
    const size_t kstep = (size_t)(BK * 2);
    const size_t hstep = (size_t)HALF * K * 2;
    const size_t tstep = 2 * hstep;
    const unsigned ldsw = (unsigned)wid * 1024u;
    const int aoff = lds_byte(wr * 64 + fr, fq * 8), boff = lds_byte(wc * 32 + fr, fq * 8);
#define PG8_SA(b, h) (((b) * 2 + (h)) * HTB)
#define PG8_SB(b, h) ((4 + (b) * 2 + (h)) * HTB)
#define PG8_STAGE(bufoff, gbase, voff) do { _Pragma("unroll") for (int _i = 0; _i < 2; ++_i) \
        __builtin_amdgcn_global_load_lds((const unsigned*)((const char*)(gbase) + (voff)[_i]), (PG8_LAS unsigned*)(lds + (bufoff) + ldsw + _i * 8192), 16, 0, 0); } while (0)
#define PG8_LDA(dst, b, h) do { _Pragma("unroll") for (int m = 0; m < 4; ++m) _Pragma("unroll") for (int k = 0; k < 2; ++k) dst[m][k] = *(const PG8_LAS bf16x8*)(lds + PG8_SA(b, h) + aoff + m * 2048 + k * 1024); } while (0)
#define PG8_LDB(dst, b, h) do { _Pragma("unroll") for (int n = 0; n < 2; ++n) _Pragma("unroll") for (int k = 0; k < 2; ++k) dst[n][k] = *(const PG8_LAS bf16x8*)(lds + PG8_SB(b, h) + boff + n * 2048 + k * 1024); } while (0)
#define PG8_MMA(ai, bj, At, Bt) do { __builtin_amdgcn_s_setprio(1); _Pragma("unroll") for (int m = 0; m < 4; ++m) _Pragma("unroll") for (int n = 0; n < 2; ++n) _Pragma("unroll") for (int k = 0; k < 2; ++k) \
        acc[ai][bj][m][n] = __builtin_amdgcn_mfma_f32_16x16x32_bf16(Bt[n][k], At[m][k], acc[ai][bj][m][n], 0, 0, 0); __builtin_amdgcn_s_setprio(0); } while (0)
#define PG8_WAIT_V(n) asm volatile("s_waitcnt vmcnt(" #n ")" ::: "memory")
#define PG8_WAIT_L(n) asm volatile("s_waitcnt lgkmcnt(" #n ")" ::: "memory")
#define PG8_BAR __builtin_amdgcn_s_barrier()
#define PG8_SCHED __builtin_amdgcn_sched_barrier(0)
    Unit cur, nxt; int ui = 0;
    if (!S.next(0, cur)) return;
    f32x4 acc[2][2][4][2];
#pragma unroll
    for (int a = 0; a < 2; ++a)
#pragma unroll
        for (int b = 0; b < 2; ++b)
#pragma unroll
            for (int m = 0; m < 4; ++m)
#pragma unroll
                for (int n = 0; n < 2; ++n) acc[a][b][m][n] = (f32x4){0.f, 0.f, 0.f, 0.f};
    bf16x8 At[4][2], B0[2][2], B1[2][2];
    const char* cA = (const char*)g.A + (size_t)cur.pm * tstep; const char* cB = (const char*)g.Bt + (size_t)cur.pn * tstep;
    S.a_ready(cur);
    if constexpr (SP2) {
        PG8_STAGE(PG8_SB(0, 0), cB, voffB); PG8_STAGE(PG8_SB(0, 1), cB + hstep, voffB); PG8_STAGE(PG8_SA(0, 0), cA, voffA); PG8_STAGE(PG8_SA(0, 1), cA + hstep, voffA);
        if (wr == 1) PG8_BAR;
        PG8_WAIT_V(2); PG8_BAR;
        PG8_STAGE(PG8_SB(1, 0), cB + kstep, voffB); PG8_STAGE(PG8_SA(1, 0), cA + kstep, voffA); PG8_STAGE(PG8_SB(1, 1), cB + hstep + kstep, voffB);
        PG8_WAIT_V(6); PG8_BAR;
    } else {
        PG8_STAGE(PG8_SB(0, 0), cB, voffB); PG8_STAGE(PG8_SA(0, 0), cA, voffA); PG8_STAGE(PG8_SB(0, 1), cB + hstep, voffB); PG8_STAGE(PG8_SA(0, 1), cA + hstep, voffA);
        if (wr == 1) PG8_BAR;
        PG8_WAIT_V(4); PG8_BAR;
        PG8_STAGE(PG8_SB(1, 0), cB + kstep, voffB); PG8_STAGE(PG8_SA(1, 0), cA + kstep, voffA); PG8_STAGE(PG8_SB(1, 1), cB + hstep + kstep, voffB);
        PG8_WAIT_V(6); PG8_BAR;
    }
    for (;;) {
        const bool has_next = S.next(ui + 1, nxt);
        const char* nA = has_next ? (const char*)g.A + (size_t)nxt.pm * tstep : cA; const char* nB = has_next ? (const char*)g.Bt + (size_t)nxt.pn * tstep : cB;
        for (int t = 0; t < nt; t += 2) {
            const bool last = (t == nt - 2);
            const char* a1 = cA + (size_t)(t + 1) * kstep;
            const char* a2 = last ? nA : cA + (size_t)(t + 2) * kstep; const char* b2 = last ? nB : cB + (size_t)(t + 2) * kstep;
            const char* a3 = a2 + kstep; const char* b3 = b2 + kstep;
            if (last && has_next) S.a_ready(nxt);
            if constexpr (SP2) {
            PG8_LDB(B0, 0, 0); PG8_LDB(B1, 0, 1); PG8_SCHED; PG8_LDA(At, 0, 0); PG8_STAGE(PG8_SA(1, 1), a1 + hstep, voffA);
            PG8_WAIT_V(8); PG8_WAIT_L(0); PG8_BAR; PG8_MMA(0, 0, At, B0); PG8_MMA(0, 1, At, B1); PG8_BAR; PG8_SCHED;
            PG8_LDA(At, 0, 1); PG8_STAGE(PG8_SB(0, 0), b2, voffB); PG8_STAGE(PG8_SB(0, 1), b2 + hstep, voffB); PG8_STAGE(PG8_SA(0, 0), a2, voffA);
            PG8_WAIT_V(8); PG8_WAIT_L(0); PG8_BAR; PG8_MMA(1, 0, At, B0); PG8_MMA(1, 1, At, B1); PG8_BAR; PG8_SCHED;
            PG8_LDB(B0, 1, 0); PG8_LDB(B1, 1, 1); PG8_SCHED; PG8_LDA(At, 1, 0); PG8_STAGE(PG8_SA(0, 1), a2 + hstep, voffA);
            PG8_WAIT_V(8); PG8_WAIT_L(0); PG8_BAR; PG8_MMA(0, 0, At, B0); PG8_MMA(0, 1, At, B1); PG8_BAR; PG8_SCHED;
            PG8_LDA(At, 1, 1); PG8_STAGE(PG8_SB(1, 0), b3, voffB); PG8_STAGE(PG8_SB(1, 1), b3 + hstep, voffB); PG8_STAGE(PG8_SA(1, 0), a3, voffA);
            PG8_WAIT_V(8); PG8_WAIT_L(0); PG8_BAR; PG8_MMA(1, 0, At, B0); PG8_MMA(1, 1, At, B1); PG8_BAR; PG8_SCHED;
            } else {
            PG8_LDB(B0, 0, 0); PG8_SCHED; PG8_LDA(At, 0, 0); PG8_STAGE(PG8_SA(1, 1), a1 + hstep, voffA);
            PG8_WAIT_L(8); PG8_BAR; PG8_WAIT_L(0); PG8_MMA(0, 0, At, B0); PG8_BAR; PG8_SCHED;
            PG8_LDB(B1, 0, 1); PG8_STAGE(PG8_SB(0, 0), b2, voffB);
            PG8_BAR; PG8_WAIT_L(0); PG8_MMA(0, 1, At, B1); PG8_BAR;
            PG8_LDA(At, 0, 1); PG8_STAGE(PG8_SA(0, 0), a2, voffA);
            PG8_BAR; PG8_WAIT_L(0); PG8_MMA(1, 0, At, B0); PG8_BAR; PG8_SCHED;
            PG8_STAGE(PG8_SB(0, 1), b2 + hstep, voffB);
            PG8_WAIT_V(6); PG8_BAR; PG8_MMA(1, 1, At, B1); PG8_BAR;
            PG8_LDB(B0, 1, 0); PG8_SCHED; PG8_LDA(At, 1, 0); PG8_STAGE(PG8_SA(0, 1), a2 + hstep, voffA);
            PG8_WAIT_L(8); PG8_BAR; PG8_WAIT_L(0); PG8_MMA(0, 0, At, B0); PG8_BAR; PG8_SCHED;
            PG8_LDB(B1, 1, 1); PG8_STAGE(PG8_SB(1, 0), b3, voffB);
            PG8_BAR; PG8_WAIT_L(0); PG8_MMA(0, 1, At, B1); PG8_BAR;
            PG8_LDA(At, 1, 1); PG8_STAGE(PG8_SA(1, 0), a3, voffA);
            PG8_BAR; PG8_WAIT_L(0); PG8_MMA(1, 0, At, B0); PG8_BAR; PG8_SCHED;
            PG8_STAGE(PG8_SB(1, 1), b3 + hstep, voffB);
            PG8_WAIT_V(6); PG8_BAR; PG8_MMA(1, 1, At, B1); PG8_BAR;
            }
        }
        if constexpr (ALIGN_EPI) { if (wr == 0) PG8_BAR; }
        if constexpr (!Epi::AFTER_DRAIN) { E(acc, cur, wr, wc, fr, fq); S.done(cur); }
        if (!has_next) break;
#pragma unroll
        for (int a = 0; a < 2; ++a)
#pragma unroll
            for (int b = 0; b < 2; ++b)
#pragma unroll
                for (int m = 0; m < 4; ++m)
#pragma unroll
                    for (int n = 0; n < 2; ++n) acc[a][b][m][n] = (f32x4){0.f, 0.f, 0.f, 0.f};
        cur = nxt; cA = nA; cB = nB; ++ui;
        if constexpr (ALIGN_EPI) { if (wr == 1) PG8_BAR; }
    }
    PG8_WAIT_V(0);
    if constexpr (!ALIGN_EPI) { if (wr == 0) PG8_BAR; }
    PG8_BAR;
    if constexpr (Epi::AFTER_DRAIN) { E.fused(acc, cur, wr, wc, fr, fq, lds, wid, lane); S.done(cur); }
#undef PG8_SA
#undef PG8_SB
#undef PG8_STAGE
#undef PG8_LDA
#undef PG8_LDB
#undef PG8_MMA
#undef PG8_WAIT_V
#undef PG8_WAIT_L
#undef PG8_BAR
#undef PG8_SCHED
}
}
#define LAS __attribute__((address_space(3)))
#define XB_TMO      128
#define XB_XCNT(j)  (256  + 64 * (j))
#define XB_XSUB(j)  (1280 + 64 * (j))
#define XB_XGEN(j)  (2304 + 64 * (j))
#define XB_TOP      3328
#define XB_TOPGEN   3392
#define XCD_BAR_WORDS 3456
#define XB_SPIN_CAP (1u << 22)

__device__ __forceinline__ unsigned xb_ld(unsigned* p)              { return __hip_atomic_load(p, __ATOMIC_RELAXED, __HIP_MEMORY_SCOPE_AGENT); }
__device__ __forceinline__ unsigned xb_add(unsigned* p, unsigned v) { return __hip_atomic_fetch_add(p, v, __ATOMIC_RELAXED, __HIP_MEMORY_SCOPE_AGENT); }
__device__ __forceinline__ unsigned xb_xcc_id() { return (unsigned)__builtin_amdgcn_s_getreg((3 << 11) | 20) & 0xFu; }
#define XB_SPIN(cond, bar) do { unsigned _sp = 0; while (cond) { __builtin_amdgcn_s_sleep(1); \
    if ((++_sp & 255u) == 0u) { if (xb_ld(&(bar)[XB_TMO])) break; if (_sp > XB_SPIN_CAP) { atomicAdd(&(bar)[XB_TMO], 1u); break; } } } } while (0)

struct XcdBarrier {
    unsigned* bar; unsigned x;
    volatile LAS unsigned* st;
};

__device__ __forceinline__ XcdBarrier xcd_barrier_post(unsigned* bar, volatile LAS unsigned* st) {
    XcdBarrier b; b.bar = bar; b.x = xb_xcc_id(); b.st = st;
    if (threadIdx.x == 0) (void)xb_add(&bar[XB_XCNT(b.x)], 1u);
    return b;
}
__device__ __forceinline__ void xcd_barrier_complete(unsigned* bar, unsigned x, unsigned& nloc, unsigned& nx) {
    const unsigned G = gridDim.x * gridDim.y * gridDim.z;
    unsigned sum, cnt, mine, sp = 0u;
    for (;;) {
        sum = 0u; cnt = 0u; mine = 0u;
#pragma unroll
        for (unsigned j = 0; j < 16; ++j) { const unsigned c = xb_ld(&bar[XB_XCNT(j)]); sum += c; cnt += (c > 0u) ? 1u : 0u; mine = (j == x) ? c : mine; }
        if (sum == G) break;
        __builtin_amdgcn_s_sleep(1);
        if ((++sp & 255u) == 0u) { if (xb_ld(&bar[XB_TMO])) break; if (sp > XB_SPIN_CAP) { atomicAdd(&bar[XB_TMO], 1u); break; } }
    }
    nloc = mine > 0u ? mine : 1u; nx = cnt > 0u ? cnt : 1u;
}

__device__ __forceinline__ void xcd_barrier(const XcdBarrier& b) {
    asm volatile("s_waitcnt vmcnt(0)" ::: "memory");
    __syncthreads();
    if (threadIdx.x == 0) {
        unsigned* bar = b.bar;
        __builtin_amdgcn_s_waitcnt(0);
        unsigned nloc = b.st[0], nx = b.st[1];
        if (nloc == 0u) { xcd_barrier_complete(bar, b.x, nloc, nx); b.st[0] = nloc; b.st[1] = nx; }
        const unsigned old = xb_add(&bar[XB_XSUB(b.x)], 1u);
        const unsigned gen = old / nloc;
        if (old + 1u == (gen + 1u) * nloc) {
            __builtin_amdgcn_fence(__ATOMIC_RELEASE, "agent");
            asm volatile("s_waitcnt vmcnt(0)" ::: "memory");
            const unsigned og = xb_add(&bar[XB_TOP], 1u);
            const unsigned tg = og / nx;
            if (og + 1u == (tg + 1u) * nx) xb_add(&bar[XB_TOPGEN], 1u);
            else XB_SPIN(xb_ld(&bar[XB_TOPGEN]) == tg, bar);
            __builtin_amdgcn_fence(__ATOMIC_ACQUIRE, "agent");
            xb_add(&bar[XB_XGEN(b.x)], 1u);
            asm volatile("s_waitcnt vmcnt(0)" ::: "memory");
        } else {
            XB_SPIN(xb_ld(&bar[XB_XGEN(b.x)]) == gen, bar);
            __builtin_amdgcn_fence(__ATOMIC_ACQUIRE, "agent");
            asm volatile("s_waitcnt vmcnt(0)" ::: "memory");
        }
    }
    __syncthreads();
}

namespace mk {
using pg8::bf16_t; using pg8::bf16x8; using pg8::f32x4; using pg8::u32x4;

#define GAS __attribute__((address_space(1)))
typedef float f32x2 __attribute__((ext_vector_type(2)));
typedef float f32x16 __attribute__((ext_vector_type(16)));
typedef unsigned u32x2 __attribute__((ext_vector_type(2)));
typedef short s16x4 __attribute__((ext_vector_type(4)));
typedef __bf16 bf16x2_t __attribute__((ext_vector_type(2)));
typedef unsigned char uchar;

constexpr int S = 8192, D = 2048, NH = 8, HD = 128, CKV = 256, IH = 16, IDM = 64, TOPK = 256;
constexpr int GW = 1024, CHUNK = 128, NGRP = 8;
constexpr int NSRC = 8528, NPROJ = 8704;
constexpr int NE = 64, FF = 512;
constexpr float EPS = 1e-6f, LOG2E = 1.4426950408889634f;
constexpr int NTHR = 512, NWAVE = 8;
constexpr int MAXROWS = 32768;

constexpr size_t MiB = 1u << 20;
constexpr size_t WS_CTL = 0, CTL_BYTES = 1 * MiB;
constexpr size_t WS_WINT = 1 * MiB, WS_WAT = 35 * MiB, WS_WBT = 39 * MiB, WS_WOT = 43 * MiB, WS_WUK = 51 * MiB, WS_WUV = 51 * MiB + 512 * 1024, WS_WSM = 52 * MiB;
constexpr size_t WS_WE1 = 53 * MiB, WS_WE2 = 309 * MiB;
constexpr size_t WS_N1 = 437 * MiB;
constexpr size_t WS_Q = 469 * MiB, WS_CKVF = 485 * MiB, WS_CKV = 493 * MiB, WS_QI = 497 * MiB, WS_KIDX = 513 * MiB, WS_WIDX = 514 * MiB;
constexpr size_t WS_UV = 515 * MiB;
constexpr size_t WS_LNS = 547 * MiB, WS_GATE = 548 * MiB;
constexpr size_t WS_QABS = 612 * MiB, WS_OB = 644 * MiB;
constexpr size_t WS_MB = 676 * MiB, WS_IDX = 692 * MiB, WS_AB = 700 * MiB, WS_ROUTE = 716 * MiB;
constexpr size_t WS_SC = 717 * MiB;
constexpr size_t WS_END = 973 * MiB;
constexpr size_t RT_EID = 0, RT_POS = 65536, RT_WGT = 131072, RT_ROW = 196608, RT_CW = 262144;
constexpr int CW_BAR = 4096, CW_CNT = 65536;

constexpr int LDS_BYTES = 155648;
constexpr int LDS_X = 131072;
constexpr int LDS_MISC = LDS_BYTES - 256;

__device__ __forceinline__ unsigned pk2(float lo, float hi) { f32x2 v = {lo, hi}; return __builtin_bit_cast(unsigned, __builtin_convertvector(v, bf16x2_t)); }
__device__ __forceinline__ float bf_lo(unsigned u) { return __uint_as_float(u << 16); }
__device__ __forceinline__ float bf_hi(unsigned u) { return __uint_as_float(u & 0xffff0000u); }
__device__ __forceinline__ float bf1(bf16_t b) { return __uint_as_float(((unsigned)b) << 16); }
__device__ __forceinline__ float wave_sum(float v) {
#pragma unroll
    for (int o = 1; o < 64; o <<= 1) v += __shfl_xor(v, o);
    return v;
}
__device__ __forceinline__ float ex2(float x) { return __builtin_amdgcn_exp2f(x); }
__device__ __forceinline__ float sigm(float x) { return __builtin_amdgcn_rcpf(1.f + ex2(-x * LOG2E)); }
__device__ __forceinline__ float gelu_t(float x) { const float u = 0.7978845608028654f * (x + 0.044715f * x * x * x); return x * __builtin_amdgcn_rcpf(1.f + ex2(-2.f * LOG2E * u)); }
__device__ __forceinline__ float silu_(float x) { return x * sigm(x); }

struct Ctx {
    LAS uchar* lds; int tid, lane, wave, G, bid;
    const float* in[22]; float* out; uchar* ws;
};
#define WSP(T, off) ((T*)(C.ws + (off)))
enum { I_X = 0, I_N1G, I_WIN, I_KVG, I_WUK, I_WUV, I_GWS, I_GBS, I_LNG, I_LNB, I_WBA, I_WBG, I_WOUT, I_N2G, I_WGRP, I_BGRP, I_WRT, I_BRT, I_WEG, I_WEU, I_WED, I_NFG };

__device__ __forceinline__ int proj_src_col(int n) {
    if (n < 2304) return n;
    if (n < 8448) return n + 80;
    if (n < 8528) return n - 8448 + 2304;
    return -1;
}
__device__ __forceinline__ void tc_item(const float* __restrict__ W, size_t ldw, int srccol, bf16_t* WT, size_t K, int dstrow0, int k0, LAS float* scr, int lane) {
#pragma unroll 8
    for (int i = 0; i < 32; ++i) { const int kk = 2 * i + (lane >> 5); scr[kk * 33 + (lane & 31)] = srccol >= 0 ? W[(size_t)(k0 + kk) * ldw + srccol] : 0.f; }
    asm volatile("s_waitcnt lgkmcnt(0)" ::: "memory");
    const int c = lane & 7;
#pragma unroll
    for (int j = 0; j < 4; ++j) { const int n = (lane >> 3) + 8 * j; const LAS float* s = scr + (8 * c) * 33 + n;
        u32x4 o; o.x = pk2(s[0 * 33], s[1 * 33]); o.y = pk2(s[2 * 33], s[3 * 33]); o.z = pk2(s[4 * 33], s[5 * 33]); o.w = pk2(s[6 * 33], s[7 * 33]);
        *(u32x4*)(WT + (size_t)(dstrow0 + n) * K + k0 + 8 * c) = o; }
    asm volatile("s_waitcnt lgkmcnt(0)" ::: "memory");
}
__device__ __forceinline__ void p0_prologue(const Ctx& C) {
    LAS float* scr = (LAS float*)(C.lds + C.wave * 16384);
    const int gw = C.bid * NWAVE + C.wave, NGW = C.G * NWAVE, lane = C.lane;
    constexpr int I_IN = (NPROJ / 32) * (D / 64);
    constexpr int I_BA = (D / 32) * (1024 / 64);
    constexpr int I_OUT = (D / 32) * (D / 64);
    constexpr int I_E1 = NE * 32 * 32;
    constexpr int I_E2 = NE * 64 * 8;
    constexpr int NITEMS = I_IN + 2 * I_BA + I_OUT + I_E1 + I_E2;
    for (int it = gw; it < NITEMS; it += NGW) {
        int r = it;
        if (r < I_IN) { const int nb = r % (NPROJ / 32), kb = r / (NPROJ / 32); tc_item(C.in[I_WIN], NSRC, proj_src_col(32 * nb + (lane & 31)), WSP(bf16_t, WS_WINT), D, 32 * nb, 64 * kb, scr, lane); continue; } r -= I_IN;
        if (r < I_BA) { const int nb = r % 64, kb = r / 64; tc_item(C.in[I_WBA], D, 32 * nb + (lane & 31), WSP(bf16_t, WS_WAT), 1024, 32 * nb, 64 * kb, scr, lane); continue; } r -= I_BA;
        if (r < I_BA) { const int nb = r % 64, kb = r / 64; tc_item(C.in[I_WBG], D, 32 * nb + (lane & 31), WSP(bf16_t, WS_WBT), 1024, 32 * nb, 64 * kb, scr, lane); continue; } r -= I_BA;
        if (r < I_OUT) { const int nb = r % 64, kb = r / 64; tc_item(C.in[I_WOUT], D, 32 * nb + (lane & 31), WSP(bf16_t, WS_WOT), D, 32 * nb, 64 * kb, scr, lane); continue; } r -= I_OUT;
        if (r < I_E1) { const int e = r / 1024, q = r % 1024, nb = q % 32, kb = q / 32, j = nb >> 3, rb = nb & 7;
            const float* src = (rb < 4 ? C.in[I_WEG] : C.in[I_WEU]) + (size_t)e * D * FF;
            tc_item(src, FF, 128 * j + 32 * (rb & 3) + (lane & 31), WSP(bf16_t, WS_WE1), D, e * 1024 + 32 * nb, 64 * kb, scr, lane); continue; } r -= I_E1;
        { const int e = r / 512, q = r % 512, nb = q % 64, kb = q / 64;
            tc_item(C.in[I_WED] + (size_t)e * FF * D, D, 32 * nb + (lane & 31), WSP(bf16_t, WS_WE2), FF, e * 2048 + 32 * nb, 64 * kb, scr, lane); }
    }
    const int gt = C.bid * NTHR + C.tid, NGT = C.G * NTHR;
    for (int i = gt; i < 262144 / 4; i += NGT) {
        const f32x4 a = ((const f32x4*)C.in[I_WUK])[i], b = ((const f32x4*)C.in[I_WUV])[i];
        u32x2 oa, ob; oa.x = pk2(a.x, a.y); oa.y = pk2(a.z, a.w); ob.x = pk2(b.x, b.y); ob.y = pk2(b.z, b.w);
        WSP(u32x2, WS_WUK)[i] = oa; WSP(u32x2, WS_WUV)[i] = ob;
    }
    for (int i = gt; i < 131072 / 4; i += NGT) {
        const f32x4 a = ((const f32x4*)C.in[I_GWS])[i]; const int e = 4 * i, s0 = e & 127, t = (e >> 7) & 127;
        u32x2 o; o.x = pk2(s0 <= t ? a.x : 0.f, s0 + 1 <= t ? a.y : 0.f); o.y = pk2(s0 + 2 <= t ? a.z : 0.f, s0 + 3 <= t ? a.w : 0.f);
        WSP(u32x2, WS_WSM)[i] = o;
    }
    for (int m = gw; m < S; m += NGW) {
        const f32x4* xr = (const f32x4*)(C.in[I_X] + (size_t)m * D) + lane; const f32x4* gr = (const f32x4*)C.in[I_N1G] + lane;
        f32x4 v[8]; float ss = 0.f;
#pragma unroll
        for (int j = 0; j < 8; ++j) { v[j] = xr[64 * j]; ss += (v[j].x * v[j].x + v[j].y * v[j].y) + (v[j].z * v[j].z + v[j].w * v[j].w); }
        const float rstd = 1.0f / sqrtf(wave_sum(ss) * (1.f / D) + EPS);
        u32x2* o = WSP(u32x2, WS_N1) + (size_t)m * (D / 4) + lane;
#pragma unroll
        for (int j = 0; j < 8; ++j) { const f32x4 g = gr[64 * j]; u32x2 w; w.x = pk2(v[j].x * rstd * g.x, v[j].y * rstd * g.y); w.y = pk2(v[j].z * rstd * g.z, v[j].w * rstd * g.w); o[64 * j] = w; }
    }
}

struct EpiProj {
    static constexpr bool PERM = true, AFTER_DRAIN = false;
    bf16_t *Q, *QI, *UV, *GATE, *KIDX; float *CKVF, *LNS, *WIDX;
    template <int ACT> __device__ __forceinline__ void st_bf16(const f32x4 (&acc)[2][2][4][2], bf16_t* base, int ld, int row0, int col0, float sc) const {
#pragma unroll
        for (int ai = 0; ai < 2; ++ai)
#pragma unroll
            for (int m = 0; m < 4; ++m) { bf16_t* rowp = base + (size_t)(row0 + ai * 128 + m * 16) * ld + col0;
#pragma unroll
                for (int bj = 0; bj < 2; ++bj) { f32x4 v0 = acc[ai][bj][m][0], v1 = acc[ai][bj][m][1];
                    if (ACT == 0) { v0 *= sc; v1 *= sc; }
                    if (ACT == 1) {
#pragma unroll
                        for (int j = 0; j < 4; ++j) { v0[j] = gelu_t(v0[j]); v1[j] = gelu_t(v1[j]); } }
                    if (ACT == 2) {
#pragma unroll
                        for (int j = 0; j < 4; ++j) { v0[j] = sigm(v0[j]); v1[j] = sigm(v1[j]); } }
                    u32x4 w; w.x = pk2(v0[0], v0[1]); w.y = pk2(v0[2], v0[3]); w.z = pk2(v1[0], v1[1]); w.w = pk2(v1[2], v1[3]);
                    *(u32x4*)(rowp + bj * 128) = w; } }
    }
    __device__ __forceinline__ void operator()(const f32x4 (&acc)[2][2][4][2], const pg8::Unit& u, int wr, int wc, int fr, int fq) const {
        const int pn = u.pn, row0 = u.pm * 256 + wr * 64 + fr, cl = wc * 32 + 8 * fq;
        if (pn < 4) st_bf16<0>(acc, Q, 1024, row0, pn * 256 + cl, 1.f);
        else if (pn == 4) {
#pragma unroll
            for (int ai = 0; ai < 2; ++ai)
#pragma unroll
                for (int m = 0; m < 4; ++m) { float* rowp = CKVF + (size_t)(row0 + ai * 128 + m * 16) * 256 + cl;
#pragma unroll
                    for (int bj = 0; bj < 2; ++bj) { *(f32x4*)(rowp + bj * 128) = acc[ai][bj][m][0]; *(f32x4*)(rowp + bj * 128 + 4) = acc[ai][bj][m][1]; } }
        }
        else if (pn < 9) st_bf16<0>(acc, QI, 1024, row0, (pn - 5) * 256 + cl, 0.125f);
        else if (pn < 13) st_bf16<1>(acc, UV, 2048, row0, (pn - 9) * 256 + cl, 1.f);
        else if (pn < 17) {
#pragma unroll
            for (int ai = 0; ai < 2; ++ai)
#pragma unroll
                for (int m = 0; m < 4; ++m) { const int row = row0 + ai * 128 + m * 16; bf16_t* rowp = UV + (size_t)row * 2048 + (pn - 9) * 256 + cl; float s = 0.f, ss = 0.f;
#pragma unroll
                    for (int bj = 0; bj < 2; ++bj) { f32x4 v0 = acc[ai][bj][m][0], v1 = acc[ai][bj][m][1];
#pragma unroll
                        for (int j = 0; j < 4; ++j) { v0[j] = gelu_t(v0[j]); v1[j] = gelu_t(v1[j]); s += v0[j] + v1[j]; ss += v0[j] * v0[j] + v1[j] * v1[j]; }
                        u32x4 w; w.x = pk2(v0[0], v0[1]); w.y = pk2(v0[2], v0[3]); w.z = pk2(v1[0], v1[1]); w.w = pk2(v1[2], v1[3]);
                        *(u32x4*)(rowp + bj * 128) = w; }
                    s += __shfl_xor(s, 16); s += __shfl_xor(s, 32); ss += __shfl_xor(ss, 16); ss += __shfl_xor(ss, 32);
                    if (fq == 0) *(f32x2*)(LNS + (size_t)row * 32 + ((pn - 13) * 4 + wc) * 2) = (f32x2){s, ss}; }
        }
        else if (pn < 33) st_bf16<2>(acc, GATE, 4096, row0, (pn - 17) * 256 + cl, 1.f);
        else {
#pragma unroll
            for (int ai = 0; ai < 2; ++ai)
#pragma unroll
                for (int m = 0; m < 4; ++m) { const int row = row0 + ai * 128 + m * 16; const f32x4 v0 = acc[ai][0][m][0], v1 = acc[ai][0][m][1];
                    if (wc < 2) { u32x4 w; w.x = pk2(v0[0], v0[1]); w.y = pk2(v0[2], v0[3]); w.z = pk2(v1[0], v1[1]); w.w = pk2(v1[2], v1[3]); *(u32x4*)(KIDX + (size_t)row * 64 + cl) = w; }
                    else if (wc == 2 && fq < 2) { float* p = WIDX + (size_t)row * 16 + 8 * fq; *(f32x4*)p = v0 * 0.25f; *(f32x4*)(p + 4) = v1 * 0.25f; } }
        }
    }
};

__device__ __forceinline__ unsigned imgb_off(unsigned row, unsigned ch) { return 256u * row + 16u * (ch ^ (((row & 3u) << 2) | ((row >> 2) & 3u))); }
__device__ __forceinline__ unsigned imgb_row16(unsigned lane, unsigned rb, unsigned s) { return imgb_off((lane & 15u) + 16u * rb, 4u * s + (lane >> 4)); }
__device__ __forceinline__ unsigned imgb_tr16(unsigned lane, unsigned c, unsigned ks, unsigned t) { const unsigned g = lane >> 4, q = (lane & 15u) >> 2, p = lane & 3u; return imgb_off(32u * ks + 8u * g + 4u * t + q, 2u * c + (p >> 1)) + 8u * (p & 1u); }
__device__ __forceinline__ bf16x8 trrd8(LAS uchar* p0, LAS uchar* p1) {
    const s16x4 b0 = __builtin_amdgcn_ds_read_tr16_b64_v4i16((LAS s16x4*)p0), b1 = __builtin_amdgcn_ds_read_tr16_b64_v4i16((LAS s16x4*)p1);
    return __builtin_shufflevector(b0, b1, 0, 1, 2, 3, 4, 5, 6, 7);
}
#define MFMA16(a, b, c) __builtin_amdgcn_mfma_f32_16x16x32_bf16((a), (b), (c), 0, 0, 0)
__device__ __forceinline__ void load_img128(LAS uchar* img, const bf16_t* src, size_t ld, int tid) {
#pragma unroll
    for (int i = 0; i < 4; ++i) { const int q = tid + NTHR * i, row = q >> 4, ch = q & 15; *(LAS u32x4*)(img + imgb_off(row, ch)) = *(const u32x4*)(src + (size_t)row * ld + ch * 8); }
}
__device__ __forceinline__ void trgemm(LAS uchar* imgA, LAS uchar* imgB, int lane, int w, f32x4 (&acc)[8]) {
#pragma unroll
    for (int ks = 0; ks < 4; ++ks) {
        const bf16x8 a = *(LAS bf16x8*)(imgA + imgb_row16(lane, w, ks));
#pragma unroll
        for (int c = 0; c < 8; ++c) { const bf16x8 b = trrd8(imgB + imgb_tr16(lane, c, ks, 0), imgB + imgb_tr16(lane, c, ks, 1)); acc[c] = MFMA16(a, b, acc[c]); }
    }
}
constexpr int STG_LD = 132;
__device__ __forceinline__ void stage_acc(LAS float* stg, const f32x4 (&acc)[8], int lane) {
    const int col = lane & 15, g = lane >> 4;
#pragma unroll
    for (int c = 0; c < 8; ++c)
#pragma unroll
        for (int r = 0; r < 4; ++r) stg[(4 * g + r) * STG_LD + 16 * c + col] = acc[c][r];
}
__device__ __forceinline__ void stage_store_bf16(LAS float* stg, const f32x4 (&acc)[8], bf16_t* orow, size_t ld, int lane) {
    stage_acc(stg, acc, lane);
#pragma unroll
    for (int i = 0; i < 4; ++i) { const int q = lane + 64 * i, row = q >> 4, ch = q & 15; const LAS float* s = stg + row * STG_LD + 8 * ch;
        u32x4 o; o.x = pk2(s[0], s[1]); o.y = pk2(s[2], s[3]); o.z = pk2(s[4], s[5]); o.w = pk2(s[6], s[7]);
        *(u32x4*)(orow + (size_t)row * ld + 8 * ch) = o; }
}
#define ZERO8(a) do { _Pragma("unroll") for (int _c = 0; _c < 8; ++_c) a[_c] = (f32x4){0.f, 0.f, 0.f, 0.f}; } while (0)

__device__ __forceinline__ void p2_ckv_norm(const Ctx& C) {
    const int gw = C.bid * NWAVE + C.wave, NGW = C.G * NWAVE, lane = C.lane;
    const f32x4 g = ((const f32x4*)C.in[I_KVG])[lane];
    for (int m = gw; m < S; m += NGW) {
        const f32x4 v = ((const f32x4*)(WSP(float, WS_CKVF) + (size_t)m * CKV))[lane];
        const float ss = wave_sum((v.x * v.x + v.y * v.y) + (v.z * v.z + v.w * v.w));
        const float rstd = 1.0f / sqrtf(ss * (1.f / CKV) + EPS);
        u32x2 o; o.x = pk2(v.x * rstd * g.x, v.y * rstd * g.y); o.y = pk2(v.z * rstd * g.z, v.w * rstd * g.w);
        (WSP(u32x2, WS_CKV) + (size_t)m * (CKV / 4))[lane] = o;
    }
}
__device__ __forceinline__ void p2_qabs(const Ctx& C) {
    LAS uchar* imgA = C.lds; LAS uchar* imgB = C.lds + 32768;
    LAS float* stg = (LAS float*)(C.lds) + C.wave * 16 * STG_LD;
    const int lane = C.lane, w = C.wave;
#pragma unroll 1
    for (int u = C.bid; u < 64 * NH * 2; u += C.G) {
        const int half = u & 1, h = (u >> 1) & 7, t0 = (u >> 4) * 128;
        __syncthreads();
        load_img128(imgA, WSP(bf16_t, WS_Q) + (size_t)t0 * 1024 + h * 128, 1024, C.tid);
        load_img128(imgB, WSP(bf16_t, WS_WUK) + (size_t)h * 128 * 256 + half * 128, 256, C.tid);
        __syncthreads();
        f32x4 acc[8]; ZERO8(acc);
        trgemm(imgA, imgB, lane, w, acc);
        __syncthreads();
        stage_store_bf16(stg, acc, WSP(bf16_t, WS_QABS) + (size_t)(t0 + 16 * w) * 2048 + h * 256 + half * 128, 2048, lane);
    }
    __syncthreads();
}
__device__ __forceinline__ void p2_gmlp(const Ctx& C) {
    LAS uchar* imgA = C.lds; LAS uchar* imgB = C.lds + 32768; LAS f32x2* stat = (LAS f32x2*)(C.lds + 65536);
    LAS float* stg = (LAS float*)(C.lds) + C.wave * 16 * STG_LD;
    const int lane = C.lane, w = C.wave, tid = C.tid;
    const bf16_t* UV = WSP(bf16_t, WS_UV);
    for (int u = C.bid; u < 64 * NGRP; u += C.G) {
        const int g = u & 7, t0 = (u >> 3) * 128;
        __syncthreads();
        if (tid < 128) { const float* p = WSP(float, WS_LNS) + (size_t)(t0 + tid) * 32; float s = 0.f, ss = 0.f;
#pragma unroll
            for (int j = 0; j < 16; ++j) { s += p[2 * j]; ss += p[2 * j + 1]; }
            const float mean = s * (1.f / GW), var = fmaxf(ss * (1.f / GW) - mean * mean, 0.f);
            stat[tid] = (f32x2){mean, 1.0f / sqrtf(var + EPS)}; }
        load_img128(imgA, WSP(bf16_t, WS_WSM) + (size_t)g * 128 * 128, 128, tid);
        __syncthreads();
#pragma unroll
        for (int i = 0; i < 4; ++i) { const int q = tid + NTHR * i, row = q >> 4, ch = q & 15; const f32x2 st = stat[row];
            const u32x4 v = *(const u32x4*)(UV + (size_t)(t0 + row) * 2048 + 1024 + g * 128 + ch * 8);
            const float* lg = C.in[I_LNG] + g * 128 + ch * 8; const float* lb = C.in[I_LNB] + g * 128 + ch * 8;
            const unsigned vv[4] = {v.x, v.y, v.z, v.w}; unsigned o[4];
#pragma unroll
            for (int j = 0; j < 4; ++j) { const float a = (bf_lo(vv[j]) - st.x) * st.y * lg[2 * j] + lb[2 * j], b = (bf_hi(vv[j]) - st.x) * st.y * lg[2 * j + 1] + lb[2 * j + 1]; o[j] = pk2(a, b); }
            *(LAS u32x4*)(imgB + imgb_off(row, ch)) = (u32x4){o[0], o[1], o[2], o[3]}; }
        __syncthreads();
        f32x4 acc[8]; ZERO8(acc);
        trgemm(imgA, imgB, lane, w, acc);
        __syncthreads();
        stage_acc(stg, acc, lane);
#pragma unroll
        for (int i = 0; i < 4; ++i) { const int q = lane + 64 * i, row = q >> 4, ch = q & 15; const LAS float* s = stg + row * STG_LD + 8 * ch;
            const int tl = 16 * w + row; const float bias = C.in[I_GBS][g * 128 + tl];
            const u32x4 uu = *(const u32x4*)(UV + (size_t)(t0 + tl) * 2048 + g * 128 + ch * 8);
            u32x4 o; o.x = pk2(bf_lo(uu.x) * (s[0] + bias), bf_hi(uu.x) * (s[1] + bias)); o.y = pk2(bf_lo(uu.y) * (s[2] + bias), bf_hi(uu.y) * (s[3] + bias));
            o.z = pk2(bf_lo(uu.z) * (s[4] + bias), bf_hi(uu.z) * (s[5] + bias)); o.w = pk2(bf_lo(uu.w) * (s[6] + bias), bf_hi(uu.w) * (s[7] + bias));
            *(u32x4*)(WSP(bf16_t, WS_MB) + (size_t)(t0 + tl) * 1024 + g * 128 + ch * 8) = o; }
    }
    __syncthreads();
}

#define MFMA32(a, b, c) __builtin_amdgcn_mfma_f32_32x32x16_bf16((a), (b), (c), 0, 0, 0)
__device__ __forceinline__ unsigned f2key(float x) { const unsigned u = __float_as_uint(x); return (u & 0x80000000u) ? ~u : (u | 0x80000000u); }
__device__ __forceinline__ int sbucket(float x) { float f = (x + 8.f) * 64.f; f = fminf(fmaxf(f, 0.f), 1023.f); return (int)f; }
__device__ __forceinline__ void lds_add(LAS unsigned* p, unsigned v) { (void)__hip_atomic_fetch_add(p, v, __ATOMIC_RELAXED, __HIP_MEMORY_SCOPE_WORKGROUP); }
__device__ __forceinline__ unsigned suffix_incl(unsigned v, int lane) {
#pragma unroll
    for (int o = 1; o < 64; o <<= 1) { const unsigned x = __shfl_down(v, o); if (lane + o < 64) v += x; }
    return v;
}
__device__ __forceinline__ void select_row_radix(const Ctx& C, int t, LAS unsigned* hist) {
    const int lane = C.lane, n = t + 1; int* out = WSP(int, WS_IDX) + (size_t)t * TOPK;
    const float* row = WSP(float, WS_SC) + (size_t)t * S;
    unsigned prefix = 0u, krem = (unsigned)TOPK;
#pragma unroll 1
    for (int pass = 0; pass < 4; ++pass) {
        const int shift = 24 - 8 * pass;
#pragma unroll
        for (int i = 0; i < 4; ++i) hist[lane + 64 * i] = 0u;
        for (int i = lane; i < n; i += 64) { const unsigned key = f2key(row[i]); if (pass == 0 || (key >> (shift + 8)) == (prefix >> (shift + 8))) lds_add(&hist[(key >> shift) & 255u], 1u); }
        unsigned h4[4]; unsigned tt = 0;
#pragma unroll
        for (int j = 0; j < 4; ++j) { h4[j] = hist[4 * lane + j]; tt += h4[j]; }
        const unsigned in2 = suffix_incl(tt, lane), ab2 = in2 - tt;
        const bool m2 = ab2 < krem && in2 >= krem;
        int d = 0; unsigned nk = 0;
        if (m2) { unsigned cum = ab2;
#pragma unroll
            for (int j = 3; j >= 0; --j) { if (nk == 0u) { if (cum + h4[j] >= krem) { d = 4 * lane + j; nk = krem - cum; } else cum += h4[j]; } } }
        const unsigned long long mk = __ballot(m2); const int src = __ffsll((long long)mk) - 1; d = __shfl(d, src); krem = __shfl(nk, src);
        prefix |= (unsigned)d << shift;
    }
    const unsigned long long lt = (1ull << lane) - 1ull;
    unsigned cnt = 0, eqc = 0;
    for (int base = 0; base < n; base += 64) { const int i = base + lane; const bool valid = i < n; const unsigned key = valid ? f2key(row[i]) : 0u;
        const bool gt = valid && key > prefix, eq = valid && key == prefix;
        const unsigned long long em = __ballot(eq); const unsigned rank = eqc + (unsigned)__popcll(em & lt);
        const bool take = gt || (eq && rank < krem);
        const unsigned long long tm = __ballot(take); const unsigned pos = cnt + (unsigned)__popcll(tm & lt);
        if (take && pos < (unsigned)TOPK) out[pos] = i;
        cnt += (unsigned)__popcll(tm); eqc += (unsigned)__popcll(em); }
}
constexpr int CAND_CAP = 256;
__device__ __forceinline__ void select_row(const Ctx& C, int t, const LAS unsigned* h, LAS unsigned* cand) {
    const int lane = C.lane, n = t + 1; int* out = WSP(int, WS_IDX) + (size_t)t * TOPK;
    if (n <= TOPK) { for (int j = lane; j < TOPK; j += 64) out[j] = j < n ? j : -1; return; }
    const float* row = WSP(float, WS_SC) + (size_t)t * S;
    unsigned wd[8]; unsigned tot = 0;
#pragma unroll
    for (int j = 0; j < 8; ++j) { wd[j] = h[8 * lane + j]; tot += (wd[j] & 0xffffu) + (wd[j] >> 16); }
    const unsigned incl = suffix_incl(tot, lane), above = incl - tot;
    const bool mine = above < (unsigned)TOPK && incl >= (unsigned)TOPK;
    int bstar = 0; unsigned krem = 0;
    if (mine) { unsigned cum = above;
#pragma unroll
        for (int b = 15; b >= 0; --b) { if (krem == 0u) { const unsigned c = (wd[b >> 1] >> (16 * (b & 1))) & 0xffffu; if (cum + c >= (unsigned)TOPK) { bstar = 16 * lane + b; krem = (unsigned)TOPK - cum; } else cum += c; } } }
    { const unsigned long long mk = __ballot(mine); const int src = __ffsll((long long)mk) - 1; bstar = __shfl(bstar, src); krem = __shfl(krem, src); }
    const unsigned ngt = (unsigned)TOPK - krem;
    const unsigned long long lt = (1ull << lane) - 1ull;
    unsigned cnt = 0, cc = 0;
    f32x4 cur = (4 * lane < n) ? *(const f32x4*)(row + 4 * lane) : (f32x4){0.f, 0.f, 0.f, 0.f};
    for (int base = 0; base < n; base += 256) {
        const int i0 = base + 4 * lane, i1 = i0 + 256;
        const f32x4 nxt = (i1 < n) ? *(const f32x4*)(row + i1) : (f32x4){0.f, 0.f, 0.f, 0.f};
#pragma unroll
        for (int j = 0; j < 4; ++j) { const bool valid = i0 + j < n; const int b = sbucket(cur[j]); const bool gt = valid && b > bstar, eq = valid && b == bstar;
            const unsigned long long m = __ballot(gt); if (gt) { const unsigned pos = cnt + (unsigned)__popcll(m & lt); if (pos < (unsigned)TOPK) out[pos] = i0 + j; } cnt += (unsigned)__popcll(m);
            const unsigned long long me = __ballot(eq); if (eq) { const unsigned p = cc + (unsigned)__popcll(me & lt); if (p < (unsigned)CAND_CAP) { cand[2 * p] = f2key(cur[j]); cand[2 * p + 1] = (unsigned)(i0 + j); } } cc += (unsigned)__popcll(me); }
        cur = nxt;
    }
    if (cc <= (unsigned)CAND_CAP) {
        for (unsigned ci = lane; ci < cc; ci += 64) { const unsigned key = cand[2 * ci], idx = cand[2 * ci + 1]; unsigned rank = 0;
            for (unsigned j = 0; j < cc; ++j) { const unsigned kj = cand[2 * j], ij = cand[2 * j + 1]; rank += (kj > key || (kj == key && ij < idx)) ? 1u : 0u; }
            if (rank < krem) out[ngt + rank] = (int)idx; }
    } else select_row_radix(C, t, cand);
}
constexpr int KT_LD = 144;
__device__ __forceinline__ void p2_indexer(const Ctx& C) {
    LAS uchar* kb = C.lds;
    LAS unsigned* hist = (LAS unsigned*)(C.lds + 36864);
    LAS unsigned* cand = (LAS unsigned*)(C.lds + 36864 + 65536) + C.wave * (2 * CAND_CAP);
    const int lane = C.lane, w = C.wave, tid = C.tid, r = lane & 31, hh = lane >> 5;
    const int tau = (r >> 2) & 1, eta = (r & 3) + 4 * (r >> 3);
    const bf16_t* QI = WSP(bf16_t, WS_QI); const bf16_t* KI = WSP(bf16_t, WS_KIDX); const float* WI = WSP(float, WS_WIDX);
    float* sc = WSP(float, WS_SC);
#pragma unroll 1
    for (int i = C.bid; i < 256; i += C.G) {
        __syncthreads();
        { LAS u32x4* hz = (LAS u32x4*)hist + tid;
#pragma unroll
          for (int j = 0; j < 8; ++j) hz[NTHR * j] = (u32x4){0u, 0u, 0u, 0u}; }
        const int tb0 = 16 * i + 2 * w, tb1 = 16 * (511 - i) + 2 * w;
        const int tmax0 = 16 * i + 15, tmax1 = 16 * (511 - i) + 15;
        bf16x8 a0[4], a1[4]; f32x4 w0[4], w1[4];
#pragma unroll
        for (int ks = 0; ks < 4; ++ks) { a0[ks] = *(const bf16x8*)(QI + (size_t)(tb0 + tau) * 1024 + eta * 64 + 16 * ks + 8 * hh); a1[ks] = *(const bf16x8*)(QI + (size_t)(tb1 + tau) * 1024 + eta * 64 + 16 * ks + 8 * hh); }
#pragma unroll
        for (int q = 0; q < 4; ++q) { w0[q] = *(const f32x4*)(WI + (size_t)(tb0 + hh) * 16 + 4 * q); w1[q] = *(const f32x4*)(WI + (size_t)(tb1 + hh) * 16 + 4 * q); }
        const int ntile = (tmax1 >> 7) + 1;
        const int kr0 = tid >> 3, kc = tid & 7;
        u32x4 pre0 = *(const u32x4*)(KI + (size_t)kr0 * 64 + kc * 8), pre1 = *(const u32x4*)(KI + (size_t)(kr0 + 64) * 64 + kc * 8);
#pragma unroll 1
        for (int kt = 0; kt < ntile; ++kt) {
            LAS uchar* buf = kb + (kt & 1) * 18432;
            *(LAS u32x4*)(buf + kr0 * KT_LD + kc * 16) = pre0; *(LAS u32x4*)(buf + (kr0 + 64) * KT_LD + kc * 16) = pre1;
            __syncthreads();
            if (kt + 1 < ntile) { const bf16_t* kp = KI + (size_t)(128 * (kt + 1)) * 64; pre0 = *(const u32x4*)(kp + (size_t)kr0 * 64 + kc * 8); pre1 = *(const u32x4*)(kp + (size_t)(kr0 + 64) * 64 + kc * 8); }
#pragma unroll 1
            for (int sub = 0; sub < 4; ++sub) {
                const int sbase = 128 * kt + 32 * sub; if (sbase > tmax1) break;
                const int s = sbase + r;
                bf16x8 b[4];
#pragma unroll
                for (int ks = 0; ks < 4; ++ks) b[ks] = *(const LAS bf16x8*)(buf + (32 * sub + r) * KT_LD + (2 * ks + hh) * 16);
                { f32x16 acc;
#pragma unroll
                  for (int q = 0; q < 16; ++q) acc[q] = 0.f;
#pragma unroll
                  for (int ks = 0; ks < 4; ++ks) acc = MFMA32(a1[ks], b[ks], acc);
                  float v = 0.f;
#pragma unroll
                  for (int q = 0; q < 16; ++q) v += w1[q >> 2][q & 3] * fmaxf(acc[q], 0.f);
                  const int t = tb1 + hh;
                  if (s <= t) { sc[(size_t)t * S + s] = v; const int bk = sbucket(v); lds_add(hist + (16 + 2 * w + hh) * 512 + (bk >> 1), 1u << (16 * (bk & 1))); } }
                if (sbase <= tmax0) { f32x16 acc;
#pragma unroll
                  for (int q = 0; q < 16; ++q) acc[q] = 0.f;
#pragma unroll
                  for (int ks = 0; ks < 4; ++ks) acc = MFMA32(a0[ks], b[ks], acc);
                  float v = 0.f;
#pragma unroll
                  for (int q = 0; q < 16; ++q) v += w0[q >> 2][q & 3] * fmaxf(acc[q], 0.f);
                  const int t = tb0 + hh;
                  if (s <= t) { sc[(size_t)t * S + s] = v; const int bk = sbucket(v); lds_add(hist + (2 * w + hh) * 512 + (bk >> 1), 1u << (16 * (bk & 1))); } }
            }
        }
        asm volatile("s_waitcnt vmcnt(0) lgkmcnt(0)" ::: "memory");
        select_row(C, tb0, hist + (2 * w) * 512, cand); select_row(C, tb0 + 1, hist + (2 * w + 1) * 512, cand);
        select_row(C, tb1, hist + (16 + 2 * w) * 512, cand); select_row(C, tb1 + 1, hist + (16 + 2 * w + 1) * 512, cand);
    }
    __syncthreads();
}

__device__ __forceinline__ void p3_attention(const Ctx& C) {
    const int lane = C.lane, w = C.wave, g = lane >> 4, h = lane & 15;
    LAS uchar* img = C.lds;
    LAS float* mx = (LAS float*)(C.lds + LDS_X);
    LAS float* ls = mx + 128;
    LAS uchar* pf = C.lds + LDS_X + 1024;
    const bf16_t* CK = WSP(bf16_t, WS_CKV);
    const float scale = 0.08838834764831845f;
    for (int t = C.bid; t < S; t += C.G) {
        const int myidx = WSP(int, WS_IDX)[(size_t)t * TOPK + 32 * w + (lane & 31)];
#pragma unroll
        for (int i = 0; i < 16; ++i) { const int rl = 2 * i + (lane >> 5); const int key = __shfl(myidx, rl); const int kk = (key < 0 || key > t) ? 0 : key; const int ch32 = lane & 31;
            const u32x4 v = *(const u32x4*)(CK + (size_t)kk * CKV + ch32 * 8);
            *(LAS u32x4*)(img + (ch32 >> 4) * 65536 + imgb_off(32 * w + rl, ch32 & 15)) = v; }
        bf16x8 bq[8]; const bf16_t* qa = WSP(bf16_t, WS_QABS) + (size_t)t * 2048 + (h & 7) * 256 + 8 * g;
#pragma unroll
        for (int kc = 0; kc < 8; ++kc) { bq[kc] = *(const bf16x8*)(qa + 32 * kc); if (h >= 8) bq[kc] = (bf16x8){0, 0, 0, 0, 0, 0, 0, 0}; }
        f32x4 x0 = {0.f, 0.f, 0.f, 0.f}, x1 = {0.f, 0.f, 0.f, 0.f};
        const unsigned rho0 = 32u * w + 8u * (h >> 2) + (h & 3);
#pragma unroll
        for (int kc = 0; kc < 8; ++kc) { const unsigned ch = (4u * kc + g) & 15u; LAS uchar* ib = img + (kc >> 2) * 65536;
            const bf16x8 a0 = *(LAS bf16x8*)(ib + imgb_off(rho0, ch)), a1 = *(LAS bf16x8*)(ib + imgb_off(rho0 + 4u, ch));
            x0 = MFMA16(a0, bq[kc], x0); x1 = MFMA16(a1, bq[kc], x1); }
        float lg[8]; float m = -1e30f;
#pragma unroll
        for (int r = 0; r < 4; ++r) { const int k0 = __shfl(myidx, 8 * g + r), k1 = __shfl(myidx, 8 * g + 4 + r); const bool v0 = k0 >= 0 && k0 <= t, v1 = k1 >= 0 && k1 <= t;
            lg[r] = v0 ? x0[r] * scale : -1e30f; lg[4 + r] = v1 ? x1[r] * scale : -1e30f; m = fmaxf(m, fmaxf(lg[r], lg[4 + r])); }
        m = fmaxf(m, __shfl_xor(m, 16)); m = fmaxf(m, __shfl_xor(m, 32));
        if (g == 0) mx[w * 16 + h] = m;
        __syncthreads();
        float M = mx[h];
#pragma unroll
        for (int ww = 1; ww < 8; ++ww) M = fmaxf(M, mx[ww * 16 + h]);
        float p[8], sum = 0.f;
#pragma unroll
        for (int j = 0; j < 8; ++j) { p[j] = ex2((lg[j] - M) * LOG2E); sum += p[j]; }
        sum += __shfl_xor(sum, 16); sum += __shfl_xor(sum, 32);
        if (g == 0) ls[w * 16 + h] = sum;
        { u32x4 pk; pk.x = pk2(p[0], p[1]); pk.y = pk2(p[2], p[3]); pk.z = pk2(p[4], p[5]); pk.w = pk2(p[6], p[7]); *(LAS u32x4*)(pf + (w * 64 + lane) * 16) = pk; }
        __syncthreads();
        float L = ls[h];
#pragma unroll
        for (int ww = 1; ww < 8; ++ww) L += ls[ww * 16 + h];
        f32x4 z0 = {0.f, 0.f, 0.f, 0.f}, z1 = {0.f, 0.f, 0.f, 0.f};
#pragma unroll
        for (int ks = 0; ks < 8; ++ks) { const bf16x8 a = *(LAS bf16x8*)(pf + (ks * 64 + lane) * 16);
            { const unsigned cc = 2u * w; LAS uchar* ib = img + (cc >> 3) * 65536; const bf16x8 b = trrd8(ib + imgb_tr16(lane, cc & 7u, ks, 0), ib + imgb_tr16(lane, cc & 7u, ks, 1)); z0 = MFMA16(a, b, z0); }
            { const unsigned cc = 2u * w + 1u; LAS uchar* ib = img + (cc >> 3) * 65536; const bf16x8 b = trrd8(ib + imgb_tr16(lane, cc & 7u, ks, 0), ib + imgb_tr16(lane, cc & 7u, ks, 1)); z1 = MFMA16(a, b, z1); } }
        float rl[4];
#pragma unroll
        for (int r = 0; r < 4; ++r) rl[r] = 1.0f / __shfl(L, (4 * g + r) & 15);
        if (g < 2) { bf16_t* o = WSP(bf16_t, WS_OB) + (size_t)t * 2048 + 32 * w + h;
#pragma unroll
            for (int r = 0; r < 4; ++r) { o[(4 * g + r) * 256] = (bf16_t)(pk2(z0[r] * rl[r], 0.f) & 0xffffu); o[(4 * g + r) * 256 + 16] = (bf16_t)(pk2(z1[r] * rl[r], 0.f) & 0xffffu); } }
        __syncthreads();
    }
}
__device__ __forceinline__ void p3_wuv(const Ctx& C) {
    LAS uchar* imgA0 = C.lds; LAS uchar* imgA1 = C.lds + 32768; LAS uchar* imgB0 = C.lds + 65536; LAS uchar* imgB1 = C.lds + 98304;
    LAS float* stg = (LAS float*)(C.lds) + C.wave * 16 * STG_LD;
    const int lane = C.lane, w = C.wave;
    for (int u = C.bid; u < 64 * NH; u += C.G) {
        const int h = u & 7, t0 = (u >> 3) * 128;
        __syncthreads();
        load_img128(imgA0, WSP(bf16_t, WS_OB) + (size_t)t0 * 2048 + h * 256, 2048, C.tid);
        load_img128(imgA1, WSP(bf16_t, WS_OB) + (size_t)t0 * 2048 + h * 256 + 128, 2048, C.tid);
        load_img128(imgB0, WSP(bf16_t, WS_WUV) + (size_t)h * 256 * 128, 128, C.tid);
        load_img128(imgB1, WSP(bf16_t, WS_WUV) + (size_t)h * 256 * 128 + 128 * 128, 128, C.tid);
        __syncthreads();
        f32x4 acc[8]; ZERO8(acc);
        trgemm(imgA0, imgB0, lane, w, acc); trgemm(imgA1, imgB1, lane, w, acc);
        __syncthreads();
        stage_store_bf16(stg, acc, WSP(bf16_t, WS_AB) + (size_t)(t0 + 16 * w) * 1024 + h * 128, 1024, lane);
    }
    __syncthreads();
}

struct EpiGateA {
    static constexpr bool PERM = true, AFTER_DRAIN = false;
    float* TMP; const bf16_t* GATE;
    __device__ __forceinline__ void operator()(const f32x4 (&acc)[2][2][4][2], const pg8::Unit& u, int wr, int wc, int fr, int fq) const {
        const int row0 = u.pm * 256 + wr * 64 + fr, col0 = u.pn * 256 + wc * 32 + 8 * fq;
#pragma unroll
        for (int ai = 0; ai < 2; ++ai)
#pragma unroll
            for (int m = 0; m < 4; ++m) { const size_t row = (size_t)(row0 + ai * 128 + m * 16);
#pragma unroll
                for (int bj = 0; bj < 2; ++bj) { const u32x4 gv = *(const u32x4*)(GATE + row * 4096 + col0 + bj * 128); const f32x4 v0 = acc[ai][bj][m][0], v1 = acc[ai][bj][m][1];
                    float* p = TMP + row * D + col0 + bj * 128;
                    *(f32x4*)p = (f32x4){v0[0] * bf_lo(gv.x), v0[1] * bf_hi(gv.x), v0[2] * bf_lo(gv.y), v0[3] * bf_hi(gv.y)};
                    *(f32x4*)(p + 4) = (f32x4){v1[0] * bf_lo(gv.z), v1[1] * bf_hi(gv.z), v1[2] * bf_lo(gv.w), v1[3] * bf_hi(gv.w)}; } }
    }
};
struct EpiGateB {
    static constexpr bool PERM = true, AFTER_DRAIN = false;
    const float* TMP; const bf16_t* GATE; bf16_t* MG;
    __device__ __forceinline__ void operator()(const f32x4 (&acc)[2][2][4][2], const pg8::Unit& u, int wr, int wc, int fr, int fq) const {
        const int row0 = u.pm * 256 + wr * 64 + fr, col0 = u.pn * 256 + wc * 32 + 8 * fq;
#pragma unroll
        for (int ai = 0; ai < 2; ++ai)
#pragma unroll
            for (int m = 0; m < 4; ++m) { const size_t row = (size_t)(row0 + ai * 128 + m * 16);
#pragma unroll
                for (int bj = 0; bj < 2; ++bj) { const u32x4 gv = *(const u32x4*)(GATE + row * 4096 + 2048 + col0 + bj * 128); const f32x4 v0 = acc[ai][bj][m][0], v1 = acc[ai][bj][m][1];
                    const float* p = TMP + row * D + col0 + bj * 128; const f32x4 t0 = *(const f32x4*)p, t1 = *(const f32x4*)(p + 4);
                    u32x4 w; w.x = pk2(t0[0] + v0[0] * bf_lo(gv.x), t0[1] + v0[1] * bf_hi(gv.x)); w.y = pk2(t0[2] + v0[2] * bf_lo(gv.y), t0[3] + v0[3] * bf_hi(gv.y));
                    w.z = pk2(t1[0] + v1[0] * bf_lo(gv.z), t1[1] + v1[1] * bf_hi(gv.z)); w.w = pk2(t1[2] + v1[2] * bf_lo(gv.w), t1[3] + v1[3] * bf_hi(gv.w));
                    *(u32x4*)(MG + row * D + col0 + bj * 128) = w; } }
    }
};
struct EpiRes {
    static constexpr bool PERM = false, AFTER_DRAIN = false;
    const float* X; float* H;
    __device__ __forceinline__ void operator()(const f32x4 (&acc)[2][2][4][2], const pg8::Unit& u, int wr, int wc, int fr, int fq) const {
        const int row0 = u.pm * 256 + wr * 64 + fr, col0 = u.pn * 256 + wc * 32 + 4 * fq;
#pragma unroll
        for (int ai = 0; ai < 2; ++ai)
#pragma unroll
            for (int m = 0; m < 4; ++m) { const size_t off = (size_t)(row0 + ai * 128 + m * 16) * D + col0;
#pragma unroll
                for (int bj = 0; bj < 2; ++bj)
#pragma unroll
                    for (int n = 0; n < 2; ++n) *(f32x4*)(H + off + bj * 128 + n * 16) = *(const f32x4*)(X + off + bj * 128 + n * 16) + acc[ai][bj][m][n]; }
    }
};
struct MoeOrder {
    int G, c, ntn, ntiles; const LAS int* tile2e;
    __device__ __forceinline__ bool next(int i, pg8::Unit& u) const { const int L = i * G + c; if (L >= ntiles * ntn) return false; const int tile = L / ntn, j = L - tile * ntn; u.pm = tile; u.pn = tile2e[tile] * ntn + j; return true; }
    __device__ __forceinline__ void a_ready(const pg8::Unit&) const {}
    __device__ __forceinline__ void done(const pg8::Unit&) const {}
};
struct EpiMoe1 {
    static constexpr bool PERM = true, AFTER_DRAIN = false;
    bf16_t* HID; const float* CW;
    __device__ __forceinline__ void operator()(const f32x4 (&acc)[2][2][4][2], const pg8::Unit& u, int wr, int wc, int fr, int fq) const {
        const int row0 = u.pm * 256 + wr * 64 + fr, col0 = (u.pn & 3) * 128 + wc * 32 + 8 * fq;
#pragma unroll
        for (int ai = 0; ai < 2; ++ai)
#pragma unroll
            for (int m = 0; m < 4; ++m) { const size_t row = (size_t)(row0 + ai * 128 + m * 16); const float cw = CW[row];
                const f32x4 g0 = acc[ai][0][m][0], g1 = acc[ai][0][m][1], u0 = acc[ai][1][m][0], u1 = acc[ai][1][m][1];
                u32x4 w; w.x = pk2(silu_(g0[0]) * u0[0] * cw, silu_(g0[1]) * u0[1] * cw); w.y = pk2(silu_(g0[2]) * u0[2] * cw, silu_(g0[3]) * u0[3] * cw);
                w.z = pk2(silu_(g1[0]) * u1[0] * cw, silu_(g1[1]) * u1[1] * cw); w.w = pk2(silu_(g1[2]) * u1[2] * cw, silu_(g1[3]) * u1[3] * cw);
                *(u32x4*)(HID + row * FF + col0) = w; }
    }
};
struct EpiMoe2 {
    static constexpr bool PERM = true, AFTER_DRAIN = false;
    bf16_t* YS;
    __device__ __forceinline__ void operator()(const f32x4 (&acc)[2][2][4][2], const pg8::Unit& u, int wr, int wc, int fr, int fq) const {
        const int row0 = u.pm * 256 + wr * 64 + fr, col0 = (u.pn & 7) * 256 + wc * 32 + 8 * fq;
#pragma unroll
        for (int ai = 0; ai < 2; ++ai)
#pragma unroll
            for (int m = 0; m < 4; ++m) { bf16_t* rowp = YS + (size_t)(row0 + ai * 128 + m * 16) * D + col0;
#pragma unroll
                for (int bj = 0; bj < 2; ++bj) { const f32x4 v0 = acc[ai][bj][m][0], v1 = acc[ai][bj][m][1];
                    u32x4 w; w.x = pk2(v0[0], v0[1]); w.y = pk2(v0[2], v0[3]); w.z = pk2(v1[0], v1[1]); w.w = pk2(v1[2], v1[3]); *(u32x4*)(rowp + bj * 128) = w; } }
    }
};
constexpr int LDS_TOFF = LDS_X + 8192, LDS_T2E = LDS_X + 8192 + 512;
__device__ __forceinline__ void build_tile_table(const Ctx& C) {
    LAS int* toff = (LAS int*)(C.lds + LDS_TOFF); LAS int* t2e = (LAS int*)(C.lds + LDS_T2E);
    const unsigned* cnt = WSP(unsigned, WS_CTL) + CW_CNT;
    __syncthreads();
    if (C.tid == 0) { int acc = 0; for (int e = 0; e < NE; ++e) { toff[e] = acc; const int nt = (int)((cnt[e] + 255u) >> 8); for (int i = 0; i < nt && acc + i < 128; ++i) t2e[acc + i] = e; acc += nt; } toff[NE] = acc; }
    __syncthreads();
}
constexpr int XS_LD = 2052;
__device__ __forceinline__ void p6_router(const Ctx& C) {
    LAS float* xs = (LAS float*)C.lds;
    LAS float* lgt = (LAS float*)(C.lds + LDS_X + 1024);
    const int lane = C.lane, w = C.wave, tid = C.tid;
    const float* H = C.out; const float* WG = C.in[I_WGRP]; const float* WR = C.in[I_WRT];
    unsigned* cnt = WSP(unsigned, WS_CTL) + CW_CNT;
    for (int u = C.bid; u < S / 16; u += C.G) {
        const int t0 = 16 * u;
        __syncthreads();
#pragma unroll 1
        for (int rr = 0; rr < 2; ++rr) { const int row = 2 * w + rr, t = t0 + row;
            const f32x4* hr = (const f32x4*)(H + (size_t)t * D) + lane; const f32x4* gr = (const f32x4*)C.in[I_N2G] + lane;
            f32x4 v[8]; float ss = 0.f;
#pragma unroll
            for (int j = 0; j < 8; ++j) { v[j] = hr[64 * j]; ss += (v[j].x * v[j].x + v[j].y * v[j].y) + (v[j].z * v[j].z + v[j].w * v[j].w); }
            const float rstd = 1.0f / sqrtf(wave_sum(ss) * (1.f / D) + EPS);
            u32x2* o = WSP(u32x2, WS_N1) + (size_t)t * (D / 4) + lane;
#pragma unroll
            for (int j = 0; j < 8; ++j) { const f32x4 g = gr[64 * j]; const f32x4 n = {v[j].x * rstd * g.x, v[j].y * rstd * g.y, v[j].z * rstd * g.z, v[j].w * rstd * g.w};
                u32x2 ww; ww.x = pk2(n.x, n.y); ww.y = pk2(n.z, n.w); o[64 * j] = ww;
                *(LAS f32x4*)(xs + row * XS_LD + 4 * (64 * j + lane)) = n; } }
        __syncthreads();
        if (w < 5) {
            f32x4 acc = {0.f, 0.f, 0.f, 0.f}; const int c = lane & 15, kq = lane >> 4;
            const LAS float* ap = xs + c * XS_LD + kq;
            const float* bp = (w == 0) ? WG + (size_t)kq * 8 + (c & 7) : WR + (size_t)kq * 64 + (w - 1) * 16 + c;
            const size_t bstep = (w == 0) ? 32 : 256;
            const bool bz = (w == 0) && c >= 8;
#pragma unroll 8
            for (int k0 = 0; k0 < D; k0 += 4) { float b = bp[(size_t)(k0 >> 2) * bstep]; if (bz) b = 0.f; acc = __builtin_amdgcn_mfma_f32_16x16x4f32(ap[k0], b, acc, 0, 0, 0); }
#pragma unroll
            for (int i = 0; i < 4; ++i) lgt[(4 * kq + i) * 80 + 16 * w + c] = acc[i];
        }
        __syncthreads();
        if (tid < 16) { const int t = t0 + tid; const LAS float* l = lgt + tid * 80;
            int gi = 0; float gm = l[0] + C.in[I_BGRP][0];
#pragma unroll
            for (int i = 1; i < 8; ++i) { const float v = l[i] + C.in[I_BGRP][i]; if (v > gm) { gm = v; gi = i; } }
            float den = 0.f;
#pragma unroll
            for (int i = 0; i < 8; ++i) den += __expf(l[i] + C.in[I_BGRP][i] - gm);
            const float gval = 1.0f / den;
            const LAS float* el = l + 16 + 8 * gi; const float* be = C.in[I_BRT] + 8 * gi;
            int i0 = 0; float v0 = el[0] + be[0];
#pragma unroll
            for (int i = 1; i < 8; ++i) { const float v = el[i] + be[i]; if (v > v0) { v0 = v; i0 = i; } }
            int i1 = -1; float v1 = -3.0e38f;
#pragma unroll
            for (int i = 0; i < 8; ++i) { const float v = el[i] + be[i]; if (i != i0 && v > v1) { v1 = v; i1 = i; } }
            const float q0 = 1.0f / (1.0f + __expf(v1 - v0)), q1 = 1.0f - q0;
            const int e0 = 8 * gi + i0, e1 = 8 * gi + i1;
            const int p0 = (int)atomicAdd(cnt + e0, 1u), p1 = (int)atomicAdd(cnt + e1, 1u);
            int* eid = (int*)(C.ws + WS_ROUTE + RT_EID) + 2 * t; int* pos = (int*)(C.ws + WS_ROUTE + RT_POS) + 2 * t; float* wg = (float*)(C.ws + WS_ROUTE + RT_WGT) + 2 * t;
            eid[0] = e0; eid[1] = e1; pos[0] = p0; pos[1] = p1; wg[0] = gval * q0; wg[1] = gval * q1; }
    }
    __syncthreads();
}
__device__ __forceinline__ void p7_gather(const Ctx& C) {
    build_tile_table(C);
    const LAS int* toff = (const LAS int*)(C.lds + LDS_TOFF);
    const int gw = C.bid * NWAVE + C.wave, NGW = C.G * NWAVE, lane = C.lane;
    for (int t = gw; t < S; t += NGW) {
        const u32x4* src = WSP(u32x4, WS_N1) + (size_t)t * (D / 8) + lane;
        u32x4 v[4];
#pragma unroll
        for (int j = 0; j < 4; ++j) v[j] = src[64 * j];
#pragma unroll
        for (int sl = 0; sl < 2; ++sl) {
            const int e = ((const int*)(C.ws + WS_ROUTE + RT_EID))[2 * t + sl], p = ((const int*)(C.ws + WS_ROUTE + RT_POS))[2 * t + sl];
            const int r = toff[e] * 256 + p;
            u32x4* dst = WSP(u32x4, WS_SC) + (size_t)r * (D / 8) + lane;
#pragma unroll
            for (int j = 0; j < 4; ++j) dst[64 * j] = v[j];
            if (lane == 0) { ((float*)(C.ws + WS_ROUTE + RT_CW))[r] = ((const float*)(C.ws + WS_ROUTE + RT_WGT))[2 * t + sl]; ((int*)(C.ws + WS_ROUTE + RT_ROW))[2 * t + sl] = r; }
        }
    }
}
__device__ __forceinline__ void p9_final(const Ctx& C) {
    const int gw = C.bid * NWAVE + C.wave, NGW = C.G * NWAVE, lane = C.lane;
    const bf16_t* YS = WSP(bf16_t, WS_SC + 128 * MiB);
    for (int t = gw; t < S; t += NGW) {
        const int r0 = ((const int*)(C.ws + WS_ROUTE + RT_ROW))[2 * t], r1 = ((const int*)(C.ws + WS_ROUTE + RT_ROW))[2 * t + 1];
        f32x4* hr = (f32x4*)(C.out + (size_t)t * D) + lane; const f32x4* gr = (const f32x4*)C.in[I_NFG] + lane;
        const u32x2* y0 = (const u32x2*)(YS + (size_t)r0 * D) + lane; const u32x2* y1 = (const u32x2*)(YS + (size_t)r1 * D) + lane;
        f32x4 v[8]; float ss = 0.f;
#pragma unroll
        for (int j = 0; j < 8; ++j) { const f32x4 hv = hr[64 * j]; const u32x2 a = y0[64 * j], b = y1[64 * j];
            v[j] = (f32x4){hv.x + (bf_lo(a.x) + bf_lo(b.x)), hv.y + (bf_hi(a.x) + bf_hi(b.x)), hv.z + (bf_lo(a.y) + bf_lo(b.y)), hv.w + (bf_hi(a.y) + bf_hi(b.y))};
            ss += (v[j].x * v[j].x + v[j].y * v[j].y) + (v[j].z * v[j].z + v[j].w * v[j].w); }
        const float rstd = 1.0f / sqrtf(wave_sum(ss) * (1.f / D) + EPS);
#pragma unroll
        for (int j = 0; j < 8; ++j) { const f32x4 g = gr[64 * j]; hr[64 * j] = (f32x4){v[j].x * rstd * g.x, v[j].y * rstd * g.y, v[j].z * rstd * g.z, v[j].w * rstd * g.w}; }
    }
}

#ifndef MK_PROBE
#define MK_PROBE 0
#endif
struct Args { const float* in[22]; float* out; unsigned char* ws; int lo, hi, li, pad; };
constexpr int NPHASE = 12;
}

__global__ void __launch_bounds__(512, 2) mk_fwd(mk::Args a) {
    using namespace mk;
    extern __shared__ __attribute__((aligned(16))) unsigned char lds_raw[];
    Ctx C; C.lds = (LAS uchar*)lds_raw; C.tid = threadIdx.x; C.lane = C.tid & 63; C.wave = __builtin_amdgcn_readfirstlane(C.tid >> 6); C.G = gridDim.x; C.bid = blockIdx.x;
#pragma unroll
    for (int i = 0; i < 22; ++i) C.in[i] = a.in[i];
    C.out = a.out; C.ws = a.ws;
    volatile LAS unsigned* misc = (volatile LAS unsigned*)(C.lds + LDS_MISC);
    if (C.tid < 64) misc[C.tid] = 0u;
    __syncthreads();
    XcdBarrier bar = xcd_barrier_post((unsigned*)(C.ws + WS_CTL) + CW_BAR + a.li * XCD_BAR_WORDS, misc + 8);
    const int lo = a.lo, hi = a.hi;
#define IN(k) (lo <= (k) && (k) < hi)
#define SEAM(k) do { if (IN(k) && IN((k) + 1)) xcd_barrier(bar); } while (0)
    LAS unsigned char* stage = (LAS unsigned char*)lds_raw;

    if (IN(0)) { p0_prologue(C);
#if MK_PROBE == 1
        p0_prologue(C);
#endif
    }
    SEAM(0);
    if (IN(1)) {
        pg8::Gemm g{WSP(bf16_t, WS_N1), WSP(bf16_t, WS_WINT), S, NPROJ, D}; pg8::StaticOrder so; so.init(S, NPROJ, C.G, C.bid);
        EpiProj E{WSP(bf16_t, WS_Q), WSP(bf16_t, WS_QI), WSP(bf16_t, WS_UV), WSP(bf16_t, WS_GATE), WSP(bf16_t, WS_KIDX), WSP(float, WS_CKVF), WSP(float, WS_LNS), WSP(float, WS_WIDX)};
        pg8::gemm_phase<EpiProj, pg8::StaticOrder, true, true>(stage, g, so, E);
    }
    SEAM(1);
    if (IN(2)) { p2_ckv_norm(C); p2_qabs(C); p2_gmlp(C); p2_indexer(C);
#if MK_PROBE == 2
        p2_indexer(C);
#endif
#if MK_PROBE == 4
        p2_ckv_norm(C); p2_qabs(C); p2_gmlp(C);
#endif
    }
    SEAM(2);
    if (IN(3)) { p3_attention(C);
#if MK_PROBE == 3
        p3_attention(C);
#endif
    }
    SEAM(3);
    if (IN(4)) p3_wuv(C);
    SEAM(4);
    if (IN(5)) {
        { pg8::Gemm g{WSP(bf16_t, WS_AB), WSP(bf16_t, WS_WAT), S, D, 1024}; pg8::StaticOrder so; so.init(S, D, C.G, C.bid);
          EpiGateA E{WSP(float, WS_QABS), WSP(bf16_t, WS_GATE)};
          pg8::gemm_phase<EpiGateA, pg8::StaticOrder, true, true>(stage, g, so, E); }
        __syncthreads();
        { pg8::Gemm g{WSP(bf16_t, WS_MB), WSP(bf16_t, WS_WBT), S, D, 1024}; pg8::StaticOrder so; so.init(S, D, C.G, C.bid);
          EpiGateB E{WSP(float, WS_QABS), WSP(bf16_t, WS_GATE), WSP(bf16_t, WS_N1)};
          pg8::gemm_phase<EpiGateB, pg8::StaticOrder, true, true>(stage, g, so, E); }
    }
    SEAM(5);
    if (IN(6)) {
        pg8::Gemm g{WSP(bf16_t, WS_N1), WSP(bf16_t, WS_WOT), S, D, D}; pg8::StaticOrder so; so.init(S, D, C.G, C.bid);
        EpiRes E{C.in[I_X], C.out};
        pg8::gemm_phase<EpiRes, pg8::StaticOrder, true, true>(stage, g, so, E);
    }
    SEAM(6);
    if (IN(7)) p6_router(C);
    SEAM(7);
    if (IN(8)) p7_gather(C);
    SEAM(8);
    if (IN(9)) {
        build_tile_table(C);
        MoeOrder mo{C.G, C.bid, 4, ((const LAS int*)(C.lds + LDS_TOFF))[NE], (const LAS int*)(C.lds + LDS_T2E)};
        pg8::Gemm g{WSP(bf16_t, WS_SC), WSP(bf16_t, WS_WE1), MAXROWS, NE * 1024, D};
        EpiMoe1 E{WSP(bf16_t, WS_UV), (const float*)(C.ws + WS_ROUTE + RT_CW)};
        pg8::gemm_phase<EpiMoe1, MoeOrder, true, true>(stage, g, mo, E);
    }
    SEAM(9);
    if (IN(10)) {
        build_tile_table(C);
        MoeOrder mo{C.G, C.bid, 8, ((const LAS int*)(C.lds + LDS_TOFF))[NE], (const LAS int*)(C.lds + LDS_T2E)};
        pg8::Gemm g{WSP(bf16_t, WS_UV), WSP(bf16_t, WS_WE2), MAXROWS, NE * 2048, FF};
        EpiMoe2 E{WSP(bf16_t, WS_SC + 128 * MiB)};
        pg8::gemm_phase<EpiMoe2, MoeOrder, true, true>(stage, g, mo, E);
    }
    SEAM(10);
    if (IN(11)) p9_final(C);
#undef IN
#undef SEAM
}

#ifndef MK_SPLIT
#define MK_SPLIT 0
#endif
extern "C" void kernel_launch(void* const* d_in, const int* in_sizes, int n_in, void* d_out, int out_size, void* d_ws, size_t ws_size, hipStream_t stream) {
    using namespace mk;
    static int grid = 0;
    if (grid == 0) {
        int dev = 0, cus = 0, per_cu = 0;
        if (n_in != 22 || ws_size < WS_END) { fprintf(stderr, "kernel_launch: unexpected n_in %d / ws_size %zu (need %zu)\n", n_in, ws_size, (size_t)WS_END); }
        if (hipGetDevice(&dev) != hipSuccess || hipDeviceGetAttribute(&cus, hipDeviceAttributeMultiprocessorCount, dev) != hipSuccess) { fprintf(stderr, "kernel_launch: device query failed\n"); grid = -1; return; }
        if (hipFuncSetAttribute((const void*)mk_fwd, hipFuncAttributeMaxDynamicSharedMemorySize, LDS_BYTES) != hipSuccess) { fprintf(stderr, "kernel_launch: hipFuncSetAttribute failed\n"); grid = -1; return; }
        if (hipOccupancyMaxActiveBlocksPerMultiprocessor(&per_cu, (const void*)mk_fwd, NTHR, LDS_BYTES) != hipSuccess || per_cu < 1) fprintf(stderr, "kernel_launch: occupancy query reports %d\n", per_cu);
        (void)hipGetLastError();
        grid = cus;
    }
    if (grid < 0) return;
    (void)hipMemsetAsync((char*)d_ws + WS_CTL, 0, CTL_BYTES, stream);
    Args a{};
    for (int i = 0; i < 22; ++i) a.in[i] = (const float*)d_in[i];
    a.out = (float*)d_out; a.ws = (unsigned char*)d_ws; a.pad = 0;
#if MK_SPLIT
    for (int p = 0; p < NPHASE; ++p) { a.lo = p; a.hi = p + 1; a.li = 0; hipLaunchKernelGGL(mk_fwd, dim3(grid), dim3(NTHR), LDS_BYTES, stream, a); }
#else
    a.lo = 0; a.hi = NPHASE; a.li = 0;
    hipLaunchKernelGGL(mk_fwd, dim3(grid), dim3(NTHR), LDS_BYTES, stream, a);
#endif
}
```

```cpp
#include <hip/hip_runtime.h>
#include <cstdio>
#include <cstdint>
namespace pg8 {
#define PG8_LAS __attribute__((address_space(3)))
typedef unsigned short bf16_t;
typedef short bf16x8 __attribute__((ext_vector_type(8)));
typedef float f32x4 __attribute__((ext_vector_type(4)));
typedef unsigned u32x4 __attribute__((ext_vector_type(4)));
constexpr int BM = 256, BK = 64, HALF = 128, HTB = HALF * BK * 2  , STAGE_BYTES = 8 * HTB, NXCD = 8, WGM = 8;

__host__ __device__ __forceinline__ int lds_byte(int r, int c) { const int st = (r >> 4) * 2 + (c >> 5), rr = r & 15, cc = c & 31, ob = rr * 64 + cc * 2; return st * 1024 + (ob ^ (((ob >> 9) & 1) << 5)); }
__host__ __device__ __forceinline__ void stage_rc(int b, int& R, int& C) { const int st = b / 1024, sb = b % 1024, swz = sb ^ (((sb >> 9) & 1) << 5); R = (st >> 1) * 16 + swz / 64; C = (st & 1) * 32 + (swz % 64) / 2; }
__host__ __device__ __forceinline__ int perm32(int rho) { const int n = rho >> 4, i = rho & 15; return 8 * (i >> 2) + 4 * n + (i & 3); }

struct Unit { int pm, pn; };
struct Gemm { const bf16_t* A; const bf16_t* Bt; int M, N, K; };

struct StaticOrder {
    int nM, nN, nwg, G, c;
    __host__ __device__ void init(int M, int N, int G_, int c_) { nM = M / BM; nN = N / BM; nwg = nM * nN; G = G_; c = c_; }
    __host__ __device__ bool next(int i, Unit& u) const {
        const long L = (long)i * G + c; if (L >= nwg) return false;
        int wgid = (int)L; { const int q = nwg / NXCD, r = nwg % NXCD, xcd = wgid % NXCD, off = wgid / NXCD; wgid = (xcd < r ? xcd * (q + 1) : r * (q + 1) + (xcd - r) * q) + off; }
        const int nig = WGM * nN, gid = wgid / nig, fm = gid * WGM, gsz = (nM - fm) < WGM ? (nM - fm) : WGM;
        u.pm = fm + ((wgid % nig) % gsz); u.pn = (wgid % nig) / gsz; return true;
    }
    __device__ __forceinline__ void a_ready(const Unit&) const {}
    __device__ __forceinline__ void done(const Unit&) const {}
};

template <class Epi, class Sched, bool ALIGN_EPI = false, bool SP2 = false>
__device__ __forceinline__ void gemm_phase(PG8_LAS unsigned char* lds, const Gemm g, const Sched& S, const Epi& E) {
    const int tid = threadIdx.x, wid = __builtin_amdgcn_readfirstlane(tid >> 6), lane = tid & 63, wr = wid >> 2, wc = wid & 3, fr = lane & 15, fq = lane >> 4;
    const int K = g.K, nt = K / BK;
    unsigned voffA[2], voffB[2];
#pragma unroll
    for (int i = 0; i < 2; ++i) { int R, C; stage_rc(tid * 16 + i * 8192, R, C); const int Rb = Epi::PERM ? ((R & ~31) + perm32(R & 31)) : R;
        voffA[i] = (unsigned)(R * K + C) * 2u; voffB[i] = (unsigned)(Rb * K + C) * 2u; }
    const size_t kstep = (size_t)(BK * 2);
    const size_t hstep = (size_t)HALF * K * 2;
    const size_t tstep = 2 * hstep;
    const unsigned ldsw = (unsigned)wid * 1024u;
    const int aoff = lds_byte(wr * 64 + fr, fq * 8), boff = lds_byte(wc * 32 + fr, fq * 8);
#define PG8_SA(b, h) (((b) * 2 + (h)) * HTB)
#define PG8_SB(b, h) ((4 + (b) * 2 + (h)) * HTB)
#define PG8_STAGE(bufoff, gbase, voff) do { _Pragma("unroll") for (int _i = 0; _i < 2; ++_i) \
        __builtin_amdgcn_global_load_lds((const unsigned*)((const char*)(gbase) + (voff)[_i]), (PG8_LAS unsigned*)(lds + (bufoff) + ldsw + _i * 8192), 16, 0, 0); } while (0)
#define PG8_LDA(dst, b, h) do { _Pragma("unroll") for (int m = 0; m < 4; ++m) _Pragma("unroll") for (int k = 0; k < 2; ++k) dst[m][k] = *(const PG8_LAS bf16x8*)(lds + PG8_SA(b, h) + aoff + m * 2048 + k * 1024); } while (0)
#define PG8_LDB(dst, b, h) do { _Pragma("unroll") for (int n = 0; n < 2; ++n) _Pragma("unroll") for (int k = 0; k < 2; ++k) dst[n][k] = *(const PG8_LAS bf16x8*)(lds + PG8_SB(b, h) + boff + n * 2048 + k * 1024); } while (0)
#define PG8_MMA(ai, bj, At, Bt) do { __builtin_amdgcn_s_setprio(1); _Pragma("unroll") for (int m = 0; m < 4; ++m) _Pragma("unroll") for (int n = 0; n < 2; ++n) _Pragma("unroll") for (int k = 0; k < 2; ++k) \
        acc[ai][bj][m][n] = __builtin_amdgcn_mfma_f32_16x16x32_bf16(Bt[n][k], At[m][k], acc[ai][bj][m][n], 0, 0, 0); __builtin_amdgcn_s_setprio(0); } while (0)
#define PG8_WAIT_V(n) asm volatile("s_waitcnt vmcnt(" #n ")" ::: "memory")
#define PG8_WAIT_L(n) asm volatile("s_waitcnt lgkmcnt(" #n ")" ::: "memory")
#define PG8_BAR __builtin_amdgcn_s_barrier()
#define PG8_SCHED __builtin_amdgcn_sched_barrier(0)
    Unit cur, nxt; int ui = 0;
    if (!S.next(0, cur)) return;
    f32x4 acc[2][2][4][2];
#pragma unroll
    for (int a = 0; a < 2; ++a)
#pragma unroll
        for (int b = 0; b < 2; ++b)
#pragma unroll
            for (int m = 0; m < 4; ++m)
#pragma unroll
                for (int n = 0; n < 2; ++n) acc[a][b][m][n] = (f32x4){0.f, 0.f, 0.f, 0.f};
    bf16x8 At[4][2], B0[2][2], B1[2][2];
    const char* cA = (const char*)g.A + (size_t)cur.pm * tstep; const char* cB = (const char*)g.Bt + (size_t)cur.pn * tstep;
    S.a_ready(cur);
    if constexpr (SP2) {
        PG8_STAGE(PG8_SB(0, 0), cB, voffB); PG8_STAGE(PG8_SB(0, 1), cB + hstep, voffB); PG8_STAGE(PG8_SA(0, 0), cA, voffA); PG8_STAGE(PG8_SA(0, 1), cA + hstep, voffA);
        if (wr == 1) PG8_BAR;
        PG8_WAIT_V(2); PG8_BAR;
        PG8_STAGE(PG8_SB(1, 0), cB + kstep, voffB); PG8_STAGE(PG8_SA(1, 0), cA + kstep, voffA); PG8_STAGE(PG8_SB(1, 1), cB + hstep + kstep, voffB);
        PG8_WAIT_V(6); PG8_BAR;
    } else {
        PG8_STAGE(PG8_SB(0, 0), cB, voffB); PG8_STAGE(PG8_SA(0, 0), cA, voffA); PG8_STAGE(PG8_SB(0, 1), cB + hstep, voffB); PG8_STAGE(PG8_SA(0, 1), cA + hstep, voffA);
        if (wr == 1) PG8_BAR;
        PG8_WAIT_V(4); PG8_BAR;
        PG8_STAGE(PG8_SB(1, 0), cB + kstep, voffB); PG8_STAGE(PG8_SA(1, 0), cA + kstep, voffA); PG8_STAGE(PG8_SB(1, 1), cB + hstep + kstep, voffB);
        PG8_WAIT_V(6); PG8_BAR;
    }
    for (;;) {
        const bool has_next = S.next(ui + 1, nxt);
        const char* nA = has_next ? (const char*)g.A + (size_t)nxt.pm * tstep : cA; const char* nB = has_next ? (const char*)g.Bt + (size_t)nxt.pn * tstep : cB;
        for (int t = 0; t < nt; t += 2) {
            const bool last = (t == nt - 2);
            const char* a1 = cA + (size_t)(t + 1) * kstep;
            const char* a2 = last ? nA : cA + (size_t)(t + 2) * kstep; const char* b2 = last ? nB : cB + (size_t)(t + 2) * kstep;
            const char* a3 = a2 + kstep; const char* b3 = b2 + kstep;
            if (last && has_next) S.a_ready(nxt);
            if constexpr (SP2) {
            PG8_LDB(B0, 0, 0); PG8_LDB(B1, 0, 1); PG8_SCHED; PG8_LDA(At, 0, 0); PG8_STAGE(PG8_SA(1, 1), a1 + hstep, voffA);
            PG8_WAIT_V(8); PG8_WAIT_L(0); PG8_BAR; PG8_MMA(0, 0, At, B0); PG8_MMA(0, 1, At, B1); PG8_BAR; PG8_SCHED;
            PG8_LDA(At, 0, 1); PG8_STAGE(PG8_SB(0, 0), b2, voffB); PG8_STAGE(PG8_SB(0, 1), b2 + hstep, voffB); PG8_STAGE(PG8_SA(0, 0), a2, voffA);
            PG8_WAIT_V(8); PG8_WAIT_L(0); PG8_BAR; PG8_MMA(1, 0, At, B0); PG8_MMA(1, 1, At, B1); PG8_BAR; PG8_SCHED;
            PG8_LDB(B0, 1, 0); PG8_LDB(B1, 1, 1); PG8_SCHED; PG8_LDA(At, 1, 0); PG8_STAGE(PG8_SA(0, 1), a2 + hstep, voffA);
            PG8_WAIT_V(8); PG8_WAIT_L(0); PG8_BAR; PG8_MMA(0, 0, At, B0); PG8_MMA(0, 1, At, B1); PG8_BAR; PG8_SCHED;
            PG8_LDA(At, 1, 1); PG8_STAGE(PG8_SB(1, 0), b3, voffB); PG8_STAGE(PG8_SB(1, 1), b3 + hstep, voffB); PG8_STAGE(PG8_SA(1, 0), a3, voffA);
            PG8_WAIT_V(8); PG8_WAIT_L(0); PG8_BAR; PG8_MMA(1, 0, At, B0); PG8_MMA(1, 1, At, B1); PG8_BAR; PG8_SCHED;
            } else {
            PG8_LDB(B0, 0, 0); PG8_SCHED; PG8_LDA(At, 0, 0); PG8_STAGE(PG8_SA(1, 1), a1 + hstep, voffA);
            PG8_WAIT_L(8); PG8_BAR; PG8_WAIT_L(0); PG8_MMA(0, 0, At, B0); PG8_BAR; PG8_SCHED;
            PG8_LDB(B1, 0, 1); PG8_STAGE(PG8_SB(0, 0), b2, voffB);
            PG8_BAR; PG8_WAIT_L(0); PG8_MMA(0, 1, At, B1); PG8_BAR;
            PG8_LDA(At, 0, 1); PG8_STAGE(PG8_SA(0, 0), a2, voffA);
            PG8_BAR; PG8_WAIT_L(0); PG8_MMA(1, 0, At, B0); PG8_BAR; PG8_SCHED;
            PG8_STAGE(PG8_SB(0, 1), b2 + hstep, voffB);
            PG8_WAIT_V(6); PG8_BAR; PG8_MMA(1, 1, At, B1); PG8_BAR;
            PG8_LDB(B0, 1, 0); PG8_SCHED; PG8_LDA(At, 1, 0); PG8_STAGE(PG8_SA(0, 1), a2 + hstep, voffA);
            PG8_WAIT_L(8); PG8_BAR; PG8_WAIT_L(0); PG8_MMA(0, 0, At, B0); PG8_BAR; PG8_SCHED;
            PG8_LDB(B1, 1, 1); PG8_STAGE(PG8_SB(1, 0), b3, voffB);
            PG8_BAR; PG8_WAIT_L(0); PG8_MMA(0, 1, At, B1); PG8_BAR;
            PG8_LDA(At, 1, 1); PG8_STAGE(PG8_SA(1, 0), a3, voffA);
            PG8_BAR; PG8_WAIT_L(0); PG8_MMA(1, 0, At, B0); PG8_BAR; PG8_SCHED;
            PG8_STAGE(PG8_SB(1, 1), b3 + hstep, voffB);
            PG8_WAIT_V(6); PG8_BAR; PG8_MMA(1, 1, At, B1); PG8_BAR;
            }
        }
        if constexpr (ALIGN_EPI) { if (wr == 0) PG8_BAR; }
        if constexpr (!Epi::AFTER_DRAIN) { E(acc, cur, wr, wc, fr, fq); S.done(cur); }
        if (!has_next) break;
#pragma unroll
        for (int a = 0; a < 2; ++a)
#pragma unroll
            for (int b = 0; b < 2; ++b)
#pragma unroll
                for (int m = 0; m < 4; ++m)
#pragma unroll
                    for (int n = 0; n < 2; ++n) acc[a][b][m][n] = (f32x4){0.f, 0.f, 0.f, 0.f};
        cur = nxt; cA = nA; cB = nB; ++ui;
        if constexpr (ALIGN_EPI) { if (wr == 1) PG8_BAR; }
    }
    PG8_WAIT_V(0);
    if constexpr (!ALIGN_EPI) { if (wr == 0) PG8_BAR; }
    PG8_BAR;
    if constexpr (Epi::AFTER_DRAIN) { E.fused(acc, cur, wr, wc, fr, fq, lds, wid, lane); S.done(cur); }
#undef PG8_SA
#undef PG8_SB
#undef PG8_STAGE
#undef PG8_LDA
#undef PG8_LDB
#undef PG8_MMA
#undef PG8_WAIT_V
#undef PG8_WAIT_L
#undef PG8_BAR
#undef PG8_SCHED
}
}
#define LAS __attribute__((address_space(3)))
#define XB_TMO      128
#define XB_XCNT(j)  (256  + 64 * (j))
#define XB_XSUB(j)  (1280 + 64 * (j))
#define XB_XGEN(j)  (2304 + 64 * (j))
#define XB_TOP      3328
#define XB_TOPGEN   3392
#define XCD_BAR_WORDS 3456
#define XB_SPIN_CAP (1u << 22)

__device__ __forceinline__ unsigned xb_ld(unsigned* p)              { return __hip_atomic_load(p, __ATOMIC_RELAXED, __HIP_MEMORY_SCOPE_AGENT); }
__device__ __forceinline__ unsigned xb_add(unsigned* p, unsigned v) { return __hip_atomic_fetch_add(p, v, __ATOMIC_RELAXED, __HIP_MEMORY_SCOPE_AGENT); }
__device__ __forceinline__ unsigned xb_xcc_id() { return (unsigned)__builtin_amdgcn_s_getreg((3 << 11) | 20) & 0xFu; }
#define XB_SPIN(cond, bar) do { unsigned _sp = 0; while (cond) { __builtin_amdgcn_s_sleep(1); \
    if ((++_sp & 255u) == 0u) { if (xb_ld(&(bar)[XB_TMO])) break; if (_sp > XB_SPIN_CAP) { atomicAdd(&(bar)[XB_TMO], 1u); break; } } } } while (0)

struct XcdBarrier {
    unsigned* bar; unsigned x;
    volatile LAS unsigned* st;
};

__device__ __forceinline__ XcdBarrier xcd_barrier_post(unsigned* bar, volatile LAS unsigned* st) {
    XcdBarrier b; b.bar = bar; b.x = xb_xcc_id(); b.st = st;
    if (threadIdx.x == 0) (void)xb_add(&bar[XB_XCNT(b.x)], 1u);
    return b;
}
__device__ __forceinline__ void xcd_barrier_complete(unsigned* bar, unsigned x, unsigned& nloc, unsigned& nx) {
    const unsigned G = gridDim.x * gridDim.y * gridDim.z;
    unsigned sum, cnt, mine, sp = 0u;
    for (;;) {
        sum = 0u; cnt = 0u; mine = 0u;
#pragma unroll
        for (unsigned j = 0; j < 16; ++j) { const unsigned c = xb_ld(&bar[XB_XCNT(j)]); sum += c; cnt += (c > 0u) ? 1u : 0u; mine = (j == x) ? c : mine; }
        if (sum == G) break;
        __builtin_amdgcn_s_sleep(1);
        if ((++sp & 255u) == 0u) { if (xb_ld(&bar[XB_TMO])) break; if (sp > XB_SPIN_CAP) { atomicAdd(&bar[XB_TMO], 1u); break; } }
    }
    nloc = mine > 0u ? mine : 1u; nx = cnt > 0u ? cnt : 1u;
}

__device__ __forceinline__ void xcd_barrier(const XcdBarrier& b) {
    asm volatile("s_waitcnt vmcnt(0)" ::: "memory");
    __syncthreads();
    if (threadIdx.x == 0) {
        unsigned* bar = b.bar;
        __builtin_amdgcn_s_waitcnt(0);
        unsigned nloc = b.st[0], nx = b.st[1];
        if (nloc == 0u) { xcd_barrier_complete(bar, b.x, nloc, nx); b.st[0] = nloc; b.st[1] = nx; }
        const unsigned old = xb_add(&bar[XB_XSUB(b.x)], 1u);
        const unsigned gen = old / nloc;
        if (old + 1u == (gen + 1u) * nloc) {
            __builtin_amdgcn_fence(__ATOMIC_RELEASE, "agent");
            asm volatile("s_waitcnt vmcnt(0)" ::: "memory");
            const unsigned og = xb_add(&bar[XB_TOP], 1u);
            const unsigned tg = og / nx;
            if (og + 1u == (tg + 1u) * nx) xb_add(&bar[XB_TOPGEN], 1u);
            else XB_SPIN(xb_ld(&bar[XB_TOPGEN]) == tg, bar);
            __builtin_amdgcn_fence(__ATOMIC_ACQUIRE, "agent");
            xb_add(&bar[XB_XGEN(b.x)], 1u);
            asm volatile("s_waitcnt vmcnt(0)" ::: "memory");
        } else {
            XB_SPIN(xb_ld(&bar[XB_XGEN(b.x)]) == gen, bar);
            __builtin_amdgcn_fence(__ATOMIC_ACQUIRE, "agent");
            asm volatile("s_waitcnt vmcnt(0)" ::: "memory");
        }
    }
    __syncthreads();
}

namespace mk {
using pg8::bf16_t; using pg8::bf16x8; using pg8::f32x4; using pg8::u32x4;

#define GAS __attribute__((address_space(1)))
typedef float f32x2 __attribute__((ext_vector_type(2)));
typedef float f32x16 __attribute__((ext_vector_type(16)));
typedef unsigned u32x2 __attribute__((ext_vector_type(2)));
typedef short s16x4 __attribute__((ext_vector_type(4)));
typedef __bf16 bf16x2_t __attribute__((ext_vector_type(2)));
typedef unsigned char uchar;

constexpr int S = 8192, D = 2048, NH = 8, HD = 128, CKV = 256, IH = 16, IDM = 64, TOPK = 256;
constexpr int GW = 1024, CHUNK = 128, NGRP = 8;
constexpr int NSRC = 8528, NPROJ = 8704;
constexpr int NE = 64, FF = 512;
constexpr float EPS = 1e-6f, LOG2E = 1.4426950408889634f;
constexpr int NTHR = 512, NWAVE = 8;
constexpr int MAXROWS = 32768;

constexpr size_t MiB = 1u << 20;
constexpr size_t WS_CTL = 0, CTL_BYTES = 1 * MiB;
constexpr size_t WS_WINT = 1 * MiB, WS_WAT = 35 * MiB, WS_WBT = 39 * MiB, WS_WOT = 43 * MiB, WS_WUK = 51 * MiB, WS_WUV = 51 * MiB + 512 * 1024, WS_WSM = 52 * MiB;
constexpr size_t WS_LIST = 53 * MiB;
constexpr size_t WS_CWT = 55 * MiB;
constexpr size_t WS_HID = 57 * MiB;
constexpr size_t WS_Y = 85 * MiB;
constexpr size_t WS_N1 = 437 * MiB;
constexpr size_t WS_Q = 469 * MiB, WS_CKVF = 485 * MiB, WS_CKV = 493 * MiB, WS_QI = 497 * MiB, WS_KIDX = 513 * MiB, WS_WIDX = 514 * MiB;
constexpr size_t WS_UV = 515 * MiB;
constexpr size_t WS_LNS = 547 * MiB, WS_GATE = 548 * MiB;
constexpr size_t WS_QABS = 612 * MiB, WS_OB = 644 * MiB;
constexpr size_t WS_MB = 676 * MiB, WS_IDX = 692 * MiB, WS_AB = 700 * MiB, WS_ROUTE = 716 * MiB;
constexpr size_t WS_SC = 717 * MiB;
constexpr size_t WS_END = 973 * MiB;
constexpr size_t RT_EID = 0, RT_POS = 65536, RT_WGT = 131072, RT_ROW = 196608, RT_CW = 262144;
constexpr int CW_BAR = 4096, CW_CNT = 65536;

constexpr int LDS_BYTES = 155648;
constexpr int LDS_X = 131072;
constexpr int LDS_MISC = LDS_BYTES - 256;

__device__ __forceinline__ unsigned pk2(float lo, float hi) { f32x2 v = {lo, hi}; return __builtin_bit_cast(unsigned, __builtin_convertvector(v, bf16x2_t)); }
__device__ __forceinline__ float bf_lo(unsigned u) { return __uint_as_float(u << 16); }
__device__ __forceinline__ float bf_hi(unsigned u) { return __uint_as_float(u & 0xffff0000u); }
__device__ __forceinline__ float bf1(bf16_t b) { return __uint_as_float(((unsigned)b) << 16); }
__device__ __forceinline__ float wave_sum(float v) {
#pragma unroll
    for (int o = 1; o < 64; o <<= 1) v += __shfl_xor(v, o);
    return v;
}
__device__ __forceinline__ float ex2(float x) { return __builtin_amdgcn_exp2f(x); }
__device__ __forceinline__ float sigm(float x) { return __builtin_amdgcn_rcpf(1.f + ex2(-x * LOG2E)); }
__device__ __forceinline__ float gelu_t(float x) { const float u = 0.7978845608028654f * (x + 0.044715f * x * x * x); return x * __builtin_amdgcn_rcpf(1.f + ex2(-2.f * LOG2E * u)); }
__device__ __forceinline__ float silu_(float x) { return x * sigm(x); }

struct Ctx {
    LAS uchar* lds; int tid, lane, wave, G, bid;
    const float* in[22]; float* out; uchar* ws;
};
#define WSP(T, off) ((T*)(C.ws + (off)))
enum { I_X = 0, I_N1G, I_WIN, I_KVG, I_WUK, I_WUV, I_GWS, I_GBS, I_LNG, I_LNB, I_WBA, I_WBG, I_WOUT, I_N2G, I_WGRP, I_BGRP, I_WRT, I_BRT, I_WEG, I_WEU, I_WED, I_NFG };

__device__ __forceinline__ int proj_src_col(int n) {
    if (n < 2304) return n;
    if (n < 8448) return n + 80;
    if (n < 8528) return n - 8448 + 2304;
    return -1;
}
__device__ __forceinline__ void tc_item(const float* __restrict__ W, size_t ldw, int srccol, bf16_t* WT, size_t K, int dstrow0, int k0, LAS float* scr, int lane) {
#pragma unroll 8
    for (int i = 0; i < 32; ++i) { const int kk = 2 * i + (lane >> 5); scr[kk * 33 + (lane & 31)] = srccol >= 0 ? W[(size_t)(k0 + kk) * ldw + srccol] : 0.f; }
    asm volatile("s_waitcnt lgkmcnt(0)" ::: "memory");
    const int c = lane & 7;
#pragma unroll
    for (int j = 0; j < 4; ++j) { const int n = (lane >> 3) + 8 * j; const LAS float* s = scr + (8 * c) * 33 + n;
        u32x4 o; o.x = pk2(s[0 * 33], s[1 * 33]); o.y = pk2(s[2 * 33], s[3 * 33]); o.z = pk2(s[4 * 33], s[5 * 33]); o.w = pk2(s[6 * 33], s[7 * 33]);
        *(u32x4*)(WT + (size_t)(dstrow0 + n) * K + k0 + 8 * c) = o; }
    asm volatile("s_waitcnt lgkmcnt(0)" ::: "memory");
}
__device__ __forceinline__ void p0_prologue(const Ctx& C) {
    LAS float* scr = (LAS float*)(C.lds + C.wave * 16384);
    const int gw = C.bid * NWAVE + C.wave, NGW = C.G * NWAVE, lane = C.lane;
    constexpr int I_IN = (NPROJ / 32) * (D / 64);
    constexpr int I_BA = (D / 32) * (1024 / 64);
    constexpr int I_OUT = (D / 32) * (D / 64);
    constexpr int NITEMS = I_IN + 2 * I_BA + I_OUT;
    for (int it = gw; it < NITEMS; it += NGW) {
        int r = it;
        if (r < I_IN) { const int nb = r % (NPROJ / 32), kb = r / (NPROJ / 32); tc_item(C.in[I_WIN], NSRC, proj_src_col(32 * nb + (lane & 31)), WSP(bf16_t, WS_WINT), D, 32 * nb, 64 * kb, scr, lane); continue; } r -= I_IN;
        if (r < I_BA) { const int nb = r % 64, kb = r / 64; tc_item(C.in[I_WBA], D, 32 * nb + (lane & 31), WSP(bf16_t, WS_WAT), 1024, 32 * nb, 64 * kb, scr, lane); continue; } r -= I_BA;
        if (r < I_BA) { const int nb = r % 64, kb = r / 64; tc_item(C.in[I_WBG], D, 32 * nb + (lane & 31), WSP(bf16_t, WS_WBT), 1024, 32 * nb, 64 * kb, scr, lane); continue; } r -= I_BA;
        { const int nb = r % 64, kb = r / 64; tc_item(C.in[I_WOUT], D, 32 * nb + (lane & 31), WSP(bf16_t, WS_WOT), D, 32 * nb, 64 * kb, scr, lane); }
    }
    const int gt = C.bid * NTHR + C.tid, NGT = C.G * NTHR;
    for (int i = gt; i < 262144 / 4; i += NGT) {
        const f32x4 a = ((const f32x4*)C.in[I_WUK])[i], b = ((const f32x4*)C.in[I_WUV])[i];
        u32x2 oa, ob; oa.x = pk2(a.x, a.y); oa.y = pk2(a.z, a.w); ob.x = pk2(b.x, b.y); ob.y = pk2(b.z, b.w);
        WSP(u32x2, WS_WUK)[i] = oa; WSP(u32x2, WS_WUV)[i] = ob;
    }
    for (int i = gt; i < 131072 / 4; i += NGT) {
        const f32x4 a = ((const f32x4*)C.in[I_GWS])[i]; const int e = 4 * i, s0 = e & 127, t = (e >> 7) & 127;
        u32x2 o; o.x = pk2(s0 <= t ? a.x : 0.f, s0 + 1 <= t ? a.y : 0.f); o.y = pk2(s0 + 2 <= t ? a.z : 0.f, s0 + 3 <= t ? a.w : 0.f);
        WSP(u32x2, WS_WSM)[i] = o;
    }
    for (int m = gw; m < S; m += NGW) {
        const f32x4* xr = (const f32x4*)(C.in[I_X] + (size_t)m * D) + lane; const f32x4* gr = (const f32x4*)C.in[I_N1G] + lane;
        f32x4 v[8]; float ss = 0.f;
#pragma unroll
        for (int j = 0; j < 8; ++j) { v[j] = xr[64 * j]; ss += (v[j].x * v[j].x + v[j].y * v[j].y) + (v[j].z * v[j].z + v[j].w * v[j].w); }
        const float rstd = 1.0f / sqrtf(wave_sum(ss) * (1.f / D) + EPS);
        u32x2* o = WSP(u32x2, WS_N1) + (size_t)m * (D / 4) + lane;
#pragma unroll
        for (int j = 0; j < 8; ++j) { const f32x4 g = gr[64 * j]; u32x2 w; w.x = pk2(v[j].x * rstd * g.x, v[j].y * rstd * g.y); w.y = pk2(v[j].z * rstd * g.z, v[j].w * rstd * g.w); o[64 * j] = w; }
    }
}

struct EpiProj {
    static constexpr bool PERM = true, AFTER_DRAIN = false;
    bf16_t *Q, *QI, *UV, *GATE, *KIDX; float *CKVF, *LNS, *WIDX;
    template <int ACT> __device__ __forceinline__ void st_bf16(const f32x4 (&acc)[2][2][4][2], bf16_t* base, int ld, int row0, int col0, float sc) const {
#pragma unroll
        for (int ai = 0; ai < 2; ++ai)
#pragma unroll
            for (int m = 0; m < 4; ++m) { bf16_t* rowp = base + (size_t)(row0 + ai * 128 + m * 16) * ld + col0;
#pragma unroll
                for (int bj = 0; bj < 2; ++bj) { f32x4 v0 = acc[ai][bj][m][0], v1 = acc[ai][bj][m][1];
                    if (ACT == 0) { v0 *= sc; v1 *= sc; }
                    if (ACT == 1) {
#pragma unroll
                        for (int j = 0; j < 4; ++j) { v0[j] = gelu_t(v0[j]); v1[j] = gelu_t(v1[j]); } }
                    if (ACT == 2) {
#pragma unroll
                        for (int j = 0; j < 4; ++j) { v0[j] = sigm(v0[j]); v1[j] = sigm(v1[j]); } }
                    u32x4 w; w.x = pk2(v0[0], v0[1]); w.y = pk2(v0[2], v0[3]); w.z = pk2(v1[0], v1[1]); w.w = pk2(v1[2], v1[3]);
                    *(u32x4*)(rowp + bj * 128) = w; } }
    }
    __device__ __forceinline__ void operator()(const f32x4 (&acc)[2][2][4][2], const pg8::Unit& u, int wr, int wc, int fr, int fq) const {
        const int pn = u.pn, row0 = u.pm * 256 + wr * 64 + fr, cl = wc * 32 + 8 * fq;
        if (pn < 4) st_bf16<0>(acc, Q, 1024, row0, pn * 256 + cl, 1.f);
        else if (pn == 4) {
#pragma unroll
            for (int ai = 0; ai < 2; ++ai)
#pragma unroll
                for (int m = 0; m < 4; ++m) { float* rowp = CKVF + (size_t)(row0 + ai * 128 + m * 16) * 256 + cl;
#pragma unroll
                    for (int bj = 0; bj < 2; ++bj) { *(f32x4*)(rowp + bj * 128) = acc[ai][bj][m][0]; *(f32x4*)(rowp + bj * 128 + 4) = acc[ai][bj][m][1]; } }
        }
        else if (pn < 9) st_bf16<0>(acc, QI, 1024, row0, (pn - 5) * 256 + cl, 0.125f);
        else if (pn < 13) st_bf16<1>(acc, UV, 2048, row0, (pn - 9) * 256 + cl, 1.f);
        else if (pn < 17) {
#pragma unroll
            for (int ai = 0; ai < 2; ++ai)
#pragma unroll
                for (int m = 0; m < 4; ++m) { const int row = row0 + ai * 128 + m * 16; bf16_t* rowp = UV + (size_t)row * 2048 + (pn - 9) * 256 + cl; float s = 0.f, ss = 0.f;
#pragma unroll
                    for (int bj = 0; bj < 2; ++bj) { f32x4 v0 = acc[ai][bj][m][0], v1 = acc[ai][bj][m][1];
#pragma unroll
                        for (int j = 0; j < 4; ++j) { v0[j] = gelu_t(v0[j]); v1[j] = gelu_t(v1[j]); s += v0[j] + v1[j]; ss += v0[j] * v0[j] + v1[j] * v1[j]; }
                        u32x4 w; w.x = pk2(v0[0], v0[1]); w.y = pk2(v0[2], v0[3]); w.z = pk2(v1[0], v1[1]); w.w = pk2(v1[2], v1[3]);
                        *(u32x4*)(rowp + bj * 128) = w; }
                    s += __shfl_xor(s, 16); s += __shfl_xor(s, 32); ss += __shfl_xor(ss, 16); ss += __shfl_xor(ss, 32);
                    if (fq == 0) *(f32x2*)(LNS + (size_t)row * 32 + ((pn - 13) * 4 + wc) * 2) = (f32x2){s, ss}; }
        }
        else if (pn < 33) st_bf16<2>(acc, GATE, 4096, row0, (pn - 17) * 256 + cl, 1.f);
        else {
#pragma unroll
            for (int ai = 0; ai < 2; ++ai)
#pragma unroll
                for (int m = 0; m < 4; ++m) { const int row = row0 + ai * 128 + m * 16; const f32x4 v0 = acc[ai][0][m][0], v1 = acc[ai][0][m][1];
                    if (wc < 2) { u32x4 w; w.x = pk2(v0[0], v0[1]); w.y = pk2(v0[2], v0[3]); w.z = pk2(v1[0], v1[1]); w.w = pk2(v1[2], v1[3]); *(u32x4*)(KIDX + (size_t)row * 64 + cl) = w; }
                    else if (wc == 2 && fq < 2) { float* p = WIDX + (size_t)row * 16 + 8 * fq; *(f32x4*)p = v0 * 0.25f; *(f32x4*)(p + 4) = v1 * 0.25f; } }
        }
    }
};

__device__ __forceinline__ unsigned imgb_off(unsigned row, unsigned ch) { return 256u * row + 16u * (ch ^ (((row & 3u) << 2) | ((row >> 2) & 3u))); }
__device__ __forceinline__ unsigned imgb_row16(unsigned lane, unsigned rb, unsigned s) { return imgb_off((lane & 15u) + 16u * rb, 4u * s + (lane >> 4)); }
__device__ __forceinline__ unsigned imgb_tr16(unsigned lane, unsigned c, unsigned ks, unsigned t) { const unsigned g = lane >> 4, q = (lane & 15u) >> 2, p = lane & 3u; return imgb_off(32u * ks + 8u * g + 4u * t + q, 2u * c + (p >> 1)) + 8u * (p & 1u); }
__device__ __forceinline__ bf16x8 trrd8(LAS uchar* p0, LAS uchar* p1) {
    const s16x4 b0 = __builtin_amdgcn_ds_read_tr16_b64_v4i16((LAS s16x4*)p0), b1 = __builtin_amdgcn_ds_read_tr16_b64_v4i16((LAS s16x4*)p1);
    return __builtin_shufflevector(b0, b1, 0, 1, 2, 3, 4, 5, 6, 7);
}
#define MFMA16(a, b, c) __builtin_amdgcn_mfma_f32_16x16x32_bf16((a), (b), (c), 0, 0, 0)
__device__ __forceinline__ void load_img128(LAS uchar* img, const bf16_t* src, size_t ld, int tid) {
#pragma unroll
    for (int i = 0; i < 4; ++i) { const int q = tid + NTHR * i, row = q >> 4, ch = q & 15; *(LAS u32x4*)(img + imgb_off(row, ch)) = *(const u32x4*)(src + (size_t)row * ld + ch * 8); }
}
__device__ __forceinline__ void trgemm(LAS uchar* imgA, LAS uchar* imgB, int lane, int w, f32x4 (&acc)[8]) {
#pragma unroll
    for (int ks = 0; ks < 4; ++ks) {
        const bf16x8 a = *(LAS bf16x8*)(imgA + imgb_row16(lane, w, ks));
#pragma unroll
        for (int c = 0; c < 8; ++c) { const bf16x8 b = trrd8(imgB + imgb_tr16(lane, c, ks, 0), imgB + imgb_tr16(lane, c, ks, 1)); acc[c] = MFMA16(a, b, acc[c]); }
    }
}
constexpr int STG_LD = 132;
__device__ __forceinline__ void stage_acc(LAS float* stg, const f32x4 (&acc)[8], int lane) {
    const int col = lane & 15, g = lane >> 4;
#pragma unroll
    for (int c = 0; c < 8; ++c)
#pragma unroll
        for (int r = 0; r < 4; ++r) stg[(4 * g + r) * STG_LD + 16 * c + col] = acc[c][r];
}
__device__ __forceinline__ void stage_store_bf16(LAS float* stg, const f32x4 (&acc)[8], bf16_t* orow, size_t ld, int lane) {
    stage_acc(stg, acc, lane);
#pragma unroll
    for (int i = 0; i < 4; ++i) { const int q = lane + 64 * i, row = q >> 4, ch = q & 15; const LAS float* s = stg + row * STG_LD + 8 * ch;
        u32x4 o; o.x = pk2(s[0], s[1]); o.y = pk2(s[2], s[3]); o.z = pk2(s[4], s[5]); o.w = pk2(s[6], s[7]);
        *(u32x4*)(orow + (size_t)row * ld + 8 * ch) = o; }
}
#define ZERO8(a) do { _Pragma("unroll") for (int _c = 0; _c < 8; ++_c) a[_c] = (f32x4){0.f, 0.f, 0.f, 0.f}; } while (0)

__device__ __forceinline__ void p2_ckv_norm(const Ctx& C) {
    const int gw = C.bid * NWAVE + C.wave, NGW = C.G * NWAVE, lane = C.lane;
    const f32x4 g = ((const f32x4*)C.in[I_KVG])[lane];
    for (int m = gw; m < S; m += NGW) {
        const f32x4 v = ((const f32x4*)(WSP(float, WS_CKVF) + (size_t)m * CKV))[lane];
        const float ss = wave_sum((v.x * v.x + v.y * v.y) + (v.z * v.z + v.w * v.w));
        const float rstd = 1.0f / sqrtf(ss * (1.f / CKV) + EPS);
        u32x2 o; o.x = pk2(v.x * rstd * g.x, v.y * rstd * g.y); o.y = pk2(v.z * rstd * g.z, v.w * rstd * g.w);
        (WSP(u32x2, WS_CKV) + (size_t)m * (CKV / 4))[lane] = o;
    }
}
__device__ __forceinline__ void p2_qabs(const Ctx& C) {
    LAS uchar* imgA = C.lds; LAS uchar* imgB = C.lds + 32768;
    LAS float* stg = (LAS float*)(C.lds) + C.wave * 16 * STG_LD;
    const int lane = C.lane, w = C.wave;
#pragma unroll 1
    for (int u = C.bid; u < 64 * NH * 2; u += C.G) {
        const int half = u & 1, h = (u >> 1) & 7, t0 = (u >> 4) * 128;
        __syncthreads();
        load_img128(imgA, WSP(bf16_t, WS_Q) + (size_t)t0 * 1024 + h * 128, 1024, C.tid);
        load_img128(imgB, WSP(bf16_t, WS_WUK) + (size_t)h * 128 * 256 + half * 128, 256, C.tid);
        __syncthreads();
        f32x4 acc[8]; ZERO8(acc);
        trgemm(imgA, imgB, lane, w, acc);
        __syncthreads();
        stage_store_bf16(stg, acc, WSP(bf16_t, WS_QABS) + (size_t)(t0 + 16 * w) * 2048 + h * 256 + half * 128, 2048, lane);
    }
    __syncthreads();
}
__device__ __forceinline__ void p2_gmlp(const Ctx& C) {
    LAS uchar* imgA = C.lds; LAS uchar* imgB = C.lds + 32768; LAS f32x2* stat = (LAS f32x2*)(C.lds + 65536);
    LAS float* stg = (LAS float*)(C.lds) + C.wave * 16 * STG_LD;
    const int lane = C.lane, w = C.wave, tid = C.tid;
    const bf16_t* UV = WSP(bf16_t, WS_UV);
    for (int u = C.bid; u < 64 * NGRP; u += C.G) {
        const int g = u & 7, t0 = (u >> 3) * 128;
        __syncthreads();
        if (tid < 128) { const float* p = WSP(float, WS_LNS) + (size_t)(t0 + tid) * 32; float s = 0.f, ss = 0.f;
#pragma unroll
            for (int j = 0; j < 16; ++j) { s += p[2 * j]; ss += p[2 * j + 1]; }
            const float mean = s * (1.f / GW), var = fmaxf(ss * (1.f / GW) - mean * mean, 0.f);
            stat[tid] = (f32x2){mean, 1.0f / sqrtf(var + EPS)}; }
        load_img128(imgA, WSP(bf16_t, WS_WSM) + (size_t)g * 128 * 128, 128, tid);
        __syncthreads();
#pragma unroll
        for (int i = 0; i < 4; ++i) { const int q = tid + NTHR * i, row = q >> 4, ch = q & 15; const f32x2 st = stat[row];
            const u32x4 v = *(const u32x4*)(UV + (size_t)(t0 + row) * 2048 + 1024 + g * 128 + ch * 8);
            const float* lg = C.in[I_LNG] + g * 128 + ch * 8; const float* lb = C.in[I_LNB] + g * 128 + ch * 8;
            const unsigned vv[4] = {v.x, v.y, v.z, v.w}; unsigned o[4];
#pragma unroll
            for (int j = 0; j < 4; ++j) { const float a = (bf_lo(vv[j]) - st.x) * st.y * lg[2 * j] + lb[2 * j], b = (bf_hi(vv[j]) - st.x) * st.y * lg[2 * j + 1] + lb[2 * j + 1]; o[j] = pk2(a, b); }
            *(LAS u32x4*)(imgB + imgb_off(row, ch)) = (u32x4){o[0], o[1], o[2], o[3]}; }
        __syncthreads();
        f32x4 acc[8]; ZERO8(acc);
        trgemm(imgA, imgB, lane, w, acc);
        __syncthreads();
        stage_acc(stg, acc, lane);
#pragma unroll
        for (int i = 0; i < 4; ++i) { const int q = lane + 64 * i, row = q >> 4, ch = q & 15; const LAS float* s = stg + row * STG_LD + 8 * ch;
            const int tl = 16 * w + row; const float bias = C.in[I_GBS][g * 128 + tl];
            const u32x4 uu = *(const u32x4*)(UV + (size_t)(t0 + tl) * 2048 + g * 128 + ch * 8);
            u32x4 o; o.x = pk2(bf_lo(uu.x) * (s[0] + bias), bf_hi(uu.x) * (s[1] + bias)); o.y = pk2(bf_lo(uu.y) * (s[2] + bias), bf_hi(uu.y) * (s[3] + bias));
            o.z = pk2(bf_lo(uu.z) * (s[4] + bias), bf_hi(uu.z) * (s[5] + bias)); o.w = pk2(bf_lo(uu.w) * (s[6] + bias), bf_hi(uu.w) * (s[7] + bias));
            *(u32x4*)(WSP(bf16_t, WS_MB) + (size_t)(t0 + tl) * 1024 + g * 128 + ch * 8) = o; }
    }
    __syncthreads();
}

#define MFMA32(a, b, c) __builtin_amdgcn_mfma_f32_32x32x16_bf16((a), (b), (c), 0, 0, 0)
__device__ __forceinline__ unsigned f2key(float x) { const unsigned u = __float_as_uint(x); return (u & 0x80000000u) ? ~u : (u | 0x80000000u); }
__device__ __forceinline__ int sbucket(float x) { float f = (x + 8.f) * 64.f; f = fminf(fmaxf(f, 0.f), 1023.f); return (int)f; }
__device__ __forceinline__ void lds_add(LAS unsigned* p, unsigned v) { (void)__hip_atomic_fetch_add(p, v, __ATOMIC_RELAXED, __HIP_MEMORY_SCOPE_WORKGROUP); }
__device__ __forceinline__ unsigned suffix_incl(unsigned v, int lane) {
#pragma unroll
    for (int o = 1; o < 64; o <<= 1) { const unsigned x = __shfl_down(v, o); if (lane + o < 64) v += x; }
    return v;
}
__device__ __forceinline__ void select_row_radix(const Ctx& C, int t, LAS unsigned* hist) {
    const int lane = C.lane, n = t + 1; int* out = WSP(int, WS_IDX) + (size_t)t * TOPK;
    const float* row = WSP(float, WS_SC) + (size_t)t * S;
    unsigned prefix = 0u, krem = (unsigned)TOPK;
#pragma unroll 1
    for (int pass = 0; pass < 4; ++pass) {
        const int shift = 24 - 8 * pass;
#pragma unroll
        for (int i = 0; i < 4; ++i) hist[lane + 64 * i] = 0u;
        for (int i = lane; i < n; i += 64) { const unsigned key = f2key(row[i]); if (pass == 0 || (key >> (shift + 8)) == (prefix >> (shift + 8))) lds_add(&hist[(key >> shift) & 255u], 1u); }
        unsigned h4[4]; unsigned tt = 0;
#pragma unroll
        for (int j = 0; j < 4; ++j) { h4[j] = hist[4 * lane + j]; tt += h4[j]; }
        const unsigned in2 = suffix_incl(tt, lane), ab2 = in2 - tt;
        const bool m2 = ab2 < krem && in2 >= krem;
        int d = 0; unsigned nk = 0;
        if (m2) { unsigned cum = ab2;
#pragma unroll
            for (int j = 3; j >= 0; --j) { if (nk == 0u) { if (cum + h4[j] >= krem) { d = 4 * lane + j; nk = krem - cum; } else cum += h4[j]; } } }
        const unsigned long long mk = __ballot(m2); const int src = __ffsll((long long)mk) - 1; d = __shfl(d, src); krem = __shfl(nk, src);
        prefix |= (unsigned)d << shift;
    }
    const unsigned long long lt = (1ull << lane) - 1ull;
    unsigned cnt = 0, eqc = 0;
    for (int base = 0; base < n; base += 64) { const int i = base + lane; const bool valid = i < n; const unsigned key = valid ? f2key(row[i]) : 0u;
        const bool gt = valid && key > prefix, eq = valid && key == prefix;
        const unsigned long long em = __ballot(eq); const unsigned rank = eqc + (unsigned)__popcll(em & lt);
        const bool take = gt || (eq && rank < krem);
        const unsigned long long tm = __ballot(take); const unsigned pos = cnt + (unsigned)__popcll(tm & lt);
        if (take && pos < (unsigned)TOPK) out[pos] = i;
        cnt += (unsigned)__popcll(tm); eqc += (unsigned)__popcll(em); }
}
constexpr int CAND_CAP = 256;
__device__ __forceinline__ void select_row(const Ctx& C, int t, const LAS unsigned* h, LAS unsigned* cand) {
    const int lane = C.lane, n = t + 1; int* out = WSP(int, WS_IDX) + (size_t)t * TOPK;
    if (n <= TOPK) { for (int j = lane; j < TOPK; j += 64) out[j] = j < n ? j : -1; return; }
    const float* row = WSP(float, WS_SC) + (size_t)t * S;
    unsigned wd[8]; unsigned tot = 0;
#pragma unroll
    for (int j = 0; j < 8; ++j) { wd[j] = h[8 * lane + j]; tot += (wd[j] & 0xffffu) + (wd[j] >> 16); }
    const unsigned incl = suffix_incl(tot, lane), above = incl - tot;
    const bool mine = above < (unsigned)TOPK && incl >= (unsigned)TOPK;
    int bstar = 0; unsigned krem = 0;
    if (mine) { unsigned cum = above;
#pragma unroll
        for (int b = 15; b >= 0; --b) { if (krem == 0u) { const unsigned c = (wd[b >> 1] >> (16 * (b & 1))) & 0xffffu; if (cum + c >= (unsigned)TOPK) { bstar = 16 * lane + b; krem = (unsigned)TOPK - cum; } else cum += c; } } }
    { const unsigned long long mk = __ballot(mine); const int src = __ffsll((long long)mk) - 1; bstar = __shfl(bstar, src); krem = __shfl(krem, src); }
    const unsigned ngt = (unsigned)TOPK - krem;
    const unsigned long long lt = (1ull << lane) - 1ull;
    unsigned cnt = 0, cc = 0;
    f32x4 cur = (4 * lane < n) ? *(const f32x4*)(row + 4 * lane) : (f32x4){0.f, 0.f, 0.f, 0.f};
    for (int base = 0; base < n; base += 256) {
        const int i0 = base + 4 * lane, i1 = i0 + 256;
        const f32x4 nxt = (i1 < n) ? *(const f32x4*)(row + i1) : (f32x4){0.f, 0.f, 0.f, 0.f};
#pragma unroll
        for (int j = 0; j < 4; ++j) { const bool valid = i0 + j < n; const int b = sbucket(cur[j]); const bool gt = valid && b > bstar, eq = valid && b == bstar;
            const unsigned long long m = __ballot(gt); if (gt) { const unsigned pos = cnt + (unsigned)__popcll(m & lt); if (pos < (unsigned)TOPK) out[pos] = i0 + j; } cnt += (unsigned)__popcll(m);
            const unsigned long long me = __ballot(eq); if (eq) { const unsigned p = cc + (unsigned)__popcll(me & lt); if (p < (unsigned)CAND_CAP) { cand[2 * p] = f2key(cur[j]); cand[2 * p + 1] = (unsigned)(i0 + j); } } cc += (unsigned)__popcll(me); }
        cur = nxt;
    }
    if (cc <= (unsigned)CAND_CAP) {
        for (unsigned ci = lane; ci < cc; ci += 64) { const unsigned key = cand[2 * ci], idx = cand[2 * ci + 1]; unsigned rank = 0;
            for (unsigned j = 0; j < cc; ++j) { const unsigned kj = cand[2 * j], ij = cand[2 * j + 1]; rank += (kj > key || (kj == key && ij < idx)) ? 1u : 0u; }
            if (rank < krem) out[ngt + rank] = (int)idx; }
    } else select_row_radix(C, t, cand);
}
constexpr int KT_LD = 144;
__device__ __forceinline__ void p2_indexer(const Ctx& C) {
    LAS uchar* kb = C.lds;
    LAS unsigned* hist = (LAS unsigned*)(C.lds + 36864);
    LAS unsigned* cand = (LAS unsigned*)(C.lds + 36864 + 65536) + C.wave * (2 * CAND_CAP);
    const int lane = C.lane, w = C.wave, tid = C.tid, r = lane & 31, hh = lane >> 5;
    const int tau = (r >> 2) & 1, eta = (r & 3) + 4 * (r >> 3);
    const bf16_t* QI = WSP(bf16_t, WS_QI); const bf16_t* KI = WSP(bf16_t, WS_KIDX); const float* WI = WSP(float, WS_WIDX);
    float* sc = WSP(float, WS_SC);
#pragma unroll 1
    for (int i = C.bid; i < 256; i += C.G) {
        __syncthreads();
        { LAS u32x4* hz = (LAS u32x4*)hist + tid;
#pragma unroll
          for (int j = 0; j < 8; ++j) hz[NTHR * j] = (u32x4){0u, 0u, 0u, 0u}; }
        const int tb0 = 16 * i + 2 * w, tb1 = 16 * (511 - i) + 2 * w;
        const int tmax0 = 16 * i + 15, tmax1 = 16 * (511 - i) + 15;
        bf16x8 a0[4], a1[4]; f32x4 w0[4], w1[4];
#pragma unroll
        for (int ks = 0; ks < 4; ++ks) { a0[ks] = *(const bf16x8*)(QI + (size_t)(tb0 + tau) * 1024 + eta * 64 + 16 * ks + 8 * hh); a1[ks] = *(const bf16x8*)(QI + (size_t)(tb1 + tau) * 1024 + eta * 64 + 16 * ks + 8 * hh); }
#pragma unroll
        for (int q = 0; q < 4; ++q) { w0[q] = *(const f32x4*)(WI + (size_t)(tb0 + hh) * 16 + 4 * q); w1[q] = *(const f32x4*)(WI + (size_t)(tb1 + hh) * 16 + 4 * q); }
        const int ntile = (tmax1 >> 7) + 1;
        const int kr0 = tid >> 3, kc = tid & 7;
        u32x4 pre0 = *(const u32x4*)(KI + (size_t)kr0 * 64 + kc * 8), pre1 = *(const u32x4*)(KI + (size_t)(kr0 + 64) * 64 + kc * 8);
#pragma unroll 1
        for (int kt = 0; kt < ntile; ++kt) {
            LAS uchar* buf = kb + (kt & 1) * 18432;
            *(LAS u32x4*)(buf + kr0 * KT_LD + kc * 16) = pre0; *(LAS u32x4*)(buf + (kr0 + 64) * KT_LD + kc * 16) = pre1;
            __syncthreads();
            if (kt + 1 < ntile) { const bf16_t* kp = KI + (size_t)(128 * (kt + 1)) * 64; pre0 = *(const u32x4*)(kp + (size_t)kr0 * 64 + kc * 8); pre1 = *(const u32x4*)(kp + (size_t)(kr0 + 64) * 64 + kc * 8); }
#pragma unroll 1
            for (int sub = 0; sub < 4; ++sub) {
                const int sbase = 128 * kt + 32 * sub; if (sbase > tmax1) break;
                const int s = sbase + r;
                bf16x8 b[4];
#pragma unroll
                for (int ks = 0; ks < 4; ++ks) b[ks] = *(const LAS bf16x8*)(buf + (32 * sub + r) * KT_LD + (2 * ks + hh) * 16);
                { f32x16 acc;
#pragma unroll
                  for (int q = 0; q < 16; ++q) acc[q] = 0.f;
#pragma unroll
                  for (int ks = 0; ks < 4; ++ks) acc = MFMA32(a1[ks], b[ks], acc);
                  float v = 0.f;
#pragma unroll
                  for (int q = 0; q < 16; ++q) v += w1[q >> 2][q & 3] * fmaxf(acc[q], 0.f);
                  const int t = tb1 + hh;
                  if (s <= t) { sc[(size_t)t * S + s] = v; const int bk = sbucket(v); lds_add(hist + (16 + 2 * w + hh) * 512 + (bk >> 1), 1u << (16 * (bk & 1))); } }
                if (sbase <= tmax0) { f32x16 acc;
#pragma unroll
                  for (int q = 0; q < 16; ++q) acc[q] = 0.f;
#pragma unroll
                  for (int ks = 0; ks < 4; ++ks) acc = MFMA32(a0[ks], b[ks], acc);
                  float v = 0.f;
#pragma unroll
                  for (int q = 0; q < 16; ++q) v += w0[q >> 2][q & 3] * fmaxf(acc[q], 0.f);
                  const int t = tb0 + hh;
                  if (s <= t) { sc[(size_t)t * S + s] = v; const int bk = sbucket(v); lds_add(hist + (2 * w + hh) * 512 + (bk >> 1), 1u << (16 * (bk & 1))); } }
            }
        }
        asm volatile("s_waitcnt vmcnt(0) lgkmcnt(0)" ::: "memory");
        select_row(C, tb0, hist + (2 * w) * 512, cand); select_row(C, tb0 + 1, hist + (2 * w + 1) * 512, cand);
        select_row(C, tb1, hist + (16 + 2 * w) * 512, cand); select_row(C, tb1 + 1, hist + (16 + 2 * w + 1) * 512, cand);
    }
    __syncthreads();
}

__device__ __forceinline__ void p3_attention(const Ctx& C) {
    const int lane = C.lane, w = C.wave, g = lane >> 4, h = lane & 15;
    LAS uchar* img = C.lds;
    LAS float* mx = (LAS float*)(C.lds + LDS_X);
    LAS float* ls = mx + 128;
    LAS uchar* pf = C.lds + LDS_X + 1024;
    const bf16_t* CK = WSP(bf16_t, WS_CKV);
    const float scale = 0.08838834764831845f;
    for (int t = C.bid; t < S; t += C.G) {
        const int myidx = WSP(int, WS_IDX)[(size_t)t * TOPK + 32 * w + (lane & 31)];
#pragma unroll
        for (int i = 0; i < 16; ++i) { const int rl = 2 * i + (lane >> 5); const int key = __shfl(myidx, rl); const int kk = (key < 0 || key > t) ? 0 : key; const int ch32 = lane & 31;
            const u32x4 v = *(const u32x4*)(CK + (size_t)kk * CKV + ch32 * 8);
            *(LAS u32x4*)(img + (ch32 >> 4) * 65536 + imgb_off(32 * w + rl, ch32 & 15)) = v; }
        bf16x8 bq[8]; const bf16_t* qa = WSP(bf16_t, WS_QABS) + (size_t)t * 2048 + (h & 7) * 256 + 8 * g;
#pragma unroll
        for (int kc = 0; kc < 8; ++kc) { bq[kc] = *(const bf16x8*)(qa + 32 * kc); if (h >= 8) bq[kc] = (bf16x8){0, 0, 0, 0, 0, 0, 0, 0}; }
        f32x4 x0 = {0.f, 0.f, 0.f, 0.f}, x1 = {0.f, 0.f, 0.f, 0.f};
        const unsigned rho0 = 32u * w + 8u * (h >> 2) + (h & 3);
#pragma unroll
        for (int kc = 0; kc < 8; ++kc) { const unsigned ch = (4u * kc + g) & 15u; LAS uchar* ib = img + (kc >> 2) * 65536;
            const bf16x8 a0 = *(LAS bf16x8*)(ib + imgb_off(rho0, ch)), a1 = *(LAS bf16x8*)(ib + imgb_off(rho0 + 4u, ch));
            x0 = MFMA16(a0, bq[kc], x0); x1 = MFMA16(a1, bq[kc], x1); }
        float lg[8]; float m = -1e30f;
#pragma unroll
        for (int r = 0; r < 4; ++r) { const int k0 = __shfl(myidx, 8 * g + r), k1 = __shfl(myidx, 8 * g + 4 + r); const bool v0 = k0 >= 0 && k0 <= t, v1 = k1 >= 0 && k1 <= t;
            lg[r] = v0 ? x0[r] * scale : -1e30f; lg[4 + r] = v1 ? x1[r] * scale : -1e30f; m = fmaxf(m, fmaxf(lg[r], lg[4 + r])); }
        m = fmaxf(m, __shfl_xor(m, 16)); m = fmaxf(m, __shfl_xor(m, 32));
        if (g == 0) mx[w * 16 + h] = m;
        __syncthreads();
        float M = mx[h];
#pragma unroll
        for (int ww = 1; ww < 8; ++ww) M = fmaxf(M, mx[ww * 16 + h]);
        float p[8], sum = 0.f;
#pragma unroll
        for (int j = 0; j < 8; ++j) { p[j] = ex2((lg[j] - M) * LOG2E); sum += p[j]; }
        sum += __shfl_xor(sum, 16); sum += __shfl_xor(sum, 32);
        if (g == 0) ls[w * 16 + h] = sum;
        { u32x4 pk; pk.x = pk2(p[0], p[1]); pk.y = pk2(p[2], p[3]); pk.z = pk2(p[4], p[5]); pk.w = pk2(p[6], p[7]); *(LAS u32x4*)(pf + (w * 64 + lane) * 16) = pk; }
        __syncthreads();
        float L = ls[h];
#pragma unroll
        for (int ww = 1; ww < 8; ++ww) L += ls[ww * 16 + h];
        f32x4 z0 = {0.f, 0.f, 0.f, 0.f}, z1 = {0.f, 0.f, 0.f, 0.f};
#pragma unroll
        for (int ks = 0; ks < 8; ++ks) { const bf16x8 a = *(LAS bf16x8*)(pf + (ks * 64 + lane) * 16);
            { const unsigned cc = 2u * w; LAS uchar* ib = img + (cc >> 3) * 65536; const bf16x8 b = trrd8(ib + imgb_tr16(lane, cc & 7u, ks, 0), ib + imgb_tr16(lane, cc & 7u, ks, 1)); z0 = MFMA16(a, b, z0); }
            { const unsigned cc = 2u * w + 1u; LAS uchar* ib = img + (cc >> 3) * 65536; const bf16x8 b = trrd8(ib + imgb_tr16(lane, cc & 7u, ks, 0), ib + imgb_tr16(lane, cc & 7u, ks, 1)); z1 = MFMA16(a, b, z1); } }
        float rl[4];
#pragma unroll
        for (int r = 0; r < 4; ++r) rl[r] = 1.0f / __shfl(L, (4 * g + r) & 15);
        if (g < 2) { bf16_t* o = WSP(bf16_t, WS_OB) + (size_t)t * 2048 + 32 * w + h;
#pragma unroll
            for (int r = 0; r < 4; ++r) { o[(4 * g + r) * 256] = (bf16_t)(pk2(z0[r] * rl[r], 0.f) & 0xffffu); o[(4 * g + r) * 256 + 16] = (bf16_t)(pk2(z1[r] * rl[r], 0.f) & 0xffffu); } }
        __syncthreads();
    }
}
__device__ __forceinline__ void p3_wuv(const Ctx& C) {
    LAS uchar* imgA0 = C.lds; LAS uchar* imgA1 = C.lds + 32768; LAS uchar* imgB0 = C.lds + 65536; LAS uchar* imgB1 = C.lds + 98304;
    LAS float* stg = (LAS float*)(C.lds) + C.wave * 16 * STG_LD;
    const int lane = C.lane, w = C.wave;
    for (int u = C.bid; u < 64 * NH; u += C.G) {
        const int h = u & 7, t0 = (u >> 3) * 128;
        __syncthreads();
        load_img128(imgA0, WSP(bf16_t, WS_OB) + (size_t)t0 * 2048 + h * 256, 2048, C.tid);
        load_img128(imgA1, WSP(bf16_t, WS_OB) + (size_t)t0 * 2048 + h * 256 + 128, 2048, C.tid);
        load_img128(imgB0, WSP(bf16_t, WS_WUV) + (size_t)h * 256 * 128, 128, C.tid);
        load_img128(imgB1, WSP(bf16_t, WS_WUV) + (size_t)h * 256 * 128 + 128 * 128, 128, C.tid);
        __syncthreads();
        f32x4 acc[8]; ZERO8(acc);
        trgemm(imgA0, imgB0, lane, w, acc); trgemm(imgA1, imgB1, lane, w, acc);
        __syncthreads();
        stage_store_bf16(stg, acc, WSP(bf16_t, WS_AB) + (size_t)(t0 + 16 * w) * 1024 + h * 128, 1024, lane);
    }
    __syncthreads();
}

struct EpiGateA {
    static constexpr bool PERM = true, AFTER_DRAIN = false;
    float* TMP; const bf16_t* GATE;
    __device__ __forceinline__ void operator()(const f32x4 (&acc)[2][2][4][2], const pg8::Unit& u, int wr, int wc, int fr, int fq) const {
        const int row0 = u.pm * 256 + wr * 64 + fr, col0 = u.pn * 256 + wc * 32 + 8 * fq;
#pragma unroll
        for (int ai = 0; ai < 2; ++ai)
#pragma unroll
            for (int m = 0; m < 4; ++m) { const size_t row = (size_t)(row0 + ai * 128 + m * 16);
#pragma unroll
                for (int bj = 0; bj < 2; ++bj) { const u32x4 gv = *(const u32x4*)(GATE + row * 4096 + col0 + bj * 128); const f32x4 v0 = acc[ai][bj][m][0], v1 = acc[ai][bj][m][1];
                    float* p = TMP + row * D + col0 + bj * 128;
                    *(f32x4*)p = (f32x4){v0[0] * bf_lo(gv.x), v0[1] * bf_hi(gv.x), v0[2] * bf_lo(gv.y), v0[3] * bf_hi(gv.y)};
                    *(f32x4*)(p + 4) = (f32x4){v1[0] * bf_lo(gv.z), v1[1] * bf_hi(gv.z), v1[2] * bf_lo(gv.w), v1[3] * bf_hi(gv.w)}; } }
    }
};
struct EpiGateB {
    static constexpr bool PERM = true, AFTER_DRAIN = false;
    const float* TMP; const bf16_t* GATE; bf16_t* MG;
    __device__ __forceinline__ void operator()(const f32x4 (&acc)[2][2][4][2], const pg8::Unit& u, int wr, int wc, int fr, int fq) const {
        const int row0 = u.pm * 256 + wr * 64 + fr, col0 = u.pn * 256 + wc * 32 + 8 * fq;
#pragma unroll
        for (int ai = 0; ai < 2; ++ai)
#pragma unroll
            for (int m = 0; m < 4; ++m) { const size_t row = (size_t)(row0 + ai * 128 + m * 16);
#pragma unroll
                for (int bj = 0; bj < 2; ++bj) { const u32x4 gv = *(const u32x4*)(GATE + row * 4096 + 2048 + col0 + bj * 128); const f32x4 v0 = acc[ai][bj][m][0], v1 = acc[ai][bj][m][1];
                    const float* p = TMP + row * D + col0 + bj * 128; const f32x4 t0 = *(const f32x4*)p, t1 = *(const f32x4*)(p + 4);
                    u32x4 w; w.x = pk2(t0[0] + v0[0] * bf_lo(gv.x), t0[1] + v0[1] * bf_hi(gv.x)); w.y = pk2(t0[2] + v0[2] * bf_lo(gv.y), t0[3] + v0[3] * bf_hi(gv.y));
                    w.z = pk2(t1[0] + v1[0] * bf_lo(gv.z), t1[1] + v1[1] * bf_hi(gv.z)); w.w = pk2(t1[2] + v1[2] * bf_lo(gv.w), t1[3] + v1[3] * bf_hi(gv.w));
                    *(u32x4*)(MG + row * D + col0 + bj * 128) = w; } }
    }
};
struct EpiRes {
    static constexpr bool PERM = false, AFTER_DRAIN = false;
    const float* X; float* H;
    __device__ __forceinline__ void operator()(const f32x4 (&acc)[2][2][4][2], const pg8::Unit& u, int wr, int wc, int fr, int fq) const {
        const int row0 = u.pm * 256 + wr * 64 + fr, col0 = u.pn * 256 + wc * 32 + 4 * fq;
#pragma unroll
        for (int ai = 0; ai < 2; ++ai)
#pragma unroll
            for (int m = 0; m < 4; ++m) { const size_t off = (size_t)(row0 + ai * 128 + m * 16) * D + col0;
#pragma unroll
                for (int bj = 0; bj < 2; ++bj)
#pragma unroll
                    for (int n = 0; n < 2; ++n) *(f32x4*)(H + off + bj * 128 + n * 16) = *(const f32x4*)(X + off + bj * 128 + n * 16) + acc[ai][bj][m][n]; }
    }
};
__device__ __forceinline__ void p6_router(const Ctx& C) {
    LAS float* part = (LAS float*)C.lds;
    LAS float* lgt = (LAS float*)(C.lds + 81920);
    LAS float* rs = (LAS float*)(C.lds + 81920 + 10240);
    const int lane = C.lane, w = C.wave, tid = C.tid;
    const float* H = C.out; const float* WG = C.in[I_WGRP]; const float* WR = C.in[I_WRT];
    unsigned* cnt = WSP(unsigned, WS_CTL) + CW_CNT;
#pragma unroll 1
    for (int u = C.bid; u < S / 32; u += C.G) {
        const int t0 = 32 * u;
        __syncthreads();
#pragma unroll 1
        for (int rr = 0; rr < 4; ++rr) { const int t = t0 + 4 * w + rr;
            const f32x4* hr = (const f32x4*)(H + (size_t)t * D) + lane; const f32x4* gr = (const f32x4*)C.in[I_N2G] + lane;
            f32x4 v[8]; float ss = 0.f;
#pragma unroll
            for (int j = 0; j < 8; ++j) { v[j] = hr[64 * j]; ss += (v[j].x * v[j].x + v[j].y * v[j].y) + (v[j].z * v[j].z + v[j].w * v[j].w); }
            const float rstd = 1.0f / sqrtf(wave_sum(ss) * (1.f / D) + EPS);
            u32x2* o = WSP(u32x2, WS_N1) + (size_t)t * (D / 4) + lane;
#pragma unroll
            for (int j = 0; j < 8; ++j) { const f32x4 g = gr[64 * j]; u32x2 ww; ww.x = pk2(v[j].x * rstd * g.x, v[j].y * rstd * g.y); ww.y = pk2(v[j].z * rstd * g.z, v[j].w * rstd * g.w); o[64 * j] = ww; }
            if (lane == 0) rs[4 * w + rr] = rstd; }
        {   f32x4 acc[2][5];
#pragma unroll
            for (int a = 0; a < 2; ++a)
#pragma unroll
                for (int b = 0; b < 5; ++b) acc[a][b] = (f32x4){0.f, 0.f, 0.f, 0.f};
            const int c = lane & 15, kq = lane >> 4, kb = 256 * w + kq;
            const float* a0p = H + (size_t)(t0 + c) * D + kb; const float* a1p = a0p + (size_t)16 * D;
            const float* g2p = C.in[I_N2G] + kb; const float* bgp = WG + (size_t)kb * 8 + (c & 7); const float* brp = WR + (size_t)kb * 64 + c;
#pragma unroll 4
            for (int k0 = 0; k0 < 256; k0 += 4) {
                const float a0 = a0p[k0], a1 = a1p[k0], gg = g2p[k0];
                float b[5]; b[0] = (c < 8) ? bgp[(size_t)k0 * 8] * gg : 0.f;
#pragma unroll
                for (int cb = 1; cb < 5; ++cb) b[cb] = brp[(size_t)k0 * 64 + (cb - 1) * 16] * gg;
#pragma unroll
                for (int cb = 0; cb < 5; ++cb) { acc[0][cb] = __builtin_amdgcn_mfma_f32_16x16x4f32(a0, b[cb], acc[0][cb], 0, 0, 0); acc[1][cb] = __builtin_amdgcn_mfma_f32_16x16x4f32(a1, b[cb], acc[1][cb], 0, 0, 0); }
            }
#pragma unroll
            for (int rb = 0; rb < 2; ++rb)
#pragma unroll
                for (int cb = 0; cb < 5; ++cb)
#pragma unroll
                    for (int i = 0; i < 4; ++i) part[(w * 32 + 16 * rb + 4 * kq + i) * 80 + 16 * cb + c] = acc[rb][cb][i];
        }
        __syncthreads();
        for (int o = tid; o < 32 * 80; o += NTHR) { const int tok = o / 80; float s = 0.f;
#pragma unroll
            for (int ww = 0; ww < 8; ++ww) s += part[ww * 2560 + o];
            lgt[o] = s * rs[tok]; }
        __syncthreads();
        if (tid < 32) { const int t = t0 + tid; const LAS float* l = lgt + tid * 80;
            int gi = 0; float gm = l[0] + C.in[I_BGRP][0];
#pragma unroll
            for (int i = 1; i < 8; ++i) { const float v = l[i] + C.in[I_BGRP][i]; if (v > gm) { gm = v; gi = i; } }
            float den = 0.f;
#pragma unroll
            for (int i = 0; i < 8; ++i) den += __expf(l[i] + C.in[I_BGRP][i] - gm);
            const float gval = 1.0f / den;
            const LAS float* el = l + 16 + 8 * gi; const float* be = C.in[I_BRT] + 8 * gi;
            int i0 = 0; float v0 = el[0] + be[0];
#pragma unroll
            for (int i = 1; i < 8; ++i) { const float v = el[i] + be[i]; if (v > v0) { v0 = v; i0 = i; } }
            int i1 = 0; float v1 = -3.0e38f;
#pragma unroll
            for (int i = 0; i < 8; ++i) { const float v = el[i] + be[i]; if (i != i0 && v > v1) { v1 = v; i1 = i; } }
            const float q0 = 1.0f / (1.0f + __expf(v1 - v0)), q1 = 1.0f - q0;
            const int e0 = 8 * gi + i0, e1 = 8 * gi + i1;
            const int p0 = (int)atomicAdd(cnt + e0, 1u), p1 = (int)atomicAdd(cnt + e1, 1u);
            int* list = WSP(int, WS_LIST); float* cw = WSP(float, WS_CWT);
            if (p0 < S) list[e0 * S + p0] = 2 * t; if (p1 < S) list[e1 * S + p1] = 2 * t + 1;
            cw[2 * t] = gval * q0; cw[2 * t + 1] = gval * q1; }
    }
    __syncthreads();
}
template <int MODE> __device__ __forceinline__ void moe_phase(const Ctx& C) {
    constexpr int K = (MODE == 1) ? D : FF, NSL = (MODE == 1) ? 8 : 16, NKS = K / 64;
    constexpr int ABYTES = 256 * 144, BBYTES = 64 * 256, BUF = ABYTES + BBYTES;
    LAS uchar* lds = C.lds; LAS int* rid = (LAS int*)(lds + 2 * BUF);
    const int tid = C.tid, lane = C.lane, w = C.wave, g = lane >> 4, c16 = lane & 15;
    const unsigned* cnt = WSP(unsigned, WS_CTL) + CW_CNT; const int* list = WSP(int, WS_LIST);
    const bf16_t* N2 = WSP(bf16_t, WS_N1); bf16_t* HID = WSP(bf16_t, WS_HID); bf16_t* Y = WSP(bf16_t, WS_Y);
    const int n4 = 4 * (tid & 31), kr = tid >> 5;
    const unsigned bw_off = imgb_off((unsigned)kr, (unsigned)(n4 >> 3)) + 8u * ((n4 >> 2) & 1);
    const unsigned aw_off = (unsigned)((tid >> 3) * 144 + (tid & 7) * 16);
#pragma unroll 1
    for (int u = C.bid; u < NE * NSL; u += C.G) {
        const int e = u / NSL, sl = u - e * NSL;
        int Me = (int)cnt[e]; if (Me > S) Me = S;
        const float* bsrc; size_t ldb;
        if (MODE == 1) { bsrc = (n4 < 64 ? C.in[I_WEG] : C.in[I_WEU]) + (size_t)e * D * FF + sl * 64 + (n4 & 63); ldb = FF; }
        else { bsrc = C.in[I_WED] + (size_t)e * FF * D + sl * 128 + n4; ldb = D; }
        bsrc += (size_t)kr * ldb;
#pragma unroll 1
        for (int m0 = 0; m0 < Me; m0 += 256) {
            __syncthreads();
            if (tid < 256) { const int r = m0 + tid; rid[tid] = list[e * S + (r < Me ? r : Me - 1)]; }
            __syncthreads();
            const bf16_t* ap[4];
#pragma unroll
            for (int j = 0; j < 4; ++j) { const int id = rid[(tid >> 3) + 64 * j]; ap[j] = ((MODE == 1) ? N2 + (size_t)(id >> 1) * D : HID + (size_t)id * FF) + (tid & 7) * 8; }
            u32x4 ra[4]; f32x4 rb[4];
#pragma unroll
            for (int j = 0; j < 4; ++j) { ra[j] = *(const u32x4*)ap[j]; rb[j] = *(const f32x4*)(bsrc + (size_t)(16 * j) * ldb); }
#pragma unroll
            for (int j = 0; j < 4; ++j) { *(LAS u32x4*)(lds + aw_off + 9216 * j) = ra[j]; *(LAS u32x2*)(lds + ABYTES + bw_off + 4096 * j) = (u32x2){pk2(rb[j].x, rb[j].y), pk2(rb[j].z, rb[j].w)}; }
            __syncthreads();
            f32x4 acc[2][8];
#pragma unroll
            for (int a = 0; a < 2; ++a)
#pragma unroll
                for (int b = 0; b < 8; ++b) acc[a][b] = (f32x4){0.f, 0.f, 0.f, 0.f};
#pragma unroll 2
            for (int ks = 0; ks < NKS; ++ks) {
                LAS uchar* Ab = lds + (ks & 1) * BUF; LAS uchar* Bb = Ab + ABYTES; LAS uchar* An = lds + ((ks + 1) & 1) * BUF;
                const bool more = ks + 1 < NKS;
                if (more) {
#pragma unroll
                    for (int j = 0; j < 4; ++j) { ra[j] = *(const u32x4*)(ap[j] + 64 * (ks + 1)); rb[j] = *(const f32x4*)(bsrc + (size_t)(64 * (ks + 1) + 16 * j) * ldb); } }
#pragma unroll
                for (int s = 0; s < 2; ++s) {
                    const bf16x8 a0 = *(const LAS bf16x8*)(Ab + (32 * w + c16) * 144 + (4 * s + g) * 16), a1 = *(const LAS bf16x8*)(Ab + (32 * w + 16 + c16) * 144 + (4 * s + g) * 16);
#pragma unroll
                    for (int c = 0; c < 8; ++c) { const bf16x8 b = trrd8(Bb + imgb_tr16(lane, c, s, 0), Bb + imgb_tr16(lane, c, s, 1)); acc[0][c] = MFMA16(a0, b, acc[0][c]); acc[1][c] = MFMA16(a1, b, acc[1][c]); }
                }
                if (more) {
#pragma unroll
                    for (int j = 0; j < 4; ++j) { *(LAS u32x4*)(An + aw_off + 9216 * j) = ra[j]; *(LAS u32x2*)(An + ABYTES + bw_off + 4096 * j) = (u32x2){pk2(rb[j].x, rb[j].y), pk2(rb[j].z, rb[j].w)}; } }
                __syncthreads();
            }
            LAS bf16_t* stg = (LAS bf16_t*)(lds + w * 8192);
            if (MODE == 1) {
                const float* cwp = WSP(float, WS_CWT);
#pragma unroll
                for (int rbk = 0; rbk < 2; ++rbk)
#pragma unroll
                    for (int r = 0; r < 4; ++r) { const int rowl = 16 * rbk + 4 * g + r; const float cw = cwp[rid[32 * w + rowl]];
#pragma unroll
                        for (int c = 0; c < 4; ++c) stg[rowl * 64 + 16 * c + c16] = (bf16_t)(pk2(silu_(acc[rbk][c][r]) * acc[rbk][c + 4][r] * cw, 0.f) & 0xffffu); }
#pragma unroll
                for (int i = 0; i < 4; ++i) { const int q = lane + 64 * i, row = q >> 3, ch = q & 7;
                    if (m0 + 32 * w + row < Me) *(u32x4*)(HID + (size_t)rid[32 * w + row] * FF + sl * 64 + ch * 8) = *(const LAS u32x4*)(stg + row * 64 + ch * 8); }
            } else {
#pragma unroll
                for (int rbk = 0; rbk < 2; ++rbk)
#pragma unroll
                    for (int r = 0; r < 4; ++r) { const int rowl = 16 * rbk + 4 * g + r;
#pragma unroll
                        for (int c = 0; c < 8; ++c) stg[rowl * 128 + 16 * c + c16] = (bf16_t)(pk2(acc[rbk][c][r], 0.f) & 0xffffu); }
#pragma unroll
                for (int i = 0; i < 8; ++i) { const int q = lane + 64 * i, row = q >> 4, ch = q & 15;
                    if (m0 + 32 * w + row < Me) *(u32x4*)(Y + (size_t)rid[32 * w + row] * D + sl * 128 + ch * 8) = *(const LAS u32x4*)(stg + row * 128 + ch * 8); }
            }
        }
    }
    __syncthreads();
}
__device__ __forceinline__ void p9_final(const Ctx& C) {
    const int gw = C.bid * NWAVE + C.wave, NGW = C.G * NWAVE, lane = C.lane;
    const bf16_t* Y = WSP(bf16_t, WS_Y);
    for (int t = gw; t < S; t += NGW) {
        f32x4* hr = (f32x4*)(C.out + (size_t)t * D) + lane; const f32x4* gr = (const f32x4*)C.in[I_NFG] + lane;
        const u32x2* y0 = (const u32x2*)(Y + (size_t)(2 * t) * D) + lane; const u32x2* y1 = (const u32x2*)(Y + (size_t)(2 * t + 1) * D) + lane;
        f32x4 v[8]; float ss = 0.f;
#pragma unroll
        for (int j = 0; j < 8; ++j) { const f32x4 hv = hr[64 * j]; const u32x2 a = y0[64 * j], b = y1[64 * j];
            v[j] = (f32x4){hv.x + (bf_lo(a.x) + bf_lo(b.x)), hv.y + (bf_hi(a.x) + bf_hi(b.x)), hv.z + (bf_lo(a.y) + bf_lo(b.y)), hv.w + (bf_hi(a.y) + bf_hi(b.y))};
            ss += (v[j].x * v[j].x + v[j].y * v[j].y) + (v[j].z * v[j].z + v[j].w * v[j].w); }
        const float rstd = 1.0f / sqrtf(wave_sum(ss) * (1.f / D) + EPS);
#pragma unroll
        for (int j = 0; j < 8; ++j) { const f32x4 g = gr[64 * j]; hr[64 * j] = (f32x4){v[j].x * rstd * g.x, v[j].y * rstd * g.y, v[j].z * rstd * g.z, v[j].w * rstd * g.w}; }
    }
}

#ifndef MK_PROBE
#define MK_PROBE 0
#endif
struct Args { const float* in[22]; float* out; unsigned char* ws; int lo, hi, li, pad; };
constexpr int NPHASE = 11;
}

__global__ void __launch_bounds__(512, 2) mk_fwd(mk::Args a) {
    using namespace mk;
    extern __shared__ __attribute__((aligned(16))) unsigned char lds_raw[];
    Ctx C; C.lds = (LAS uchar*)lds_raw; C.tid = threadIdx.x; C.lane = C.tid & 63; C.wave = __builtin_amdgcn_readfirstlane(C.tid >> 6); C.G = gridDim.x; C.bid = blockIdx.x;
#pragma unroll
    for (int i = 0; i < 22; ++i) C.in[i] = a.in[i];
    C.out = a.out; C.ws = a.ws;
    volatile LAS unsigned* misc = (volatile LAS unsigned*)(C.lds + LDS_MISC);
    if (C.tid < 64) misc[C.tid] = 0u;
    __syncthreads();
    XcdBarrier bar = xcd_barrier_post((unsigned*)(C.ws + WS_CTL) + CW_BAR + a.li * XCD_BAR_WORDS, misc + 8);
    const int lo = a.lo, hi = a.hi;
#define IN(k) (lo <= (k) && (k) < hi)
#define SEAM(k) do { if (IN(k) && IN((k) + 1)) xcd_barrier(bar); } while (0)
    LAS unsigned char* stage = (LAS unsigned char*)lds_raw;

    if (IN(0)) { p0_prologue(C);
#if MK_PROBE == 1
        p0_prologue(C);
#endif
    }
    SEAM(0);
    if (IN(1)) {
        pg8::Gemm g{WSP(bf16_t, WS_N1), WSP(bf16_t, WS_WINT), S, NPROJ, D}; pg8::StaticOrder so; so.init(S, NPROJ, C.G, C.bid);
        EpiProj E{WSP(bf16_t, WS_Q), WSP(bf16_t, WS_QI), WSP(bf16_t, WS_UV), WSP(bf16_t, WS_GATE), WSP(bf16_t, WS_KIDX), WSP(float, WS_CKVF), WSP(float, WS_LNS), WSP(float, WS_WIDX)};
        pg8::gemm_phase<EpiProj, pg8::StaticOrder, true, true>(stage, g, so, E);
#if MK_PROBE == 5
        __syncthreads(); pg8::gemm_phase<EpiProj, pg8::StaticOrder, true, true>(stage, g, so, E);
#endif
    }
    SEAM(1);
    if (IN(2)) { p2_ckv_norm(C); p2_qabs(C); p2_gmlp(C); p2_indexer(C);
#if MK_PROBE == 2
        p2_indexer(C);
#endif
#if MK_PROBE == 4
        p2_ckv_norm(C); p2_qabs(C); p2_gmlp(C);
#endif
    }
    SEAM(2);
    if (IN(3)) { p3_attention(C);
#if MK_PROBE == 3
        p3_attention(C);
#endif
    }
    SEAM(3);
    if (IN(4)) p3_wuv(C);
    SEAM(4);
    if (IN(5)) {
        { pg8::Gemm g{WSP(bf16_t, WS_AB), WSP(bf16_t, WS_WAT), S, D, 1024}; pg8::StaticOrder so; so.init(S, D, C.G, C.bid);
          EpiGateA E{WSP(float, WS_QABS), WSP(bf16_t, WS_GATE)};
          pg8::gemm_phase<EpiGateA, pg8::StaticOrder, true, true>(stage, g, so, E); }
        __syncthreads();
        { pg8::Gemm g{WSP(bf16_t, WS_MB), WSP(bf16_t, WS_WBT), S, D, 1024}; pg8::StaticOrder so; so.init(S, D, C.G, C.bid);
          EpiGateB E{WSP(float, WS_QABS), WSP(bf16_t, WS_GATE), WSP(bf16_t, WS_N1)};
          pg8::gemm_phase<EpiGateB, pg8::StaticOrder, true, true>(stage, g, so, E); }
    }
    SEAM(5);
    if (IN(6)) {
        pg8::Gemm g{WSP(bf16_t, WS_N1), WSP(bf16_t, WS_WOT), S, D, D}; pg8::StaticOrder so; so.init(S, D, C.G, C.bid);
        EpiRes E{C.in[I_X], C.out};
        pg8::gemm_phase<EpiRes, pg8::StaticOrder, true, true>(stage, g, so, E);
    }
    SEAM(6);
    if (IN(7)) p6_router(C);
    SEAM(7);
    if (IN(8)) moe_phase<1>(C);
    SEAM(8);
    if (IN(9)) moe_phase<2>(C);
    SEAM(9);
    if (IN(10)) p9_final(C);
#undef IN
#undef SEAM
}

#ifndef MK_SPLIT
#define MK_SPLIT 0
#endif
extern "C" void kernel_launch(void* const* d_in, const int* in_sizes, int n_in, void* d_out, int out_size, void* d_ws, size_t ws_size, hipStream_t stream) {
    using namespace mk;
    static int grid = 0;
    if (grid == 0) {
        int dev = 0, cus = 0, per_cu = 0;
        if (n_in != 22 || ws_size < WS_END) { fprintf(stderr, "kernel_launch: unexpected n_in %d / ws_size %zu (need %zu)\n", n_in, ws_size, (size_t)WS_END); }
        if (hipGetDevice(&dev) != hipSuccess || hipDeviceGetAttribute(&cus, hipDeviceAttributeMultiprocessorCount, dev) != hipSuccess) { fprintf(stderr, "kernel_launch: device query failed\n"); grid = -1; return; }
        if (hipFuncSetAttribute((const void*)mk_fwd, hipFuncAttributeMaxDynamicSharedMemorySize, LDS_BYTES) != hipSuccess) { fprintf(stderr, "kernel_launch: hipFuncSetAttribute failed\n"); grid = -1; return; }
        if (hipOccupancyMaxActiveBlocksPerMultiprocessor(&per_cu, (const void*)mk_fwd, NTHR, LDS_BYTES) != hipSuccess || per_cu < 1) fprintf(stderr, "kernel_launch: occupancy query reports %d\n", per_cu);
        (void)hipGetLastError();
        grid = cus;
    }
    if (grid < 0) return;
    (void)hipMemsetAsync((char*)d_ws + WS_CTL, 0, CTL_BYTES, stream);
    Args a{};
    for (int i = 0; i < 22; ++i) a.in[i] = (const float*)d_in[i];
    a.out = (float*)d_out; a.ws = (unsigned char*)d_ws; a.pad = 0;
#if MK_SPLIT
    for (int p = 0; p < NPHASE; ++p) { a.lo = p; a.hi = p + 1; a.li = 0; hipLaunchKernelGGL(mk_fwd, dim3(grid), dim3(NTHR), LDS_BYTES, stream, a); }
#else
    a.lo = 0; a.hi = NPHASE; a.li = 0;
    hipLaunchKernelGGL(mk_fwd, dim3(grid), dim3(NTHR), LDS_BYTES, stream, a);
#endif
}
```

```cpp
#include <hip/hip_runtime.h>
#include <cstdio>
#include <cstdint>
namespace pg8 {
#define PG8_LAS __attribute__((address_space(3)))
typedef unsigned short bf16_t;
typedef short bf16x8 __attribute__((ext_vector_type(8)));
typedef float f32x4 __attribute__((ext_vector_type(4)));
typedef unsigned u32x4 __attribute__((ext_vector_type(4)));
constexpr int BM = 256, BK = 64, HALF = 128, HTB = HALF * BK * 2  , STAGE_BYTES = 8 * HTB, NXCD = 8, WGM = 8;

__host__ __device__ __forceinline__ int lds_byte(int r, int c) { const int st = (r >> 4) * 2 + (c >> 5), rr = r & 15, cc = c & 31, ob = rr * 64 + cc * 2; return st * 1024 + (ob ^ (((ob >> 9) & 1) << 5)); }
__host__ __device__ __forceinline__ void stage_rc(int b, int& R, int& C) { const int st = b / 1024, sb = b % 1024, swz = sb ^ (((sb >> 9) & 1) << 5); R = (st >> 1) * 16 + swz / 64; C = (st & 1) * 32 + (swz % 64) / 2; }
__host__ __device__ __forceinline__ int perm32(int rho) { const int n = rho >> 4, i = rho & 15; return 8 * (i >> 2) + 4 * n + (i & 3); }

struct Unit { int pm, pn; };
struct Gemm { const bf16_t* A; const bf16_t* Bt; int M, N, K; };

struct StaticOrder {
    int nM, nN, nwg, G, c;
    __host__ __device__ void init(int M, int N, int G_, int c_) { nM = M / BM; nN = N / BM; nwg = nM * nN; G = G_; c = c_; }
    __host__ __device__ bool next(int i, Unit& u) const {
        const long L = (long)i * G + c; if (L >= nwg) return false;
        int wgid = (int)L; { const int q = nwg / NXCD, r = nwg % NXCD, xcd = wgid % NXCD, off = wgid / NXCD; wgid = (xcd < r ? xcd * (q + 1) : r * (q + 1) + (xcd - r) * q) + off; }
        const int nig = WGM * nN, gid = wgid / nig, fm = gid * WGM, gsz = (nM - fm) < WGM ? (nM - fm) : WGM;
        u.pm = fm + ((wgid % nig) % gsz); u.pn = (wgid % nig) / gsz; return true;
    }
    __device__ __forceinline__ void a_ready(const Unit&) const {}
    __device__ __forceinline__ void done(const Unit&) const {}
};

template <class Epi, class Sched, bool ALIGN_EPI = false, bool SP2 = false>
__device__ __forceinline__ void gemm_phase(PG8_LAS unsigned char* lds, const Gemm g, const Sched& S, const Epi& E) {
    const int tid = threadIdx.x, wid = __builtin_amdgcn_readfirstlane(tid >> 6), lane = tid & 63, wr = wid >> 2, wc = wid & 3, fr = lane & 15, fq = lane >> 4;
    const int K = g.K, nt = K / BK;
    unsigned voffA[2], voffB[2];
#pragma unroll
    for (int i = 0; i < 2; ++i) { int R, C; stage_rc(tid * 16 + i * 8192, R, C); const int Rb = Epi::PERM ? ((R & ~31) + perm32(R & 31)) : R;
        voffA[i] = (unsigned)(R * K + C) * 2u; voffB[i] = (unsigned)(Rb * K + C) * 2u; }
    const size_t kstep = (size_t)(BK * 2);
    const size_t hstep = (size_t)HALF * K * 2;
    const size_t tstep = 2 * hstep;
    const unsigned ldsw = (unsigned)wid * 1024u;
    const int aoff = lds_byte(wr * 64 + fr, fq * 8), boff = lds_byte(wc * 32 + fr, fq * 8);
#define PG8_SA(b, h) (((b) * 2 + (h)) * HTB)
#define PG8_SB(b, h) ((4 + (b) * 2 + (h)) * HTB)
#define PG8_STAGE(bufoff, gbase, voff) do { _Pragma("unroll") for (int _i = 0; _i < 2; ++_i) \
        __builtin_amdgcn_global_load_lds((const unsigned*)((const char*)(gbase) + (voff)[_i]), (PG8_LAS unsigned*)(lds + (bufoff) + ldsw + _i * 8192), 16, 0, 0); } while (0)
#define PG8_LDA(dst, b, h) do { _Pragma("unroll") for (int m = 0; m < 4; ++m) _Pragma("unroll") for (int k = 0; k < 2; ++k) dst[m][k] = *(const PG8_LAS bf16x8*)(lds + PG8_SA(b, h) + aoff + m * 2048 + k * 1024); } while (0)
#define PG8_LDB(dst, b, h) do { _Pragma("unroll") for (int n = 0; n < 2; ++n) _Pragma("unroll") for (int k = 0; k < 2; ++k) dst[n][k] = *(const PG8_LAS bf16x8*)(lds + PG8_SB(b, h) + boff + n * 2048 + k * 1024); } while (0)
#define PG8_MMA(ai, bj, At, Bt) do { __builtin_amdgcn_s_setprio(1); _Pragma("unroll") for (int m = 0; m < 4; ++m) _Pragma("unroll") for (int n = 0; n < 2; ++n) _Pragma("unroll") for (int k = 0; k < 2; ++k) \
        acc[ai][bj][m][n] = __builtin_amdgcn_mfma_f32_16x16x32_bf16(Bt[n][k], At[m][k], acc[ai][bj][m][n], 0, 0, 0); __builtin_amdgcn_s_setprio(0); } while (0)
#define PG8_WAIT_V(n) asm volatile("s_waitcnt vmcnt(" #n ")" ::: "memory")
#define PG8_WAIT_L(n) asm volatile("s_waitcnt lgkmcnt(" #n ")" ::: "memory")
#define PG8_BAR __builtin_amdgcn_s_barrier()
#define PG8_SCHED __builtin_amdgcn_sched_barrier(0)
    Unit cur, nxt; int ui = 0;
    if (!S.next(0, cur)) return;
    f32x4 acc[2][2][4][2];
#pragma unroll
    for (int a = 0; a < 2; ++a)
#pragma unroll
        for (int b = 0; b < 2; ++b)
#pragma unroll
            for (int m = 0; m < 4; ++m)
#pragma unroll
                for (int n = 0; n < 2; ++n) acc[a][b][m][n] = (f32x4){0.f, 0.f, 0.f, 0.f};
    bf16x8 At[4][2], B0[2][2], B1[2][2];
    const char* cA = (const char*)g.A + (size_t)cur.pm * tstep; const char* cB = (const char*)g.Bt + (size_t)cur.pn * tstep;
    S.a_ready(cur);
    if constexpr (SP2) {
        PG8_STAGE(PG8_SB(0, 0), cB, voffB); PG8_STAGE(PG8_SB(0, 1), cB + hstep, voffB); PG8_STAGE(PG8_SA(0, 0), cA, voffA); PG8_STAGE(PG8_SA(0, 1), cA + hstep, voffA);
        if (wr == 1) PG8_BAR;
        PG8_WAIT_V(2); PG8_BAR;
        PG8_STAGE(PG8_SB(1, 0), cB + kstep, voffB); PG8_STAGE(PG8_SA(1, 0), cA + kstep, voffA); PG8_STAGE(PG8_SB(1, 1), cB + hstep + kstep, voffB);
        PG8_WAIT_V(6); PG8_BAR;
    } else {
        PG8_STAGE(PG8_SB(0, 0), cB, voffB); PG8_STAGE(PG8_SA(0, 0), cA, voffA); PG8_STAGE(PG8_SB(0, 1), cB + hstep, voffB); PG8_STAGE(PG8_SA(0, 1), cA + hstep, voffA);
        if (wr == 1) PG8_BAR;
        PG8_WAIT_V(4); PG8_BAR;
        PG8_STAGE(PG8_SB(1, 0), cB + kstep, voffB); PG8_STAGE(PG8_SA(1, 0), cA + kstep, voffA); PG8_STAGE(PG8_SB(1, 1), cB + hstep + kstep, voffB);
        PG8_WAIT_V(6); PG8_BAR;
    }
    for (;;) {
        const bool has_next = S.next(ui + 1, nxt);
        const char* nA = has_next ? (const char*)g.A + (size_t)nxt.pm * tstep : cA; const char* nB = has_next ? (const char*)g.Bt + (size_t)nxt.pn * tstep : cB;
        for (int t = 0; t < nt; t += 2) {
            const bool last = (t == nt - 2);
            const char* a1 = cA + (size_t)(t + 1) * kstep;
            const char* a2 = last ? nA : cA + (size_t)(t + 2) * kstep; const char* b2 = last ? nB : cB + (size_t)(t + 2) * kstep;
            const char* a3 = a2 + kstep; const char* b3 = b2 + kstep;
            if (last && has_next) S.a_ready(nxt);
            if constexpr (SP2) {
            PG8_LDB(B0, 0, 0); PG8_LDB(B1, 0, 1); PG8_SCHED; PG8_LDA(At, 0, 0); PG8_STAGE(PG8_SA(1, 1), a1 + hstep, voffA);
            PG8_WAIT_V(8); PG8_WAIT_L(0); PG8_BAR; PG8_MMA(0, 0, At, B0); PG8_MMA(0, 1, At, B1); PG8_BAR; PG8_SCHED;
            PG8_LDA(At, 0, 1); PG8_STAGE(PG8_SB(0, 0), b2, voffB); PG8_STAGE(PG8_SB(0, 1), b2 + hstep, voffB); PG8_STAGE(PG8_SA(0, 0), a2, voffA);
            PG8_WAIT_V(8); PG8_WAIT_L(0); PG8_BAR; PG8_MMA(1, 0, At, B0); PG8_MMA(1, 1, At, B1); PG8_BAR; PG8_SCHED;
            PG8_LDB(B0, 1, 0); PG8_LDB(B1, 1, 1); PG8_SCHED; PG8_LDA(At, 1, 0); PG8_STAGE(PG8_SA(0, 1), a2 + hstep, voffA);
            PG8_WAIT_V(8); PG8_WAIT_L(0); PG8_BAR; PG8_MMA(0, 0, At, B0); PG8_MMA(0, 1, At, B1); PG8_BAR; PG8_SCHED;
            PG8_LDA(At, 1, 1); PG8_STAGE(PG8_SB(1, 0), b3, voffB); PG8_STAGE(PG8_SB(1, 1), b3 + hstep, voffB); PG8_STAGE(PG8_SA(1, 0), a3, voffA);
            PG8_WAIT_V(8); PG8_WAIT_L(0); PG8_BAR; PG8_MMA(1, 0, At, B0); PG8_MMA(1, 1, At, B1); PG8_BAR; PG8_SCHED;
            } else {
            PG8_LDB(B0, 0, 0); PG8_SCHED; PG8_LDA(At, 0, 0); PG8_STAGE(PG8_SA(1, 1), a1 + hstep, voffA);
            PG8_WAIT_L(8); PG8_BAR; PG8_WAIT_L(0); PG8_MMA(0, 0, At, B0); PG8_BAR; PG8_SCHED;
            PG8_LDB(B1, 0, 1); PG8_STAGE(PG8_SB(0, 0), b2, voffB);
            PG8_BAR; PG8_WAIT_L(0); PG8_MMA(0, 1, At, B1); PG8_BAR;
            PG8_LDA(At, 0, 1); PG8_STAGE(PG8_SA(0, 0), a2, voffA);
            PG8_BAR; PG8_WAIT_L(0); PG8_MMA(1, 0, At, B0); PG8_BAR; PG8_SCHED;
            PG8_STAGE(PG8_SB(0, 1), b2 + hstep, voffB);
            PG8_WAIT_V(6); PG8_BAR; PG8_MMA(1, 1, At, B1); PG8_BAR;
            PG8_LDB(B0, 1, 0); PG8_SCHED; PG8_LDA(At, 1, 0); PG8_STAGE(PG8_SA(0, 1), a2 + hstep, voffA);
            PG8_WAIT_L(8); PG8_BAR; PG8_WAIT_L(0); PG8_MMA(0, 0, At, B0); PG8_BAR; PG8_SCHED;
            PG8_LDB(B1, 1, 1); PG8_STAGE(PG8_SB(1, 0), b3, voffB);
            PG8_BAR; PG8_WAIT_L(0); PG8_MMA(0, 1, At, B1); PG8_BAR;
            PG8_LDA(At, 1, 1); PG8_STAGE(PG8_SA(1, 0), a3, voffA);
            PG8_BAR; PG8_WAIT_L(0); PG8_MMA(1, 0, At, B0); PG8_BAR; PG8_SCHED;
            PG8_STAGE(PG8_SB(1, 1), b3 + hstep, voffB);
            PG8_WAIT_V(6); PG8_BAR; PG8_MMA(1, 1, At, B1); PG8_BAR;
            }
        }
        if constexpr (ALIGN_EPI) { if (wr == 0) PG8_BAR; }
        if constexpr (!Epi::AFTER_DRAIN) { E(acc, cur, wr, wc, fr, fq); S.done(cur); }
        if (!has_next) break;
#pragma unroll
        for (int a = 0; a < 2; ++a)
#pragma unroll
            for (int b = 0; b < 2; ++b)
#pragma unroll
                for (int m = 0; m < 4; ++m)
#pragma unroll
                    for (int n = 0; n < 2; ++n) acc[a][b][m][n] = (f32x4){0.f, 0.f, 0.f, 0.f};
        cur = nxt; cA = nA; cB = nB; ++ui;
        if constexpr (ALIGN_EPI) { if (wr == 1) PG8_BAR; }
    }
    PG8_WAIT_V(0);
    if constexpr (!ALIGN_EPI) { if (wr == 0) PG8_BAR; }
    PG8_BAR;
    if constexpr (Epi::AFTER_DRAIN) { E.fused(acc, cur, wr, wc, fr, fq, lds, wid, lane); S.done(cur); }
#undef PG8_SA
#undef PG8_SB
#undef PG8_STAGE
#undef PG8_LDA
#undef PG8_LDB
#undef PG8_MMA
#undef PG8_WAIT_V
#undef PG8_WAIT_L
#undef PG8_BAR
#undef PG8_SCHED
}
}
#define LAS __attribute__((address_space(3)))
#define XB_TMO      128
#define XB_XCNT(j)  (256  + 64 * (j))
#define XB_XSUB(j)  (1280 + 64 * (j))
#define XB_XGEN(j)  (2304 + 64 * (j))
#define XB_TOP      3328
#define XB_TOPGEN   3392
#define XCD_BAR_WORDS 3456
#define XB_SPIN_CAP (1u << 22)

__device__ __forceinline__ unsigned xb_ld(unsigned* p)              { return __hip_atomic_load(p, __ATOMIC_RELAXED, __HIP_MEMORY_SCOPE_AGENT); }
__device__ __forceinline__ unsigned xb_add(unsigned* p, unsigned v) { return __hip_atomic_fetch_add(p, v, __ATOMIC_RELAXED, __HIP_MEMORY_SCOPE_AGENT); }
__device__ __forceinline__ unsigned xb_xcc_id() { return (unsigned)__builtin_amdgcn_s_getreg((3 << 11) | 20) & 0xFu; }
#define XB_SPIN(cond, bar) do { unsigned _sp = 0; while (cond) { __builtin_amdgcn_s_sleep(1); \
    if ((++_sp & 255u) == 0u) { if (xb_ld(&(bar)[XB_TMO])) break; if (_sp > XB_SPIN_CAP) { atomicAdd(&(bar)[XB_TMO], 1u); break; } } } } while (0)

struct XcdBarrier {
    unsigned* bar; unsigned x;
    volatile LAS unsigned* st;
};

__device__ __forceinline__ XcdBarrier xcd_barrier_post(unsigned* bar, volatile LAS unsigned* st) {
    XcdBarrier b; b.bar = bar; b.x = xb_xcc_id(); b.st = st;
    if (threadIdx.x == 0) (void)xb_add(&bar[XB_XCNT(b.x)], 1u);
    return b;
}
__device__ __forceinline__ void xcd_barrier_complete(unsigned* bar, unsigned x, unsigned& nloc, unsigned& nx) {
    const unsigned G = gridDim.x * gridDim.y * gridDim.z;
    unsigned sum, cnt, mine, sp = 0u;
    for (;;) {
        sum = 0u; cnt = 0u; mine = 0u;
#pragma unroll
        for (unsigned j = 0; j < 16; ++j) { const unsigned c = xb_ld(&bar[XB_XCNT(j)]); sum += c; cnt += (c > 0u) ? 1u : 0u; mine = (j == x) ? c : mine; }
        if (sum == G) break;
        __builtin_amdgcn_s_sleep(1);
        if ((++sp & 255u) == 0u) { if (xb_ld(&bar[XB_TMO])) break; if (sp > XB_SPIN_CAP) { atomicAdd(&bar[XB_TMO], 1u); break; } }
    }
    nloc = mine > 0u ? mine : 1u; nx = cnt > 0u ? cnt : 1u;
}

__device__ __forceinline__ void xcd_barrier(const XcdBarrier& b) {
    asm volatile("s_waitcnt vmcnt(0)" ::: "memory");
    __syncthreads();
    if (threadIdx.x == 0) {
        unsigned* bar = b.bar;
        __builtin_amdgcn_s_waitcnt(0);
        unsigned nloc = b.st[0], nx = b.st[1];
        if (nloc == 0u) { xcd_barrier_complete(bar, b.x, nloc, nx); b.st[0] = nloc; b.st[1] = nx; }
        const unsigned old = xb_add(&bar[XB_XSUB(b.x)], 1u);
        const unsigned gen = old / nloc;
        if (old + 1u == (gen + 1u) * nloc) {
            __builtin_amdgcn_fence(__ATOMIC_RELEASE, "agent");
            asm volatile("s_waitcnt vmcnt(0)" ::: "memory");
            const unsigned og = xb_add(&bar[XB_TOP], 1u);
            const unsigned tg = og / nx;
            if (og + 1u == (tg + 1u) * nx) xb_add(&bar[XB_TOPGEN], 1u);
            else XB_SPIN(xb_ld(&bar[XB_TOPGEN]) == tg, bar);
            __builtin_amdgcn_fence(__ATOMIC_ACQUIRE, "agent");
            xb_add(&bar[XB_XGEN(b.x)], 1u);
            asm volatile("s_waitcnt vmcnt(0)" ::: "memory");
        } else {
            XB_SPIN(xb_ld(&bar[XB_XGEN(b.x)]) == gen, bar);
            __builtin_amdgcn_fence(__ATOMIC_ACQUIRE, "agent");
            asm volatile("s_waitcnt vmcnt(0)" ::: "memory");
        }
    }
    __syncthreads();
}

#ifndef MK_PROBE
#define MK_PROBE 0
#endif
#if MK_PROBE >= 30
#define RPROBE(i) do { const unsigned long long _n = __builtin_amdgcn_s_memrealtime(); if ((i) == MK_PROBE - 30 + 1) tacc_ += _n - tq_; tq_ = _n; } while (0)
#endif
#if MK_PROBE >= 40 && MK_PROBE < 50
#define IPROBE(i) do { const unsigned long long _n = __builtin_amdgcn_s_memrealtime(); if ((i) == MK_PROBE - 40 + 1) tacc_ += _n - tq_; tq_ = _n; } while (0)
#endif
#if MK_PROBE >= 100 && MK_PROBE < 110
#define APROBE(i) do { const unsigned long long _n = __builtin_amdgcn_s_memrealtime(); if ((i) == MK_PROBE - 100 + 1) tacc_ += _n - tq_; tq_ = _n; } while (0)
#endif
namespace mk {
using pg8::bf16_t; using pg8::bf16x8; using pg8::f32x4; using pg8::u32x4;

#define GAS __attribute__((address_space(1)))
typedef float f32x2 __attribute__((ext_vector_type(2)));
typedef float f32x16 __attribute__((ext_vector_type(16)));
typedef unsigned u32x2 __attribute__((ext_vector_type(2)));
typedef short s16x4 __attribute__((ext_vector_type(4)));
typedef __bf16 bf16x2_t __attribute__((ext_vector_type(2)));
typedef unsigned char uchar;

constexpr int S = 8192, D = 2048, NH = 8, HD = 128, CKV = 256, IH = 16, IDM = 64, TOPK = 256;
constexpr int GW = 1024, CHUNK = 128, NGRP = 8;
constexpr int NSRC = 8528, NPROJ = 8704;
constexpr int NE = 64, FF = 512;
constexpr float EPS = 1e-6f, LOG2E = 1.4426950408889634f;
constexpr int NTHR = 512, NWAVE = 8;
constexpr int MAXROWS = 32768;

constexpr size_t MiB = 1u << 20;
constexpr size_t WS_CTL = 0, CTL_BYTES = 1 * MiB;
constexpr size_t WS_WINT = 1 * MiB, WS_WAT = 35 * MiB, WS_WBT = 39 * MiB, WS_WOT = 43 * MiB, WS_WUK = 51 * MiB, WS_WUV = 51 * MiB + 512 * 1024, WS_WSM = 52 * MiB;
constexpr size_t WS_LIST = 53 * MiB;
constexpr size_t WS_CWT = 55 * MiB;
constexpr size_t WS_WRT = 56 * MiB;
constexpr size_t WS_HID = 57 * MiB;
constexpr size_t WS_Y = 85 * MiB;
constexpr size_t WS_CKV8 = 87 * MiB;
constexpr size_t WS_N1 = 437 * MiB;
constexpr size_t WS_Q = 469 * MiB, WS_CKVF = 485 * MiB, WS_CKV = 493 * MiB, WS_QI = 497 * MiB, WS_KIDX = 513 * MiB, WS_WIDX = 514 * MiB;
constexpr size_t WS_UV = 515 * MiB;
constexpr size_t WS_LNS = 547 * MiB, WS_GATE = 548 * MiB;
constexpr size_t WS_QABS = 612 * MiB, WS_OB = 644 * MiB;
constexpr size_t WS_MB = 676 * MiB, WS_IDX = 692 * MiB, WS_AB = 700 * MiB, WS_ROUTE = 716 * MiB;
constexpr size_t WS_SC = 717 * MiB;
constexpr size_t WS_END = 973 * MiB;
constexpr size_t RT_EID = 0, RT_POS = 65536, RT_WGT = 131072, RT_ROW = 196608, RT_CW = 262144;
constexpr int CW_BAR = 4096, CW_CNT = 65536;

constexpr int LDS_BYTES = 155648;
constexpr int LDS_X = 131072;
constexpr int LDS_MISC = LDS_BYTES - 256;

#define LDS_BARRIER() do { asm volatile("s_waitcnt lgkmcnt(0)" ::: "memory"); __builtin_amdgcn_s_barrier(); asm volatile("" ::: "memory"); } while (0)
__device__ __forceinline__ unsigned pk2(float lo, float hi) { f32x2 v = {lo, hi}; return __builtin_bit_cast(unsigned, __builtin_convertvector(v, bf16x2_t)); }
__device__ __forceinline__ float bf_lo(unsigned u) { return __uint_as_float(u << 16); }
__device__ __forceinline__ float bf_hi(unsigned u) { return __uint_as_float(u & 0xffff0000u); }
__device__ __forceinline__ float bf1(bf16_t b) { return __uint_as_float(((unsigned)b) << 16); }
__device__ __forceinline__ float wave_sum(float v) {
#pragma unroll
    for (int o = 1; o < 64; o <<= 1) v += __shfl_xor(v, o);
    return v;
}
__device__ __forceinline__ float ex2(float x) { return __builtin_amdgcn_exp2f(x); }
__device__ __forceinline__ float sigm(float x) { return __builtin_amdgcn_rcpf(1.f + ex2(-x * LOG2E)); }
__device__ __forceinline__ float gelu_t(float x) { const float u = 0.7978845608028654f * (x + 0.044715f * x * x * x); return x * __builtin_amdgcn_rcpf(1.f + ex2(-2.f * LOG2E * u)); }
__device__ __forceinline__ float silu_(float x) { return x * sigm(x); }

struct Ctx {
    LAS uchar* lds; int tid, lane, wave, G, bid;
    const float* in[22]; float* out; uchar* ws;
};
#define WSP(T, off) ((T*)(C.ws + (off)))
enum { I_X = 0, I_N1G, I_WIN, I_KVG, I_WUK, I_WUV, I_GWS, I_GBS, I_LNG, I_LNB, I_WBA, I_WBG, I_WOUT, I_N2G, I_WGRP, I_BGRP, I_WRT, I_BRT, I_WEG, I_WEU, I_WED, I_NFG };

__device__ __forceinline__ int proj_src_col(int n) {
    if (n < 2304) return n;
    if (n < 8448) return n + 80;
    if (n < 8528) return n - 8448 + 2304;
    return -1;
}
struct TcItem { const float* W; size_t ldw; int srccol; bf16_t* WT; size_t K; int dstrow0, k0; };
__device__ __forceinline__ TcItem tc_params(const Ctx& C, int it, int lane) {
    constexpr int I_IN = (NPROJ / 32) * (D / 64), I_BA = (D / 32) * (1024 / 64);
    TcItem t; int r = it;
    if (r < I_IN) { const int nb = r % (NPROJ / 32), kb = r / (NPROJ / 32); t = TcItem{C.in[I_WIN], (size_t)NSRC, proj_src_col(32 * nb + (lane & 31)), WSP(bf16_t, WS_WINT), (size_t)D, 32 * nb, 64 * kb}; return t; } r -= I_IN;
    if (r < I_BA) { const int nb = r % 64, kb = r / 64; t = TcItem{C.in[I_WBA], (size_t)D, 32 * nb + (lane & 31), WSP(bf16_t, WS_WAT), (size_t)1024, 32 * nb, 64 * kb}; return t; } r -= I_BA;
    if (r < I_BA) { const int nb = r % 64, kb = r / 64; t = TcItem{C.in[I_WBG], (size_t)D, 32 * nb + (lane & 31), WSP(bf16_t, WS_WBT), (size_t)1024, 32 * nb, 64 * kb}; return t; } r -= I_BA;
    { const int nb = r % 64, kb = r / 64; t = TcItem{C.in[I_WOUT], (size_t)D, 32 * nb + (lane & 31), WSP(bf16_t, WS_WOT), (size_t)D, 32 * nb, 64 * kb}; return t; }
}
#define TC_LOAD(T, tv) do { _Pragma("unroll") for (int i = 0; i < 32; ++i) { const int kk = 2 * i + (lane >> 5); tv[i] = (T).srccol >= 0 ? (T).W[(size_t)((T).k0 + kk) * (T).ldw + (T).srccol] : 0.f; } } while (0)
__device__ __forceinline__ void tc_finish(const TcItem& T, const float (&tv)[32], LAS float* scr, int lane) {
#pragma unroll
    for (int i = 0; i < 32; ++i) { const int kk = 2 * i + (lane >> 5); scr[kk * 33 + (lane & 31)] = tv[i]; }
    asm volatile("s_waitcnt lgkmcnt(0)" ::: "memory");
    const int c = lane & 7;
#pragma unroll
    for (int j = 0; j < 4; ++j) { const int n = (lane >> 3) + 8 * j; const LAS float* s = scr + (8 * c) * 33 + n;
        u32x4 o; o.x = pk2(s[0 * 33], s[1 * 33]); o.y = pk2(s[2 * 33], s[3 * 33]); o.z = pk2(s[4 * 33], s[5 * 33]); o.w = pk2(s[6 * 33], s[7 * 33]);
        *(u32x4*)(T.WT + (size_t)(T.dstrow0 + n) * T.K + T.k0 + 8 * c) = o; }
    asm volatile("s_waitcnt lgkmcnt(0)" ::: "memory");
}
__device__ __forceinline__ void tc_range(const Ctx& C, int lo, int hi, LAS float* scr) {
    const int gw = C.bid * NWAVE + C.wave, NGW = C.G * NWAVE, lane = C.lane;
    if (lo + gw < hi) {
        TcItem cur = tc_params(C, lo + gw, lane); float tv[32]; TC_LOAD(cur, tv);
#pragma unroll 1
        for (int it = lo + gw; it < hi; it += NGW) {
            const int itn = (it + NGW < hi) ? it + NGW : it;
            const TcItem nxt = tc_params(C, itn, lane); float tn[32]; TC_LOAD(nxt, tn);
            __builtin_amdgcn_sched_barrier(0);
            tc_finish(cur, tv, scr, lane);
#pragma unroll
            for (int i = 0; i < 32; ++i) tv[i] = tn[i];
            cur = nxt;
        }
    }
}
__device__ __forceinline__ void p0_late(const Ctx& C) {
    constexpr int I_IN = (NPROJ / 32) * (D / 64), NITEMS = I_IN + 2 * (D / 32) * (1024 / 64) + (D / 32) * (D / 64);
    tc_range(C, I_IN, NITEMS, (LAS float*)(C.lds + C.wave * 16384));
    __syncthreads();
}
__device__ __forceinline__ void p0_prologue(const Ctx& C) {
    LAS float* scr = (LAS float*)(C.lds + C.wave * 16384);
    const int gw = C.bid * NWAVE + C.wave, NGW = C.G * NWAVE, lane = C.lane;
    tc_range(C, 0, (NPROJ / 32) * (D / 64), scr);
    const int gt = C.bid * NTHR + C.tid, NGT = C.G * NTHR;
    for (int i = gt; i < 262144 / 4; i += NGT) {
        const f32x4 a = ((const f32x4*)C.in[I_WUK])[i], b = ((const f32x4*)C.in[I_WUV])[i];
        u32x2 oa, ob; oa.x = pk2(a.x, a.y); oa.y = pk2(a.z, a.w); ob.x = pk2(b.x, b.y); ob.y = pk2(b.z, b.w);
        WSP(u32x2, WS_WUK)[i] = oa; WSP(u32x2, WS_WUV)[i] = ob;
    }
    for (int i = gt; i < 131072 / 4; i += NGT) {
        const f32x4 a = ((const f32x4*)C.in[I_GWS])[i]; const int e = 4 * i, s0 = e & 127, t = (e >> 7) & 127;
        u32x2 o; o.x = pk2(s0 <= t ? a.x : 0.f, s0 + 1 <= t ? a.y : 0.f); o.y = pk2(s0 + 2 <= t ? a.z : 0.f, s0 + 3 <= t ? a.w : 0.f);
        WSP(u32x2, WS_WSM)[i] = o;
    }
    for (int i = gt; i < 512 * 5 * 64; i += NGT) { const int ln = i & 63, cb = (i >> 6) % 5, ks = i / 320, k = 4 * ks + (ln >> 4), c = ln & 15;
        const float g2 = C.in[I_N2G][k]; float v;
        if (cb == 0) v = (c < 8) ? C.in[I_WGRP][(size_t)k * 8 + c] * g2 : 0.f; else v = C.in[I_WRT][(size_t)k * 64 + (cb - 1) * 16 + c] * g2;
        WSP(float, WS_WRT)[i] = v; }
    for (int m = gw; m < S; m += 2 * NGW) {
        const int m2 = (m + NGW < S) ? m + NGW : m;
        const f32x4* xr = (const f32x4*)(C.in[I_X] + (size_t)m * D) + lane; const f32x4* xr2 = (const f32x4*)(C.in[I_X] + (size_t)m2 * D) + lane; const f32x4* gr = (const f32x4*)C.in[I_N1G] + lane;
        f32x4 v[8], v2[8]; float ss = 0.f, ss2 = 0.f;
#pragma unroll
        for (int j = 0; j < 8; ++j) { v[j] = xr[64 * j]; v2[j] = xr2[64 * j]; }
        f32x4 gq[8];
#pragma unroll
        for (int j = 0; j < 8; ++j) gq[j] = gr[64 * j];
#pragma unroll
        for (int j = 0; j < 8; ++j) { ss += (v[j].x * v[j].x + v[j].y * v[j].y) + (v[j].z * v[j].z + v[j].w * v[j].w); ss2 += (v2[j].x * v2[j].x + v2[j].y * v2[j].y) + (v2[j].z * v2[j].z + v2[j].w * v2[j].w); }
        const float rstd = 1.0f / sqrtf(wave_sum(ss) * (1.f / D) + EPS), rstd2 = 1.0f / sqrtf(wave_sum(ss2) * (1.f / D) + EPS);
        u32x2* o = WSP(u32x2, WS_N1) + (size_t)m * (D / 4) + lane; u32x2* o2 = WSP(u32x2, WS_N1) + (size_t)m2 * (D / 4) + lane;
#pragma unroll
        for (int j = 0; j < 8; ++j) { const f32x4 g = gq[j]; u32x2 w; w.x = pk2(v[j].x * rstd * g.x, v[j].y * rstd * g.y); w.y = pk2(v[j].z * rstd * g.z, v[j].w * rstd * g.w); o[64 * j] = w;
            u32x2 w2; w2.x = pk2(v2[j].x * rstd2 * g.x, v2[j].y * rstd2 * g.y); w2.y = pk2(v2[j].z * rstd2 * g.z, v2[j].w * rstd2 * g.w); o2[64 * j] = w2; }
    }
}

struct EpiProj {
    static constexpr bool PERM = true, AFTER_DRAIN = false;
    bf16_t *Q, *QI, *UV, *GATE, *KIDX; float *CKVF, *LNS, *WIDX;
    template <int ACT> __device__ __forceinline__ void st_bf16(const f32x4 (&acc)[2][2][4][2], bf16_t* base, int ld, int row0, int col0, float sc) const {
#pragma unroll
        for (int ai = 0; ai < 2; ++ai)
#pragma unroll
            for (int m = 0; m < 4; ++m) { bf16_t* rowp = base + (size_t)(row0 + ai * 128 + m * 16) * ld + col0;
#pragma unroll
                for (int bj = 0; bj < 2; ++bj) { f32x4 v0 = acc[ai][bj][m][0], v1 = acc[ai][bj][m][1];
                    if (ACT == 0) { v0 *= sc; v1 *= sc; }
                    if (ACT == 1) {
#pragma unroll
                        for (int j = 0; j < 4; ++j) { v0[j] = gelu_t(v0[j]); v1[j] = gelu_t(v1[j]); } }
                    if (ACT == 2) {
#pragma unroll
                        for (int j = 0; j < 4; ++j) { v0[j] = sigm(v0[j]); v1[j] = sigm(v1[j]); } }
                    u32x4 w; w.x = pk2(v0[0], v0[1]); w.y = pk2(v0[2], v0[3]); w.z = pk2(v1[0], v1[1]); w.w = pk2(v1[2], v1[3]);
                    *(u32x4*)(rowp + bj * 128) = w; } }
    }
    __device__ __forceinline__ void operator()(const f32x4 (&acc)[2][2][4][2], const pg8::Unit& u, int wr, int wc, int fr, int fq) const {
        const int pn = u.pn, row0 = u.pm * 256 + wr * 64 + fr, cl = wc * 32 + 8 * fq;
        if (pn < 4) st_bf16<0>(acc, Q, 1024, row0, pn * 256 + cl, 1.f);
        else if (pn == 4) {
#pragma unroll
            for (int ai = 0; ai < 2; ++ai)
#pragma unroll
                for (int m = 0; m < 4; ++m) { float* rowp = CKVF + (size_t)(row0 + ai * 128 + m * 16) * 256 + cl;
#pragma unroll
                    for (int bj = 0; bj < 2; ++bj) { *(f32x4*)(rowp + bj * 128) = acc[ai][bj][m][0]; *(f32x4*)(rowp + bj * 128 + 4) = acc[ai][bj][m][1]; } }
        }
        else if (pn < 9) st_bf16<0>(acc, QI, 1024, row0, (pn - 5) * 256 + cl, 0.125f);
        else if (pn < 13) st_bf16<1>(acc, UV, 2048, row0, (pn - 9) * 256 + cl, 1.f);
        else if (pn < 17) {
#pragma unroll
            for (int ai = 0; ai < 2; ++ai)
#pragma unroll
                for (int m = 0; m < 4; ++m) { const int row = row0 + ai * 128 + m * 16; bf16_t* rowp = UV + (size_t)row * 2048 + (pn - 9) * 256 + cl; float s = 0.f, ss = 0.f;
#pragma unroll
                    for (int bj = 0; bj < 2; ++bj) { f32x4 v0 = acc[ai][bj][m][0], v1 = acc[ai][bj][m][1];
#pragma unroll
                        for (int j = 0; j < 4; ++j) { v0[j] = gelu_t(v0[j]); v1[j] = gelu_t(v1[j]); s += v0[j] + v1[j]; ss += v0[j] * v0[j] + v1[j] * v1[j]; }
                        u32x4 w; w.x = pk2(v0[0], v0[1]); w.y = pk2(v0[2], v0[3]); w.z = pk2(v1[0], v1[1]); w.w = pk2(v1[2], v1[3]);
                        *(u32x4*)(rowp + bj * 128) = w; }
                    s += __shfl_xor(s, 16); s += __shfl_xor(s, 32); ss += __shfl_xor(ss, 16); ss += __shfl_xor(ss, 32);
                    if (fq == 0) *(f32x2*)(LNS + (size_t)row * 32 + ((pn - 13) * 4 + wc) * 2) = (f32x2){s, ss}; }
        }
        else if (pn < 33) st_bf16<2>(acc, GATE, 4096, row0, (pn - 17) * 256 + cl, 1.f);
        else {
#pragma unroll
            for (int ai = 0; ai < 2; ++ai)
#pragma unroll
                for (int m = 0; m < 4; ++m) { const int row = row0 + ai * 128 + m * 16; const f32x4 v0 = acc[ai][0][m][0], v1 = acc[ai][0][m][1];
                    if (wc < 2) { u32x4 w; w.x = pk2(v0[0], v0[1]); w.y = pk2(v0[2], v0[3]); w.z = pk2(v1[0], v1[1]); w.w = pk2(v1[2], v1[3]); *(u32x4*)(KIDX + (size_t)row * 64 + cl) = w; }
                    else if (wc == 2 && fq < 2) { float* p = WIDX + (size_t)row * 16 + 8 * fq; *(f32x4*)p = v0 * 0.25f; *(f32x4*)(p + 4) = v1 * 0.25f; } }
        }
    }
};

struct ProjOrderA : pg8::StaticOrder {
    __device__ __forceinline__ bool next(int i, pg8::Unit& u) const { if (!pg8::StaticOrder::next(i, u)) return false; if (u.pn == 31) u.pn = 33; return true; }
};
struct ProjOrderB { int j;
    __device__ __forceinline__ bool next(int i, pg8::Unit& u) const { if (i != 0) return false; u.pm = j & 31; u.pn = 31 + (j >> 5); return true; }
    __device__ __forceinline__ void a_ready(const pg8::Unit&) const {}
    __device__ __forceinline__ void done(const pg8::Unit&) const {}
};
struct ProjOrderC { int G, c;
    __device__ __forceinline__ bool next(int i, pg8::Unit& u) const { const int j = i * G + c; if (j >= 64) return false; u.pm = j & 31; u.pn = 31 + (j >> 5); return true; }
    __device__ __forceinline__ void a_ready(const pg8::Unit&) const {}
    __device__ __forceinline__ void done(const pg8::Unit&) const {}
};
__device__ __forceinline__ unsigned imgb_off(unsigned row, unsigned ch) { return 256u * row + 16u * (ch ^ (((row & 3u) << 2) | ((row >> 2) & 3u))); }
__device__ __forceinline__ unsigned imgb_row16(unsigned lane, unsigned rb, unsigned s) { return imgb_off((lane & 15u) + 16u * rb, 4u * s + (lane >> 4)); }
__device__ __forceinline__ unsigned imgb_tr16(unsigned lane, unsigned c, unsigned ks, unsigned t) { const unsigned g = lane >> 4, q = (lane & 15u) >> 2, p = lane & 3u; return imgb_off(32u * ks + 8u * g + 4u * t + q, 2u * c + (p >> 1)) + 8u * (p & 1u); }
__device__ __forceinline__ bf16x8 trrd8(LAS uchar* p0, LAS uchar* p1) {
    const s16x4 b0 = __builtin_amdgcn_ds_read_tr16_b64_v4i16((LAS s16x4*)p0), b1 = __builtin_amdgcn_ds_read_tr16_b64_v4i16((LAS s16x4*)p1);
    return __builtin_shufflevector(b0, b1, 0, 1, 2, 3, 4, 5, 6, 7);
}
#define MFMA16(a, b, c) __builtin_amdgcn_mfma_f32_16x16x32_bf16((a), (b), (c), 0, 0, 0)
__device__ __forceinline__ void img128_ld(u32x4 (&v)[4], const bf16_t* src, size_t ld, int tid) {
#pragma unroll
    for (int i = 0; i < 4; ++i) { const int q = tid + NTHR * i, row = q >> 4, ch = q & 15; v[i] = *(const u32x4*)(src + (size_t)row * ld + ch * 8); }
}
__device__ __forceinline__ void img128_st(LAS uchar* img, const u32x4 (&v)[4], int tid) {
#pragma unroll
    for (int i = 0; i < 4; ++i) { const int q = tid + NTHR * i, row = q >> 4, ch = q & 15; *(LAS u32x4*)(img + imgb_off(row, ch)) = v[i]; }
}
__device__ __forceinline__ void load_img128(LAS uchar* img, const bf16_t* src, size_t ld, int tid) { u32x4 v[4]; img128_ld(v, src, ld, tid); __builtin_amdgcn_sched_barrier(0); img128_st(img, v, tid); }
__device__ __forceinline__ void trgemm(LAS uchar* imgA, LAS uchar* imgB, int lane, int w, f32x4 (&acc)[8]) {
#pragma unroll
    for (int ks = 0; ks < 4; ++ks) {
        const bf16x8 a = *(LAS bf16x8*)(imgA + imgb_row16(lane, w, ks));
#pragma unroll
        for (int c = 0; c < 8; ++c) { const bf16x8 b = trrd8(imgB + imgb_tr16(lane, c, ks, 0), imgB + imgb_tr16(lane, c, ks, 1)); acc[c] = MFMA16(a, b, acc[c]); }
    }
}
constexpr int STG_LD = 132;
__device__ __forceinline__ void stage_acc(LAS float* stg, const f32x4 (&acc)[8], int lane) {
    const int col = lane & 15, g = lane >> 4;
#pragma unroll
    for (int c = 0; c < 8; ++c)
#pragma unroll
        for (int r = 0; r < 4; ++r) stg[(4 * g + r) * STG_LD + 16 * c + col] = acc[c][r];
}
__device__ __forceinline__ void stage_store_bf16(LAS float* stg, const f32x4 (&acc)[8], bf16_t* orow, size_t ld, int lane) {
    stage_acc(stg, acc, lane);
#pragma unroll
    for (int i = 0; i < 4; ++i) { const int q = lane + 64 * i, row = q >> 4, ch = q & 15; const LAS float* s = stg + row * STG_LD + 8 * ch;
        u32x4 o; o.x = pk2(s[0], s[1]); o.y = pk2(s[2], s[3]); o.z = pk2(s[4], s[5]); o.w = pk2(s[6], s[7]);
        *(u32x4*)(orow + (size_t)row * ld + 8 * ch) = o; }
}
#define ZERO8(a) do { _Pragma("unroll") for (int _c = 0; _c < 8; ++_c) a[_c] = (f32x4){0.f, 0.f, 0.f, 0.f}; } while (0)

__device__ __forceinline__ void p2_ckv_norm(const Ctx& C) {
    const int gw = C.bid * NWAVE + C.wave, NGW = C.G * NWAVE, lane = C.lane;
    const f32x4 g = ((const f32x4*)C.in[I_KVG])[lane];
    for (int m0 = gw; m0 < S; m0 += 4 * NGW) {
        f32x4 v[4];
#pragma unroll
        for (int q = 0; q < 4; ++q) { const int m = (m0 + q * NGW < S) ? m0 + q * NGW : m0; v[q] = ((const f32x4*)(WSP(float, WS_CKVF) + (size_t)m * CKV))[lane]; }
#pragma unroll
        for (int q = 0; q < 4; ++q) { const int m = m0 + q * NGW; if (m < S) {
            const float ss = wave_sum((v[q].x * v[q].x + v[q].y * v[q].y) + (v[q].z * v[q].z + v[q].w * v[q].w));
            const float rstd = 1.0f / sqrtf(ss * (1.f / CKV) + EPS);
            u32x2 o; o.x = pk2(v[q].x * rstd * g.x, v[q].y * rstd * g.y); o.y = pk2(v[q].z * rstd * g.z, v[q].w * rstd * g.w);
            (WSP(u32x2, WS_CKV) + (size_t)m * (CKV / 4))[lane] = o; } }
    }
}
__device__ __forceinline__ void p2_qabs(const Ctx& C) {
    LAS uchar* imgA = C.lds; LAS uchar* imgB = C.lds + 32768;
    LAS float* stg = (LAS float*)(C.lds) + C.wave * 16 * STG_LD;
    const int lane = C.lane, w = C.wave;
#pragma unroll 1
    for (int u = C.bid; u < 64 * NH * 2; u += C.G) {
        const int half = u & 1, h = (u >> 1) & 7, t0 = (u >> 4) * 128;
        __syncthreads();
        { u32x4 va[4], vb[4];
          img128_ld(va, WSP(bf16_t, WS_Q) + (size_t)t0 * 1024 + h * 128, 1024, C.tid);
          img128_ld(vb, WSP(bf16_t, WS_WUK) + (size_t)h * 128 * 256 + half * 128, 256, C.tid);
          __builtin_amdgcn_sched_barrier(0);
          img128_st(imgA, va, C.tid); img128_st(imgB, vb, C.tid); }
        __syncthreads();
        f32x4 acc[8]; ZERO8(acc);
        trgemm(imgA, imgB, lane, w, acc);
        __syncthreads();
        stage_store_bf16(stg, acc, WSP(bf16_t, WS_QABS) + (size_t)(t0 + 16 * w) * 2048 + h * 256 + half * 128, 2048, lane);
    }
    __syncthreads();
}
__device__ __forceinline__ void p2_gmlp(const Ctx& C) {
    LAS uchar* imgA = C.lds; LAS uchar* imgB = C.lds + 32768; LAS f32x2* stat = (LAS f32x2*)(C.lds + 65536);
    LAS float* stg = (LAS float*)(C.lds) + C.wave * 16 * STG_LD;
    const int lane = C.lane, w = C.wave, tid = C.tid;
    const bf16_t* UV = WSP(bf16_t, WS_UV);
    for (int u = C.bid; u < 64 * NGRP; u += C.G) {
        const int g = u & 7, t0 = (u >> 3) * 128;
        __syncthreads();
        if (tid < 128) { const float* p = WSP(float, WS_LNS) + (size_t)(t0 + tid) * 32; float s = 0.f, ss = 0.f;
#pragma unroll
            for (int j = 0; j < 16; ++j) { s += p[2 * j]; ss += p[2 * j + 1]; }
            const float mean = s * (1.f / GW), var = fmaxf(ss * (1.f / GW) - mean * mean, 0.f);
            stat[tid] = (f32x2){mean, 1.0f / sqrtf(var + EPS)}; }
        load_img128(imgA, WSP(bf16_t, WS_WSM) + (size_t)g * 128 * 128, 128, tid);
        __syncthreads();
        u32x4 vq[4];
#pragma unroll
        for (int i = 0; i < 4; ++i) { const int q = tid + NTHR * i, row = q >> 4, ch = q & 15; vq[i] = *(const u32x4*)(UV + (size_t)(t0 + row) * 2048 + 1024 + g * 128 + ch * 8); }
        __builtin_amdgcn_sched_barrier(0);
#pragma unroll
        for (int i = 0; i < 4; ++i) { const int q = tid + NTHR * i, row = q >> 4, ch = q & 15; const f32x2 st = stat[row];
            const u32x4 v = vq[i];
            const float* lg = C.in[I_LNG] + g * 128 + ch * 8; const float* lb = C.in[I_LNB] + g * 128 + ch * 8;
            const unsigned vv[4] = {v.x, v.y, v.z, v.w}; unsigned o[4];
#pragma unroll
            for (int j = 0; j < 4; ++j) { const float a = (bf_lo(vv[j]) - st.x) * st.y * lg[2 * j] + lb[2 * j], b = (bf_hi(vv[j]) - st.x) * st.y * lg[2 * j + 1] + lb[2 * j + 1]; o[j] = pk2(a, b); }
            *(LAS u32x4*)(imgB + imgb_off(row, ch)) = (u32x4){o[0], o[1], o[2], o[3]}; }
        __syncthreads();
        f32x4 acc[8]; ZERO8(acc);
        trgemm(imgA, imgB, lane, w, acc);
        __syncthreads();
        stage_acc(stg, acc, lane);
        u32x4 uq[4]; float bq[4];
#pragma unroll
        for (int i = 0; i < 4; ++i) { const int q = lane + 64 * i, row = q >> 4, ch = q & 15, tl = 16 * w + row; bq[i] = C.in[I_GBS][g * 128 + tl]; uq[i] = *(const u32x4*)(UV + (size_t)(t0 + tl) * 2048 + g * 128 + ch * 8); }
        __builtin_amdgcn_sched_barrier(0);
#pragma unroll
        for (int i = 0; i < 4; ++i) { const int q = lane + 64 * i, row = q >> 4, ch = q & 15; const LAS float* s = stg + row * STG_LD + 8 * ch;
            const int tl = 16 * w + row; const float bias = bq[i];
            const u32x4 uu = uq[i];
            u32x4 o; o.x = pk2(bf_lo(uu.x) * (s[0] + bias), bf_hi(uu.x) * (s[1] + bias)); o.y = pk2(bf_lo(uu.y) * (s[2] + bias), bf_hi(uu.y) * (s[3] + bias));
            o.z = pk2(bf_lo(uu.z) * (s[4] + bias), bf_hi(uu.z) * (s[5] + bias)); o.w = pk2(bf_lo(uu.w) * (s[6] + bias), bf_hi(uu.w) * (s[7] + bias));
            *(u32x4*)(WSP(bf16_t, WS_MB) + (size_t)(t0 + tl) * 1024 + g * 128 + ch * 8) = o; }
    }
    __syncthreads();
}

#define MFMA32(a, b, c) __builtin_amdgcn_mfma_f32_32x32x16_bf16((a), (b), (c), 0, 0, 0)
__device__ __forceinline__ float relu_i(float x) { const int b = __float_as_int(x); return __int_as_float(b > 0 ? b : 0); }
__device__ __forceinline__ unsigned f2key(float x) { const unsigned u = __float_as_uint(x); return (u & 0x80000000u) ? ~u : (u | 0x80000000u); }
__device__ __forceinline__ int sbucket(float x) { float f = __builtin_fmaf(x, 64.f, 512.f); f = fminf(fmaxf(f, 0.f), 1023.f); return (int)f; }
__device__ __forceinline__ void lds_add(LAS unsigned* p, unsigned v) { (void)__hip_atomic_fetch_add(p, v, __ATOMIC_RELAXED, __HIP_MEMORY_SCOPE_WORKGROUP); }
__device__ __forceinline__ unsigned suffix_incl(unsigned v, int lane) {
#pragma unroll
    for (int o = 1; o < 64; o <<= 1) { const unsigned x = __shfl_down(v, o); if (lane + o < 64) v += x; }
    return v;
}
__device__ __forceinline__ void select_row_radix(const Ctx& C, int t, LAS unsigned* hist) {
    const int lane = C.lane, n = t + 1; int* out = WSP(int, WS_IDX) + (size_t)t * TOPK;
    const float* row = WSP(float, WS_SC) + (size_t)t * S;
    unsigned prefix = 0u, krem = (unsigned)TOPK;
#pragma unroll 1
    for (int pass = 0; pass < 4; ++pass) {
        const int shift = 24 - 8 * pass;
#pragma unroll
        for (int i = 0; i < 4; ++i) hist[lane + 64 * i] = 0u;
        for (int i = lane; i < n; i += 64) { const unsigned key = f2key(row[i]); if (pass == 0 || (key >> (shift + 8)) == (prefix >> (shift + 8))) lds_add(&hist[(key >> shift) & 255u], 1u); }
        unsigned h4[4]; unsigned tt = 0;
#pragma unroll
        for (int j = 0; j < 4; ++j) { h4[j] = hist[4 * lane + j]; tt += h4[j]; }
        const unsigned in2 = suffix_incl(tt, lane), ab2 = in2 - tt;
        const bool m2 = ab2 < krem && in2 >= krem;
        int d = 0; unsigned nk = 0;
        if (m2) { unsigned cum = ab2;
#pragma unroll
            for (int j = 3; j >= 0; --j) { if (nk == 0u) { if (cum + h4[j] >= krem) { d = 4 * lane + j; nk = krem - cum; } else cum += h4[j]; } } }
        const unsigned long long mk = __ballot(m2); const int src = __ffsll((long long)mk) - 1; d = __shfl(d, src); krem = __shfl(nk, src);
        prefix |= (unsigned)d << shift;
    }
    const unsigned long long lt = (1ull << lane) - 1ull;
    unsigned cnt = 0, eqc = 0;
    for (int base = 0; base < n; base += 64) { const int i = base + lane; const bool valid = i < n; const unsigned key = valid ? f2key(row[i]) : 0u;
        const bool gt = valid && key > prefix, eq = valid && key == prefix;
        const unsigned long long em = __ballot(eq); const unsigned rank = eqc + (unsigned)__popcll(em & lt);
        const bool take = gt || (eq && rank < krem);
        const unsigned long long tm = __ballot(take); const unsigned pos = cnt + (unsigned)__popcll(tm & lt);
        if (take && pos < (unsigned)TOPK) out[pos] = i;
        cnt += (unsigned)__popcll(tm); eqc += (unsigned)__popcll(em); }
}
constexpr int CAND_CAP = 256;
__device__ __forceinline__ void select_row(const Ctx& C, int t, const LAS unsigned* h, LAS unsigned* cand) {
    const int lane = C.lane, n = t + 1; int* out = WSP(int, WS_IDX) + (size_t)t * TOPK;
    if (n <= TOPK) { for (int j = lane; j < TOPK; j += 64) out[j] = j < n ? j : -1; return; }
    const float* row = WSP(float, WS_SC) + (size_t)t * S;
    unsigned wd[8]; unsigned tot = 0;
#pragma unroll
    for (int j = 0; j < 8; ++j) { wd[j] = h[8 * lane + j]; tot += (wd[j] & 0xffffu) + (wd[j] >> 16); }
    const unsigned incl = suffix_incl(tot, lane), above = incl - tot;
    const bool mine = above < (unsigned)TOPK && incl >= (unsigned)TOPK;
    int bstar = 0; unsigned krem = 0;
    if (mine) { unsigned cum = above;
#pragma unroll
        for (int b = 15; b >= 0; --b) { if (krem == 0u) { const unsigned c = (wd[b >> 1] >> (16 * (b & 1))) & 0xffffu; if (cum + c >= (unsigned)TOPK) { bstar = 16 * lane + b; krem = (unsigned)TOPK - cum; } else cum += c; } } }
    { const unsigned long long mk = __ballot(mine); const int src = __ffsll((long long)mk) - 1; bstar = __shfl(bstar, src); krem = __shfl(krem, src); }
    const unsigned ngt = (unsigned)TOPK - krem;
    const float flo = (bstar == 0) ? -3.0e38f : (float)bstar, fhi = (bstar == 1023) ? 3.0e38f : (float)(bstar + 1);
    const unsigned long long lt = (1ull << lane) - 1ull;
    unsigned cnt = 0, cc = 0;
    f32x4 rr[4];
#pragma unroll
    for (int q = 0; q < 4; ++q) { int ii = 256 * q + 4 * lane; ii = ii < S - 4 ? ii : S - 4; rr[q] = *(const f32x4*)(row + ii); }
    for (int base = 0; base < n; base += 1024) {
#pragma unroll
        for (int q = 0; q < 4; ++q) {
            const int i0 = base + 256 * q + 4 * lane; const f32x4 cur = rr[q];
            { int ii = i0 + 1024; ii = ii < S - 4 ? ii : S - 4; rr[q] = *(const f32x4*)(row + ii); }
#pragma unroll
            for (int j = 0; j < 4; ++j) { const bool valid = i0 + j < n; const float f = __builtin_fmaf(cur[j], 64.f, 512.f); const bool gt = valid && f >= fhi, eq = valid && f >= flo && f < fhi;
                const unsigned long long m = __ballot(gt); if (gt) { const unsigned pos = cnt + (unsigned)__popcll(m & lt); if (pos < (unsigned)TOPK) out[pos] = i0 + j; } cnt += (unsigned)__popcll(m);
                const unsigned long long me = __ballot(eq);
                if (me) { if (eq) { const unsigned p = cc + (unsigned)__popcll(me & lt); if (p < (unsigned)CAND_CAP) { cand[2 * p] = f2key(cur[j]); cand[2 * p + 1] = (unsigned)(i0 + j); } } cc += (unsigned)__popcll(me); } }
        }
    }
    asm volatile("s_waitcnt vmcnt(0)" ::: "memory");
    if (cc <= (unsigned)CAND_CAP) {
        for (unsigned ci = lane; ci < cc; ci += 64) { const unsigned key = cand[2 * ci], idx = cand[2 * ci + 1]; unsigned rank = 0;
            for (unsigned j = 0; j < cc; ++j) { const unsigned kj = cand[2 * j], ij = cand[2 * j + 1]; rank += (kj > key || (kj == key && ij < idx)) ? 1u : 0u; }
            if (rank < krem) out[ngt + rank] = (int)idx; }
    } else select_row_radix(C, t, cand);
}
#ifndef IPROBE
#define IPROBE(i) ((void)0)
#endif
constexpr int KT_LD = 144;
__device__ __forceinline__ void idx_set(const Ctx& C, int tb16, unsigned long long& tacc_) {
    unsigned long long tq_ = 0ull; (void)tq_; (void)tacc_;
    LAS uchar* kb = C.lds;
    LAS unsigned* hist = (LAS unsigned*)(C.lds + 36864);
    int tid = C.tid; asm volatile("" : "+v"(tid));
    const int lane = tid & 63, w = __builtin_amdgcn_readfirstlane(tid >> 6), r = lane & 31, hh = lane >> 5;
    const int tau = (r >> 2) & 1, eta = (r & 3) + 4 * (r >> 3);
    const bf16_t* QI = WSP(bf16_t, WS_QI); const bf16_t* KI = WSP(bf16_t, WS_KIDX); const float* WI = WSP(float, WS_WIDX);
    float* sc = WSP(float, WS_SC);
    LAS unsigned* cand = (LAS unsigned*)(C.lds + 36864 + 32768) + w * (2 * CAND_CAP + 8);
    __syncthreads();
    IPROBE(0);
    { LAS u32x4* hz = (LAS u32x4*)hist + tid;
#pragma unroll
      for (int j = 0; j < 4; ++j) hz[NTHR * j] = (u32x4){0u, 0u, 0u, 0u}; }
    const int tb1 = tb16 + 2 * w, tmax1 = tb16 + 15;
    bf16x8 a1[4]; f32x4 w1[4];
#pragma unroll
    for (int ks = 0; ks < 4; ++ks) a1[ks] = *(const bf16x8*)(QI + (size_t)(tb1 + tau) * 1024 + eta * 64 + 16 * ks + 8 * hh);
#pragma unroll
    for (int q = 0; q < 4; ++q) w1[q] = *(const f32x4*)(WI + (size_t)(tb1 + hh) * 16 + 4 * q);
    const int ntile = (tmax1 >> 7) + 1;
#pragma unroll
    for (int ks = 0; ks < 4; ++ks) asm volatile("" :: "v"(a1[ks]), "v"(w1[ks]));
    const int kr0 = tid >> 3, kc = tid & 7;
    u32x4 pre0 = *(const u32x4*)(KI + (size_t)kr0 * 64 + kc * 8), pre1 = *(const u32x4*)(KI + (size_t)(kr0 + 64) * 64 + kc * 8);
    float vh[4] = {0.f, 0.f, 0.f, 0.f};
#pragma unroll 1
    for (int kt = 0; kt < ntile; ++kt) {
        LAS uchar* buf = kb + (kt & 1) * 18432;
        *(LAS u32x4*)(buf + kr0 * KT_LD + kc * 16) = pre0; *(LAS u32x4*)(buf + (kr0 + 64) * KT_LD + kc * 16) = pre1;
        LDS_BARRIER();
        if (kt > 0) {
#pragma unroll
            for (int sub = 0; sub < 4; ++sub) sc[(size_t)(tb1 + hh) * S + 128 * (kt - 1) + 32 * sub + r] = vh[sub]; }
        { const int kn = (kt + 1 < ntile) ? kt + 1 : kt; const bf16_t* kp = KI + (size_t)(128 * kn) * 64; pre0 = *(const u32x4*)(kp + (size_t)kr0 * 64 + kc * 8); pre1 = *(const u32x4*)(kp + (size_t)(kr0 + 64) * 64 + kc * 8); }
#pragma unroll
        for (int sub = 0; sub < 4; ++sub) { const int s = 128 * kt + 32 * sub + r;
            bf16x8 b[4];
#pragma unroll
            for (int ks = 0; ks < 4; ++ks) b[ks] = *(const LAS bf16x8*)(buf + (32 * sub + r) * KT_LD + (2 * ks + hh) * 16);
            f32x16 acc;
#pragma unroll
            for (int q = 0; q < 16; ++q) acc[q] = 0.f;
#pragma unroll
            for (int ks = 0; ks < 4; ++ks) acc = MFMA32(a1[ks], b[ks], acc);
            float v4_[4] = {0.f, 0.f, 0.f, 0.f};
#pragma unroll
            for (int q = 0; q < 16; ++q) v4_[q & 3] += w1[q >> 2][q & 3] * relu_i(acc[q]);
            float v = (v4_[0] + v4_[1]) + (v4_[2] + v4_[3]); asm volatile("" : "+v"(v));
            vh[sub] = v;
            if (s <= tb1 + hh) { const int bk = sbucket(v); lds_add(hist + (2 * w + hh) * 512 + (bk >> 1), 1u << (16 * (bk & 1))); } }
    }
#pragma unroll
    for (int sub = 0; sub < 4; ++sub) sc[(size_t)(tb1 + hh) * S + 128 * (ntile - 1) + 32 * sub + r] = vh[sub];
    asm volatile("s_waitcnt vmcnt(0) lgkmcnt(0)" ::: "memory");
    IPROBE(1);
    select_row(C, tb1, hist + (2 * w) * 512, cand); select_row(C, tb1 + 1, hist + (2 * w + 1) * 512, cand);
    IPROBE(2);
}

#ifndef APROBE
#define APROBE(i) ((void)0)
#endif
__device__ __forceinline__ void p3_attention(const Ctx& C, int tbase0, int ntok, unsigned long long& tacc_) {
    unsigned long long tq_ = 0ull; (void)tq_; (void)tacc_;
    int tid_ = C.tid; asm volatile("" : "+v"(tid_));
    const int lane = tid_ & 63, w = __builtin_amdgcn_readfirstlane(tid_ >> 6), g = lane >> 4, h = lane & 15;
    LAS uchar* img = C.lds;
    LAS float* mx = (LAS float*)(C.lds + LDS_X);
    LAS float* ls = mx + 128;
    LAS uchar* pf = C.lds + LDS_X + 1024;
    LAS bf16_t* obuf = (LAS bf16_t*)(C.lds + LDS_X + 10240);
    const bf16_t* CK = WSP(bf16_t, WS_CKV);
    const float scale = 0.08838834764831845f;
    const int tstep = 1, niter = ntok, tbase = tbase0, tlast = tbase + (niter - 1) * tstep;
    __syncthreads();
    const int* IDXp = WSP(int, WS_IDX) + 32 * w + (lane & 31);
    int myidx = IDXp[(size_t)tbase * TOPK];
    int idx1 = IDXp[(size_t)(tbase + tstep <= tlast ? tbase + tstep : tlast) * TOPK];
    int tprev = -1;
    bf16x8 bq[8];
    { const bf16_t* qa = WSP(bf16_t, WS_QABS) + (size_t)tbase * 2048 + (h & 7) * 256 + 8 * g;
#pragma unroll
      for (int kc = 0; kc < 8; ++kc) bq[kc] = *(const bf16x8*)(qa + 32 * kc); }
    u32x4 gv[16];
#pragma unroll
    for (int i = 0; i < 16; ++i) { const int rl = 2 * i + (lane >> 5); const int key = __shfl(myidx, rl); const int kk = (key < 0 || key > tbase) ? 0 : key; gv[i] = *(const u32x4*)(CK + (size_t)kk * CKV + (lane & 31) * 8); }
#pragma unroll 1
    for (int it = 0; it < niter; ++it) {
        const int t = tbase + it * tstep;
        APROBE(0);
        const int t1 = (t + tstep <= tlast) ? t + tstep : tlast, t2 = (t + 2 * tstep <= tlast) ? t + 2 * tstep : tlast;
#pragma unroll
        for (int i = 0; i < 16; ++i) { const int rl = 2 * i + (lane >> 5), ch32 = lane & 31; *(LAS u32x4*)(img + (ch32 >> 4) * 65536 + imgb_off(32 * w + rl, ch32 & 15)) = gv[i]; }
        APROBE(1);
        if (tprev >= 0 && tid_ < 256) *(u32x4*)(WSP(bf16_t, WS_OB) + (size_t)tprev * 2048 + tid_ * 8) = *(const LAS u32x4*)(obuf + tid_ * 8);
        f32x4 x0 = {0.f, 0.f, 0.f, 0.f}, x1 = {0.f, 0.f, 0.f, 0.f};
        const unsigned rho0 = 32u * w + 8u * (h >> 2) + (h & 3);
#pragma unroll
        for (int kc = 0; kc < 8; ++kc) { const unsigned ch = (4u * kc + g) & 15u; LAS uchar* ib = img + (kc >> 2) * 65536;
            const bf16x8 a0 = *(LAS bf16x8*)(ib + imgb_off(rho0, ch)), a1 = *(LAS bf16x8*)(ib + imgb_off(rho0 + 4u, ch));
            bf16x8 bb = bq[kc]; if (h >= 8) bb = (bf16x8){0, 0, 0, 0, 0, 0, 0, 0};
            x0 = MFMA16(a0, bb, x0); x1 = MFMA16(a1, bb, x1); }
        __builtin_amdgcn_sched_barrier(0);
        const int idx2 = IDXp[(size_t)t2 * TOPK];
#pragma unroll
        for (int i = 0; i < 16; ++i) { const int rl = 2 * i + (lane >> 5); const int key = __shfl(idx1, rl); const int kk = (key < 0 || key > t1) ? 0 : key; gv[i] = *(const u32x4*)(CK + (size_t)kk * CKV + (lane & 31) * 8); }
        __builtin_amdgcn_sched_barrier(0);
        float lg[8]; float m = -1e30f;
#pragma unroll
        for (int r = 0; r < 4; ++r) { const int k0 = __shfl(myidx, 8 * g + r), k1 = __shfl(myidx, 8 * g + 4 + r); const bool v0 = k0 >= 0 && k0 <= t, v1 = k1 >= 0 && k1 <= t;
            lg[r] = v0 ? x0[r] * scale : -1e30f; lg[4 + r] = v1 ? x1[r] * scale : -1e30f; m = fmaxf(m, fmaxf(lg[r], lg[4 + r])); }
        m = fmaxf(m, __shfl_xor(m, 16)); m = fmaxf(m, __shfl_xor(m, 32));
        if (g == 0) mx[w * 16 + h] = m;
        LDS_BARRIER();
        APROBE(2);
        float M = mx[h];
#pragma unroll
        for (int ww = 1; ww < 8; ++ww) M = fmaxf(M, mx[ww * 16 + h]);
        float p[8], sum = 0.f;
#pragma unroll
        for (int j = 0; j < 8; ++j) { p[j] = ex2((lg[j] - M) * LOG2E); sum += p[j]; }
        sum += __shfl_xor(sum, 16); sum += __shfl_xor(sum, 32);
        if (g == 0) ls[w * 16 + h] = sum;
        { u32x4 pk; pk.x = pk2(p[0], p[1]); pk.y = pk2(p[2], p[3]); pk.z = pk2(p[4], p[5]); pk.w = pk2(p[6], p[7]); *(LAS u32x4*)(pf + (w * 64 + lane) * 16) = pk; }
        LDS_BARRIER();
        APROBE(3);
        { const bf16_t* qa = WSP(bf16_t, WS_QABS) + (size_t)t1 * 2048 + (h & 7) * 256 + 8 * g;
#pragma unroll
          for (int kc = 0; kc < 8; ++kc) bq[kc] = *(const bf16x8*)(qa + 32 * kc); }
        __builtin_amdgcn_sched_barrier(0);
        float L = ls[h];
#pragma unroll
        for (int ww = 1; ww < 8; ++ww) L += ls[ww * 16 + h];
        f32x4 z0 = {0.f, 0.f, 0.f, 0.f}, z1 = {0.f, 0.f, 0.f, 0.f};
#pragma unroll
        for (int ks = 0; ks < 8; ++ks) { const bf16x8 a = *(LAS bf16x8*)(pf + (ks * 64 + lane) * 16);
            { const unsigned cc = 2u * w; LAS uchar* ib = img + (cc >> 3) * 65536; const bf16x8 b = trrd8(ib + imgb_tr16(lane, cc & 7u, ks, 0), ib + imgb_tr16(lane, cc & 7u, ks, 1)); z0 = MFMA16(a, b, z0); }
            { const unsigned cc = 2u * w + 1u; LAS uchar* ib = img + (cc >> 3) * 65536; const bf16x8 b = trrd8(ib + imgb_tr16(lane, cc & 7u, ks, 0), ib + imgb_tr16(lane, cc & 7u, ks, 1)); z1 = MFMA16(a, b, z1); } }
        float rl[4];
#pragma unroll
        for (int r = 0; r < 4; ++r) rl[r] = 1.0f / __shfl(L, (4 * g + r) & 15);
        if (g < 2) {
#pragma unroll
            for (int r = 0; r < 4; ++r) { obuf[(4 * g + r) * 256 + 32 * w + h] = (bf16_t)(pk2(z0[r] * rl[r], 0.f) & 0xffffu); obuf[(4 * g + r) * 256 + 32 * w + 16 + h] = (bf16_t)(pk2(z1[r] * rl[r], 0.f) & 0xffffu); } }
        tprev = t;
        LDS_BARRIER();
        APROBE(4);
        myidx = idx1; idx1 = idx2;
    }
    if (tprev >= 0 && tid_ < 256) *(u32x4*)(WSP(bf16_t, WS_OB) + (size_t)tprev * 2048 + tid_ * 8) = *(const LAS u32x4*)(obuf + tid_ * 8);
}
__device__ __forceinline__ void p3_wuv(const Ctx& C) {
    LAS uchar* imgA0 = C.lds; LAS uchar* imgA1 = C.lds + 32768; LAS uchar* imgB0 = C.lds + 65536; LAS uchar* imgB1 = C.lds + 98304;
    LAS float* stg = (LAS float*)(C.lds) + C.wave * 16 * STG_LD;
    const int lane = C.lane, w = C.wave;
    for (int u = C.bid; u < 64 * NH; u += C.G) {
        const int h = u & 7, t0 = (u >> 3) * 128;
        __syncthreads();
        { u32x4 va0[4], va1[4], vb0[4], vb1[4];
          img128_ld(va0, WSP(bf16_t, WS_OB) + (size_t)t0 * 2048 + h * 256, 2048, C.tid);
          img128_ld(va1, WSP(bf16_t, WS_OB) + (size_t)t0 * 2048 + h * 256 + 128, 2048, C.tid);
          img128_ld(vb0, WSP(bf16_t, WS_WUV) + (size_t)h * 256 * 128, 128, C.tid);
          img128_ld(vb1, WSP(bf16_t, WS_WUV) + (size_t)h * 256 * 128 + 128 * 128, 128, C.tid);
          __builtin_amdgcn_sched_barrier(0);
          img128_st(imgA0, va0, C.tid); img128_st(imgA1, va1, C.tid); img128_st(imgB0, vb0, C.tid); img128_st(imgB1, vb1, C.tid); }
        __syncthreads();
        f32x4 acc[8]; ZERO8(acc);
        trgemm(imgA0, imgB0, lane, w, acc); trgemm(imgA1, imgB1, lane, w, acc);
        __syncthreads();
        stage_store_bf16(stg, acc, WSP(bf16_t, WS_AB) + (size_t)(t0 + 16 * w) * 1024 + h * 128, 1024, lane);
    }
    __syncthreads();
}

struct EpiGateA {
    static constexpr bool PERM = true, AFTER_DRAIN = false;
    bf16_t* TMP; const bf16_t* GATE;
    __device__ __forceinline__ void operator()(const f32x4 (&acc)[2][2][4][2], const pg8::Unit& u, int wr, int wc, int fr, int fq) const {
        const int row0 = u.pm * 256 + wr * 64 + fr, col0 = u.pn * 256 + wc * 32 + 8 * fq;
#pragma unroll
        for (int ai = 0; ai < 2; ++ai)
#pragma unroll
            for (int m = 0; m < 4; ++m) { const size_t row = (size_t)(row0 + ai * 128 + m * 16);
#pragma unroll
                for (int bj = 0; bj < 2; ++bj) { const u32x4 gv = *(const u32x4*)(GATE + row * 4096 + col0 + bj * 128); const f32x4 v0 = acc[ai][bj][m][0], v1 = acc[ai][bj][m][1];
                    u32x4 w; w.x = pk2(v0[0] * bf_lo(gv.x), v0[1] * bf_hi(gv.x)); w.y = pk2(v0[2] * bf_lo(gv.y), v0[3] * bf_hi(gv.y));
                    w.z = pk2(v1[0] * bf_lo(gv.z), v1[1] * bf_hi(gv.z)); w.w = pk2(v1[2] * bf_lo(gv.w), v1[3] * bf_hi(gv.w));
                    *(u32x4*)(TMP + row * D + col0 + bj * 128) = w; } }
    }
};
struct EpiGateB {
    static constexpr bool PERM = true, AFTER_DRAIN = false;
    const bf16_t* TMP; const bf16_t* GATE; bf16_t* MG;
    __device__ __forceinline__ void operator()(const f32x4 (&acc)[2][2][4][2], const pg8::Unit& u, int wr, int wc, int fr, int fq) const {
        const int row0 = u.pm * 256 + wr * 64 + fr, col0 = u.pn * 256 + wc * 32 + 8 * fq;
#pragma unroll
        for (int ai = 0; ai < 2; ++ai)
#pragma unroll
            for (int m = 0; m < 4; ++m) { const size_t row = (size_t)(row0 + ai * 128 + m * 16);
#pragma unroll
                for (int bj = 0; bj < 2; ++bj) { const u32x4 gv = *(const u32x4*)(GATE + row * 4096 + 2048 + col0 + bj * 128); const f32x4 v0 = acc[ai][bj][m][0], v1 = acc[ai][bj][m][1];
                    const u32x4 tv = *(const u32x4*)(TMP + row * D + col0 + bj * 128);
                    u32x4 w; w.x = pk2(bf_lo(tv.x) + v0[0] * bf_lo(gv.x), bf_hi(tv.x) + v0[1] * bf_hi(gv.x)); w.y = pk2(bf_lo(tv.y) + v0[2] * bf_lo(gv.y), bf_hi(tv.y) + v0[3] * bf_hi(gv.y));
                    w.z = pk2(bf_lo(tv.z) + v1[0] * bf_lo(gv.z), bf_hi(tv.z) + v1[1] * bf_hi(gv.z)); w.w = pk2(bf_lo(tv.w) + v1[2] * bf_lo(gv.w), bf_hi(tv.w) + v1[3] * bf_hi(gv.w));
                    *(u32x4*)(MG + row * D + col0 + bj * 128) = w; } }
    }
};
struct EpiRes {
    static constexpr bool PERM = false, AFTER_DRAIN = false;
    const float* X; float* H;
    __device__ __forceinline__ void operator()(const f32x4 (&acc)[2][2][4][2], const pg8::Unit& u, int wr, int wc, int fr, int fq) const {
        const int row0 = u.pm * 256 + wr * 64 + fr, col0 = u.pn * 256 + wc * 32 + 4 * fq;
#pragma unroll
        for (int ai = 0; ai < 2; ++ai) {
            f32x4 xv[4][2][2];
#pragma unroll
            for (int m = 0; m < 4; ++m) { const size_t off = (size_t)(row0 + ai * 128 + m * 16) * D + col0;
#pragma unroll
                for (int bj = 0; bj < 2; ++bj)
#pragma unroll
                    for (int n = 0; n < 2; ++n) xv[m][bj][n] = *(const f32x4*)(X + off + bj * 128 + n * 16); }
            __builtin_amdgcn_sched_barrier(0);
#pragma unroll
            for (int m = 0; m < 4; ++m) { const size_t off = (size_t)(row0 + ai * 128 + m * 16) * D + col0;
#pragma unroll
                for (int bj = 0; bj < 2; ++bj)
#pragma unroll
                    for (int n = 0; n < 2; ++n) *(f32x4*)(H + off + bj * 128 + n * 16) = xv[m][bj][n] + acc[ai][bj][m][n]; }
            __builtin_amdgcn_sched_barrier(0);
        }
    }
};
#ifndef RPROBE
#define RPROBE(i) ((void)0)
#endif
__device__ __forceinline__ void p6_router(const Ctx& C, unsigned long long& tacc_) {
    unsigned long long tq_ = 0ull; (void)tq_; (void)tacc_;
    constexpr int XLD = 68;
    LAS float* part = (LAS float*)C.lds;
    LAS float* xst = (LAS float*)C.lds + C.wave * (2 * 32 * XLD);
    LAS float* rsum = (LAS float*)(C.lds + 139264);
    LAS float* rs = rsum + 256;
    LAS float* lgt = rs + 32;
    const int lane = C.lane, w = C.wave, tid = C.tid;
    const float* H = C.out;
    unsigned* cnt = WSP(unsigned, WS_CTL) + CW_CNT;
#pragma unroll 1
    for (int u = C.bid; u < S / 32; u += C.G) {
        const int t0 = 32 * u;
        __syncthreads();
        RPROBE(0);
        RPROBE(1);
        {   f32x4 acc[2][5];
#pragma unroll
            for (int a = 0; a < 2; ++a)
#pragma unroll
                for (int b = 0; b < 5; ++b) acc[a][b] = (f32x4){0.f, 0.f, 0.f, 0.f};
            const int c = lane & 15, kq = lane >> 4;
            const float* hrow = H + (size_t)(t0 + kq) * D + 256 * w + 4 * c;
            const float* bp = WSP(float, WS_WRT) + (size_t)(64 * w) * 320 + lane;
            f32x4 st[8]; float sq[8];
#pragma unroll
            for (int j = 0; j < 8; ++j) { st[j] = *(const f32x4*)(hrow + (size_t)(4 * j) * D); sq[j] = 0.f; }
            constexpr int NB = 8;
            float cb_[NB][5];
#pragma unroll
            for (int q = 0; q < NB; ++q)
#pragma unroll
                for (int cb = 0; cb < 5; ++cb) cb_[q][cb] = bp[(size_t)(q * 5 + cb) * 64];
#pragma unroll 1
            for (int ch = 0; ch < 4; ++ch) {
                LAS float* xs = xst + (ch & 1) * (32 * XLD);
#pragma unroll
                for (int j = 0; j < 8; ++j) { sq[j] += (st[j].x * st[j].x + st[j].y * st[j].y) + (st[j].z * st[j].z + st[j].w * st[j].w); *(LAS f32x4*)(xs + (4 * j + kq) * XLD + 4 * c) = st[j]; }
                { const int cn = (ch + 1 < 4) ? ch + 1 : ch;
#pragma unroll
                  for (int j = 0; j < 8; ++j) st[j] = *(const f32x4*)(hrow + (size_t)(4 * j) * D + 64 * cn); }
#pragma unroll
                for (int hb = 0; hb < 2; ++hb) {
                    float nb[NB][5];
                    const int bt = 2 * ch + hb, kn = (bt + 1 < 8) ? NB * (bt + 1) : 0;
#pragma unroll
                    for (int q = 0; q < NB; ++q)
#pragma unroll
                        for (int cb = 0; cb < 5; ++cb) nb[q][cb] = bp[(size_t)((kn + q) * 5 + cb) * 64];
                    __builtin_amdgcn_sched_barrier(0);
#pragma unroll
                    for (int q = 0; q < NB; ++q) { const float a0 = xs[c * XLD + 4 * (NB * hb + q) + kq], a1 = xs[(16 + c) * XLD + 4 * (NB * hb + q) + kq];
#pragma unroll
                        for (int cb = 0; cb < 5; ++cb) { acc[0][cb] = __builtin_amdgcn_mfma_f32_16x16x4f32(a0, cb_[q][cb], acc[0][cb], 0, 0, 0); acc[1][cb] = __builtin_amdgcn_mfma_f32_16x16x4f32(a1, cb_[q][cb], acc[1][cb], 0, 0, 0); } }
                    __builtin_amdgcn_sched_barrier(0);
#pragma unroll
                    for (int q = 0; q < NB; ++q)
#pragma unroll
                        for (int cb = 0; cb < 5; ++cb) cb_[q][cb] = nb[q][cb];
                }
            }
#pragma unroll
            for (int j = 0; j < 8; ++j) { float v = sq[j]; v += __shfl_xor(v, 1); v += __shfl_xor(v, 2); v += __shfl_xor(v, 4); v += __shfl_xor(v, 8); if (c == 0) rsum[w * 32 + 4 * j + kq] = v; }
            __syncthreads();
#pragma unroll
            for (int rb = 0; rb < 2; ++rb)
#pragma unroll
                for (int cb = 0; cb < 5; ++cb)
#pragma unroll
                    for (int i = 0; i < 4; ++i) part[(w * 32 + 16 * rb + 4 * kq + i) * 80 + 16 * cb + c] = acc[rb][cb][i];
            if (tid < 32) { float q = 0.f;
#pragma unroll
                for (int ww = 0; ww < 8; ++ww) q += rsum[ww * 32 + tid];
                rs[tid] = 1.0f / sqrtf(q * (1.f / D) + EPS); }
        }
        __syncthreads();
        RPROBE(2);
        for (int o = tid; o < 32 * 80; o += NTHR) { const int tok = o / 80; float s = 0.f;
#pragma unroll
            for (int ww = 0; ww < 8; ++ww) s += part[ww * 2560 + o];
            lgt[o] = s * rs[tok]; }
#pragma unroll 1
        for (int rr = 0; rr < 4; rr += 2) { const int t = t0 + 4 * w + rr;
            const f32x4* hr = (const f32x4*)(H + (size_t)t * D) + lane; const f32x4* gr = (const f32x4*)C.in[I_N2G] + lane;
            f32x4 v[8], v2[8];
#pragma unroll
            for (int j = 0; j < 8; ++j) { v[j] = hr[64 * j]; v2[j] = hr[64 * j + D / 4]; }
            f32x4 gq[8];
#pragma unroll
            for (int j = 0; j < 8; ++j) gq[j] = gr[64 * j];
            const float rstd = rs[4 * w + rr], rstd2 = rs[4 * w + rr + 1];
            u32x2* o = WSP(u32x2, WS_N1) + (size_t)t * (D / 4) + lane;
#pragma unroll
            for (int j = 0; j < 8; ++j) { const f32x4 g = gq[j]; u32x2 ww; ww.x = pk2(v[j].x * rstd * g.x, v[j].y * rstd * g.y); ww.y = pk2(v[j].z * rstd * g.z, v[j].w * rstd * g.w); o[64 * j] = ww;
                u32x2 w2; w2.x = pk2(v2[j].x * rstd2 * g.x, v2[j].y * rstd2 * g.y); w2.y = pk2(v2[j].z * rstd2 * g.z, v2[j].w * rstd2 * g.w); o[64 * j + D / 4] = w2; } }
        __syncthreads();
        if (tid < 32) { const int t = t0 + tid; const LAS float* l = lgt + tid * 80;
            int gi = 0; float gm = l[0] + C.in[I_BGRP][0];
#pragma unroll
            for (int i = 1; i < 8; ++i) { const float v = l[i] + C.in[I_BGRP][i]; if (v > gm) { gm = v; gi = i; } }
            float den = 0.f;
#pragma unroll
            for (int i = 0; i < 8; ++i) den += __expf(l[i] + C.in[I_BGRP][i] - gm);
            const float gval = 1.0f / den;
            const LAS float* el = l + 16 + 8 * gi; const float* be = C.in[I_BRT] + 8 * gi;
            int i0 = 0; float v0 = el[0] + be[0];
#pragma unroll
            for (int i = 1; i < 8; ++i) { const float v = el[i] + be[i]; if (v > v0) { v0 = v; i0 = i; } }
            int i1 = 0; float v1 = -3.0e38f;
#pragma unroll
            for (int i = 0; i < 8; ++i) { const float v = el[i] + be[i]; if (i != i0 && v > v1) { v1 = v; i1 = i; } }
            const float q0 = 1.0f / (1.0f + __expf(v1 - v0)), q1 = 1.0f - q0;
            const int e0 = 8 * gi + i0, e1 = 8 * gi + i1;
            const int p0 = (int)atomicAdd(cnt + 64 * e0, 1u), p1 = (int)atomicAdd(cnt + 64 * e1, 1u);
            int* list = WSP(int, WS_LIST); float* cw = WSP(float, WS_CWT);
            if (p0 < S) list[e0 * S + p0] = 2 * t; if (p1 < S) list[e1 * S + p1] = 2 * t + 1;
            cw[2 * t] = gval * q0; cw[2 * t + 1] = gval * q1; }
        RPROBE(3);
    }
    __syncthreads();
}
template <int MODE, int DBG = 0> __device__ __forceinline__ void moe_phase(const Ctx& C) {
    constexpr int K = (MODE == 1) ? D : FF, NSL = (MODE == 1) ? 8 : 16, NKS = K / 64, BM = 256;
    constexpr int ABYTES = BM * 144, BBYTES = 64 * 256, AOFF = 2 * BBYTES;
    LAS uchar* lds = C.lds; LAS int* ridb = (LAS int*)(lds + AOFF + 2 * ABYTES);
    const int tid = C.tid, lane = C.lane, w = C.wave, g = lane >> 4, c16 = lane & 15;
    const unsigned* cnt = WSP(unsigned, WS_CTL) + CW_CNT; const int* list = WSP(int, WS_LIST);
    const bf16_t* N2 = WSP(bf16_t, WS_N1); bf16_t* HID = WSP(bf16_t, DBG ? WS_SC : WS_HID); bf16_t* Y = WSP(bf16_t, DBG ? WS_SC : WS_Y); const bf16_t* HIDR = WSP(bf16_t, WS_HID);
    const int n4 = 4 * (tid & 31), kr = tid >> 5;
    const unsigned bw_off = imgb_off((unsigned)kr, (unsigned)(n4 >> 3)) + 8u * ((n4 >> 2) & 1);
    const unsigned aw_off = (unsigned)((tid >> 3) * 144 + (tid & 7) * 16);
    LAS int* pfx = (LAS int*)(lds + AOFF + 2 * ABYTES + 2048);
    LAS float* cwl = (LAS float*)(lds + AOFF + 2 * ABYTES + 3072);
    __syncthreads();
    LAS int* mel = pfx + 128;
    if (tid == 0) { int acc = 0; for (int e = 0; e < NE; ++e) { pfx[e] = acc; int c = (int)cnt[64 * e]; if (c > S) c = S; mel[e] = c; acc += (c + BM - 1) / BM; } pfx[NE] = acc; }
    __syncthreads();
    const int ngroups = pfx[NE];
    const bool xdeal = (C.G % 8) == 0 && ((C.G >> 3) % NSL) == 0;
    const int y = C.bid >> 3, slots = xdeal ? (C.G >> 3) / NSL : 1;
    const int g0 = xdeal ? (C.bid & 7) + 8 * (y / NSL) : C.bid / NSL, gstep = xdeal ? 8 * slots : (C.G / NSL > 0 ? C.G / NSL : 1);
    const int sl = xdeal ? y % NSL : C.bid % NSL;
    const size_t ldb = (MODE == 1) ? FF : D;
    if (g0 < ngroups && (xdeal || C.bid < (C.G / NSL) * NSL)) {
        int gi = g0, e = 0;
        while (pfx[e + 1] <= gi) ++e;
        int m0 = (gi - pfx[e]) * BM, Me = mel[e];
        { const int r = m0 + (tid & (BM - 1)); ridb[tid & (BM - 1)] = list[e * S + (r < Me ? r : Me - 1)]; }
        __syncthreads();
        int cur = 0;
        const float* bsrc;
        { const int eb = (DBG == 2) ? 0 : e;
          if (MODE == 1) bsrc = (n4 < 64 ? C.in[I_WEG] : C.in[I_WEU]) + (size_t)eb * D * FF + sl * 64 + (n4 & 63);
          else bsrc = C.in[I_WED] + (size_t)eb * FF * D + sl * 128 + n4;
          bsrc += (size_t)kr * ldb; }
        const bf16_t* ap[4];
#define MOE_AP(RID) do { _Pragma("unroll") for (int j = 0; j < 4; ++j) { const int id = (DBG == 3) ? 0 : (RID)[(tid >> 3) + 64 * j]; ap[j] = ((MODE == 1) ? N2 + (size_t)(id >> 1) * D : HIDR + (size_t)id * FF) + (tid & 7) * 8; } } while (0)
        MOE_AP(ridb);
        u32x4 ra0[4], ra1[4]; f32x4 rb0[4], rb1[4];
#define MOE_LOAD(RA, RB, step) do { _Pragma("unroll") for (int j = 0; j < 4; ++j) { RA[j] = *(const u32x4*)(ap[j] + 64 * (step)); RB[j] = __builtin_nontemporal_load((const f32x4*)(bsrc + (size_t)(64 * (step) + 16 * j) * ldb)); } } while (0)
#define MOE_WRITE(RA, RB, bi) do { _Pragma("unroll") for (int j = 0; j < 4; ++j) { *(LAS u32x4*)(lds + AOFF + (bi) * ABYTES + aw_off + 9216 * j) = RA[j]; \
            *(LAS u32x2*)(lds + (bi) * BBYTES + bw_off + 4096 * j) = (u32x2){pk2(RB[j].x, RB[j].y), pk2(RB[j].z, RB[j].w)}; } } while (0)
#define MOE_COMPUTE(bi) do { _Pragma("unroll") for (int s = 0; s < 2; ++s) { \
            bf16x8 af[2]; _Pragma("unroll") for (int rbk = 0; rbk < 2; ++rbk) af[rbk] = *(const LAS bf16x8*)(lds + AOFF + (bi) * ABYTES + (32 * w + 16 * rbk + c16) * 144 + (4 * s + g) * 16); \
            _Pragma("unroll") for (int cg = 0; cg < 2; ++cg) { \
                bf16x8 bf[4]; _Pragma("unroll") for (int c = 0; c < 4; ++c) bf[c] = trrd8(lds + (bi) * BBYTES + imgb_tr16(lane, 4 * cg + c, s, 0), lds + (bi) * BBYTES + imgb_tr16(lane, 4 * cg + c, s, 1)); \
                _Pragma("unroll") for (int rbk = 0; rbk < 2; ++rbk) { if (rbk < nrb) { _Pragma("unroll") for (int c = 0; c < 4; ++c) acc[rbk][4 * cg + c] = MFMA16(af[rbk], bf[c], acc[rbk][4 * cg + c]); } } \
                __builtin_amdgcn_sched_barrier(0); } } } while (0)
        MOE_LOAD(ra0, rb0, 0);
        __builtin_amdgcn_sched_barrier(0);
        MOE_LOAD(ra1, rb1, 1);
        __builtin_amdgcn_sched_barrier(0);
        {
            bf16_t* dummy0 = WSP(bf16_t, WS_SC) + (size_t)(64 << 20) + (size_t)C.bid * 65536 + tid * 8;
#pragma unroll
            for (int i = 0; i < ((MODE == 1) ? 4 : 8); ++i) *(u32x4*)(dummy0 + 4096 * i) = (u32x4){0u, 0u, 0u, 0u};
        }
        __builtin_amdgcn_sched_barrier(0);
#pragma unroll 1
        for (;;) {
            LAS int* rid = ridb + 256 * cur; LAS int* ridn = ridb + 256 * (cur ^ 1);
            const int gin = gi + gstep; const bool hn = gin < ngroups;
            int en = e; if (hn) { while (pfx[en + 1] <= gin) ++en; }
            int m0n = m0, Men = Me; if (hn) { m0n = (gin - pfx[en]) * BM; Men = mel[en]; }
            int ridv; { const int r = m0n + (tid & (BM - 1)); ridv = list[en * S + (r < Men ? r : Men - 1)]; }
            float cwv = 0.f; if (MODE == 1) cwv = WSP(float, WS_CWT)[rid[tid & (BM - 1)]];
            int nrb = (Me - m0 - 32 * w + 15) >> 4; nrb = nrb < 0 ? 0 : (nrb > 2 ? 2 : nrb);
            MOE_WRITE(ra0, rb0, 0);
            __syncthreads();
            f32x4 acc[2][8];
#pragma unroll
            for (int a = 0; a < 2; ++a)
#pragma unroll
                for (int b = 0; b < 8; ++b) acc[a][b] = (f32x4){0.f, 0.f, 0.f, 0.f};
#pragma unroll 1
            for (int ks = 0; ks < NKS - 2; ks += 2) {
                MOE_LOAD(ra0, rb0, ks + 2);
                __builtin_amdgcn_sched_barrier(0);
                MOE_COMPUTE(0);
                MOE_WRITE(ra1, rb1, 1);
                __syncthreads();
                MOE_LOAD(ra1, rb1, ks + 3);
                __builtin_amdgcn_sched_barrier(0);
                MOE_COMPUTE(1);
                MOE_WRITE(ra0, rb0, 0);
                __syncthreads();
            }
            MOE_COMPUTE(0);
            MOE_WRITE(ra1, rb1, 1);
            ridn[tid & (BM - 1)] = ridv;
            if (MODE == 1) cwl[tid & (BM - 1)] = cwv;
            __syncthreads();
            MOE_AP(ridn);
            { const int eb = (DBG == 2) ? 0 : (en - e); bsrc += (size_t)eb * ((MODE == 1) ? (size_t)D * FF : (size_t)FF * D); }
            MOE_LOAD(ra0, rb0, 0);
            __builtin_amdgcn_sched_barrier(0);
            MOE_LOAD(ra1, rb1, 1);
            __builtin_amdgcn_sched_barrier(0);
            MOE_COMPUTE(1);
            LDS_BARRIER();
            int tid_e = tid; asm volatile("" : "+v"(tid_e));
            const int lane_e = tid_e & 63, w_e = tid_e >> 6, g_e = lane_e >> 4, c16_e = lane_e & 15;
            LAS bf16_t* stg = (LAS bf16_t*)(lds + w_e * 8192);
            bf16_t* dummy = WSP(bf16_t, WS_SC) + (size_t)(64 << 20) + (size_t)C.bid * 65536 + tid_e * 8;
            if (MODE == 1) {
#pragma unroll
                for (int rbk = 0; rbk < 2; ++rbk)
#pragma unroll
                    for (int r = 0; r < 4; ++r) { const int rowl = 16 * rbk + 4 * g_e + r; const float cw = cwl[32 * w_e + rowl];
#pragma unroll
                        for (int c = 0; c < 4; ++c) stg[rowl * 64 + 16 * c + c16_e] = (bf16_t)(pk2(silu_(acc[rbk][c][r]) * acc[rbk][c + 4][r] * cw, 0.f) & 0xffffu); }
#pragma unroll
                for (int i = 0; i < 4; ++i) { const int q = lane_e + 64 * i, row = q >> 3, ch = q & 7;
                    bf16_t* dst = (m0 + 32 * w_e + row < Me) ? HID + (size_t)rid[32 * w_e + row] * FF + sl * 64 + ch * 8 : dummy;
                    *(u32x4*)dst = *(const LAS u32x4*)(stg + row * 64 + ch * 8); }
            } else {
#pragma unroll
                for (int rbk = 0; rbk < 2; ++rbk)
#pragma unroll
                    for (int r = 0; r < 4; ++r) { const int rowl = 16 * rbk + 4 * g_e + r;
#pragma unroll
                        for (int c = 0; c < 8; ++c) stg[rowl * 128 + 16 * c + c16_e] = (bf16_t)(pk2(acc[rbk][c][r], 0.f) & 0xffffu); }
#pragma unroll
                for (int i = 0; i < 8; ++i) { const int q = lane_e + 64 * i, row = q >> 4, ch = q & 15;
                    bf16_t* dst = (m0 + 32 * w_e + row < Me) ? Y + (size_t)rid[32 * w_e + row] * D + sl * 128 + ch * 8 : dummy;
                    *(u32x4*)dst = *(const LAS u32x4*)(stg + row * 128 + ch * 8); }
            }
            if (!hn) break;
            LDS_BARRIER();
            gi = gin; e = en; m0 = m0n; Me = Men; cur ^= 1;
        }
        asm volatile("s_waitcnt vmcnt(0)" ::: "memory");
#undef MOE_AP
#undef MOE_LOAD
#undef MOE_WRITE
#undef MOE_COMPUTE
    }
    __syncthreads();
}
__device__ __forceinline__ void p9_final(const Ctx& C) {
    const int gw = C.bid * NWAVE + C.wave, NGW = C.G * NWAVE, lane = C.lane;
    const bf16_t* Y = WSP(bf16_t, WS_Y);
    f32x4 gv[8];
#pragma unroll
    for (int j = 0; j < 8; ++j) gv[j] = ((const f32x4*)C.in[I_NFG] + lane)[64 * j];
    for (int t0 = gw; t0 < S; t0 += 2 * NGW) {
        const int tt[2] = {t0, (t0 + NGW < S) ? t0 + NGW : t0};
        f32x4 hv[2][8]; u32x2 ya[2][8], yb[2][8];
#pragma unroll
        for (int q = 0; q < 2; ++q) { const f32x4* hr = (const f32x4*)(C.out + (size_t)tt[q] * D) + lane;
            const u32x2* y0 = (const u32x2*)(Y + (size_t)(2 * tt[q]) * D) + lane; const u32x2* y1 = (const u32x2*)(Y + (size_t)(2 * tt[q] + 1) * D) + lane;
#pragma unroll
            for (int j = 0; j < 8; ++j) { hv[q][j] = hr[64 * j]; ya[q][j] = y0[64 * j]; yb[q][j] = y1[64 * j]; } }
#pragma unroll
        for (int q = 0; q < 2; ++q) { if (q == 1 && tt[1] == tt[0]) break;
            f32x4 v[8]; float ss = 0.f;
#pragma unroll
            for (int j = 0; j < 8; ++j) { const u32x2 a = ya[q][j], b = yb[q][j]; const f32x4 h4 = hv[q][j];
                v[j] = (f32x4){h4.x + (bf_lo(a.x) + bf_lo(b.x)), h4.y + (bf_hi(a.x) + bf_hi(b.x)), h4.z + (bf_lo(a.y) + bf_lo(b.y)), h4.w + (bf_hi(a.y) + bf_hi(b.y))};
                ss += (v[j].x * v[j].x + v[j].y * v[j].y) + (v[j].z * v[j].z + v[j].w * v[j].w); }
            const float rstd = 1.0f / sqrtf(wave_sum(ss) * (1.f / D) + EPS);
            f32x4* hw = (f32x4*)(C.out + (size_t)tt[q] * D) + lane;
#pragma unroll
            for (int j = 0; j < 8; ++j) { const f32x4 g = gv[j]; hw[64 * j] = (f32x4){v[j].x * rstd * g.x, v[j].y * rstd * g.y, v[j].z * rstd * g.z, v[j].w * rstd * g.w}; } }
    }
}

#ifndef MK_PROBE
#define MK_PROBE 0
#endif
struct Args { const float* in[22]; float* out; unsigned char* ws; int lo, hi, li, pad; };
constexpr int NPHASE = 11;
}

__global__ void __launch_bounds__(512, 2) mk_fwd(mk::Args a) {
    using namespace mk;
    extern __shared__ __attribute__((aligned(16))) unsigned char lds_raw[];
    Ctx C; C.lds = (LAS uchar*)lds_raw; C.tid = threadIdx.x; C.lane = C.tid & 63; C.wave = __builtin_amdgcn_readfirstlane(C.tid >> 6); C.G = gridDim.x; C.bid = blockIdx.x;
#pragma unroll
    for (int i = 0; i < 22; ++i) C.in[i] = a.in[i];
    C.out = a.out; C.ws = a.ws;
    volatile LAS unsigned* misc = (volatile LAS unsigned*)(C.lds + LDS_MISC);
    if (C.tid < 64) misc[C.tid] = 0u;
    __syncthreads();
    XcdBarrier bar = xcd_barrier_post((unsigned*)(C.ws + WS_CTL) + CW_BAR + a.li * XCD_BAR_WORDS, misc + 8);
    const int lo = a.lo, hi = a.hi;
#define IN(k) (lo <= (k) && (k) < hi)
#if MK_PROBE >= 20
    unsigned long long tacc = 0ull, tq0 = 0ull; (void)tq0;
#define TICK() (tq0 = __builtin_amdgcn_s_memrealtime())
#define TOCK() (tacc += __builtin_amdgcn_s_memrealtime() - tq0)
#else
#define TICK() ((void)0)
#define TOCK() ((void)0)
#endif
#if MK_PROBE >= 50 && MK_PROBE < 60
#define SEAM_MASK ((MK_PROBE == 50) ? 0x003 : (MK_PROBE == 51) ? 0x00c : (MK_PROBE == 52) ? 0x070 : 0x380)
#define SEAM(k) do { if (IN(k) && IN((k) + 1)) { if ((SEAM_MASK >> (k)) & 1) { TICK(); xcd_barrier(bar); TOCK(); } else xcd_barrier(bar); } } while (0)
#elif MK_PROBE == 20
#define SEAM(k) do { if (IN(k) && IN((k) + 1)) { TICK(); xcd_barrier(bar); TOCK(); } } while (0)
#else
#if MK_PROBE == 19
#define SEAM(k) do { if (IN(k) && IN((k) + 1)) { xcd_barrier(bar); xcd_barrier(bar); } } while (0)
#else
#define SEAM(k) do { if (IN(k) && IN((k) + 1)) xcd_barrier(bar); } while (0)
#endif
#endif
    LAS unsigned char* stage = (LAS unsigned char*)lds_raw;

#if MK_PROBE == 80
    TICK();
#endif
    if (IN(0)) { p0_prologue(C);
#if MK_PROBE == 1
        p0_prologue(C);
#endif
    }
#if MK_PROBE == 80
    TOCK();
#endif
    SEAM(0);
#if MK_PROBE == 81
    TICK();
#endif
    if (IN(1)) {
        pg8::Gemm g{WSP(bf16_t, WS_N1), WSP(bf16_t, WS_WINT), S, NPROJ, D}; ProjOrderA so; so.init(S, 32 * 256, C.G, C.bid);
        EpiProj E{WSP(bf16_t, WS_Q), WSP(bf16_t, WS_QI), WSP(bf16_t, WS_UV), WSP(bf16_t, WS_GATE), WSP(bf16_t, WS_KIDX), WSP(float, WS_CKVF), WSP(float, WS_LNS), WSP(float, WS_WIDX)};
        pg8::gemm_phase<EpiProj, ProjOrderA, true, true>(stage, g, so, E);
    }
#if MK_PROBE == 81
    TOCK();
#endif
    SEAM(1);
    if (IN(2)) {
        const bool split = (C.G % 4) == 0 && C.G / 4 >= 64;
        if (split && (C.bid & 3) == 0 && (C.bid >> 2) < 64) {
            pg8::Gemm g{WSP(bf16_t, WS_N1), WSP(bf16_t, WS_WINT), S, NPROJ, D}; ProjOrderB so; so.j = C.bid >> 2;
            EpiProj E{WSP(bf16_t, WS_Q), WSP(bf16_t, WS_QI), WSP(bf16_t, WS_UV), WSP(bf16_t, WS_GATE), WSP(bf16_t, WS_KIDX), WSP(float, WS_CKVF), WSP(float, WS_LNS), WSP(float, WS_WIDX)};
            pg8::gemm_phase<EpiProj, ProjOrderB, true, true>(stage, g, so, E);
        } else {
            Ctx C2 = C;
            if (split) { const int q = C.bid >> 2; C2.bid = C.bid - (q < 64 ? q + 1 : 64); C2.G = C.G - 64; }
            else if (C.bid == 0) {   }
            p2_ckv_norm(C2); p2_qabs(C2); p2_gmlp(C2);
        }
        if (!split) {
            pg8::Gemm g{WSP(bf16_t, WS_N1), WSP(bf16_t, WS_WINT), S, NPROJ, D}; ProjOrderC so; so.G = C.G; so.c = C.bid;
            EpiProj E{WSP(bf16_t, WS_Q), WSP(bf16_t, WS_QI), WSP(bf16_t, WS_UV), WSP(bf16_t, WS_GATE), WSP(bf16_t, WS_KIDX), WSP(float, WS_CKVF), WSP(float, WS_LNS), WSP(float, WS_WIDX)};
            __syncthreads();
            pg8::gemm_phase<EpiProj, ProjOrderC, true, true>(stage, g, so, E);
        }
    }
    SEAM(2);
#if MK_PROBE == 83
    TICK();
#endif
    if (IN(3)) {
        unsigned long long ia_ = 0ull, aa_ = 0ull;
#pragma unroll 1
        for (int j = 2 * C.bid; j < 512; j += (j & 1) ? 2 * C.G - 1 : 1) { const int set = (j & 1) ? 511 - (j >> 1) : (j >> 1); idx_set(C, 16 * set, ia_); }
        __syncthreads();
#pragma unroll 1
        for (int j = 2 * C.bid; j < 512; j += (j & 1) ? 2 * C.G - 1 : 1) { const int set = (j & 1) ? 511 - (j >> 1) : (j >> 1); p3_attention(C, 16 * set, 16, aa_); __syncthreads(); }
#if MK_PROBE >= 40 && MK_PROBE < 50
        tacc += ia_;
#endif
#if MK_PROBE >= 100 && MK_PROBE < 110
        tacc += aa_;
#endif
    }
#if MK_PROBE == 83
    TOCK();
#endif
    SEAM(3);
    if (IN(4)) { p3_wuv(C); p0_late(C);
#if MK_PROBE == 11
        p3_wuv(C);
#endif
    }
    SEAM(4);
    if (IN(5)) {
        { pg8::Gemm g{WSP(bf16_t, WS_AB), WSP(bf16_t, WS_WAT), S, D, 1024}; pg8::StaticOrder so; so.init(S, D, C.G, C.bid);
          EpiGateA E{WSP(bf16_t, WS_QABS), WSP(bf16_t, WS_GATE)};
          pg8::gemm_phase<EpiGateA, pg8::StaticOrder, true, true>(stage, g, so, E); }
        __syncthreads();
        { pg8::Gemm g{WSP(bf16_t, WS_MB), WSP(bf16_t, WS_WBT), S, D, 1024}; pg8::StaticOrder so; so.init(S, D, C.G, C.bid);
          EpiGateB E{WSP(bf16_t, WS_QABS), WSP(bf16_t, WS_GATE), WSP(bf16_t, WS_N1)};
          pg8::gemm_phase<EpiGateB, pg8::StaticOrder, true, true>(stage, g, so, E); }
#if MK_PROBE == 6
        __syncthreads();
        { pg8::Gemm g{WSP(bf16_t, WS_AB), WSP(bf16_t, WS_WAT), S, D, 1024}; pg8::StaticOrder so; so.init(S, D, C.G, C.bid);
          EpiGateA E{WSP(bf16_t, WS_QABS), WSP(bf16_t, WS_GATE)};
          pg8::gemm_phase<EpiGateA, pg8::StaticOrder, true, true>(stage, g, so, E); }
        __syncthreads();
        { pg8::Gemm g{WSP(bf16_t, WS_MB), WSP(bf16_t, WS_WBT), S, D, 1024}; pg8::StaticOrder so; so.init(S, D, C.G, C.bid);
          EpiGateB E{WSP(bf16_t, WS_QABS), WSP(bf16_t, WS_GATE), WSP(bf16_t, WS_N1)};
          pg8::gemm_phase<EpiGateB, pg8::StaticOrder, true, true>(stage, g, so, E); }
#endif
    }
    SEAM(5);
    if (IN(6))
#if MK_PROBE == 7
    for (int rep = 0; rep < 2; ++rep)
#endif
    {
        pg8::Gemm g{WSP(bf16_t, WS_N1), WSP(bf16_t, WS_WOT), S, D, D}; pg8::StaticOrder so; so.init(S, D, C.G, C.bid);
        EpiRes E{C.in[I_X], C.out};
        pg8::gemm_phase<EpiRes, pg8::StaticOrder, true, true>(stage, g, so, E);
    }
    SEAM(6);
#if MK_PROBE == 21
    TICK();
#endif
    { unsigned long long rt_acc = 0ull; if (IN(7)) p6_router(C, rt_acc);
#if MK_PROBE >= 30
      tacc += rt_acc;
#endif
    }
#if MK_PROBE == 21
    TOCK();
#endif
    SEAM(7);
#if MK_PROBE == 88
    TICK();
#endif
    if (IN(8)) { moe_phase<1>(C);
#if MK_PROBE == 8
        moe_phase<1>(C);
#endif
#if MK_PROBE >= 61 && MK_PROBE <= 63
        moe_phase<1, MK_PROBE - 60>(C);
#endif
    }
#if MK_PROBE == 88
    TOCK();
#endif
    SEAM(8);
#if MK_PROBE == 89
    TICK();
#endif
    if (IN(9)) { moe_phase<2>(C);
#if MK_PROBE == 9
        moe_phase<2>(C);
#endif
#if MK_PROBE >= 71 && MK_PROBE <= 73
        moe_phase<2, MK_PROBE - 70>(C);
#endif
    }
#if MK_PROBE == 89
    TOCK();
#endif
    SEAM(9);
#if MK_PROBE == 22
    TICK();
#endif
    if (IN(10)) { p9_final(C);
#if MK_PROBE == 22
    TOCK();
#endif
#if MK_PROBE == 10
        p9_final(C);
#endif
    }
#if MK_PROBE >= 20
    if (C.bid == 0) { const unsigned long long te = __builtin_amdgcn_s_memrealtime(); while (__builtin_amdgcn_s_memrealtime() - te < 4ull * tacc) __builtin_amdgcn_s_sleep(8); }
#endif
#undef IN
#undef SEAM
}

#ifndef MK_SPLIT
#define MK_SPLIT 0
#endif
extern "C" void kernel_launch(void* const* d_in, const int* in_sizes, int n_in, void* d_out, int out_size, void* d_ws, size_t ws_size, hipStream_t stream) {
    using namespace mk;
    static int grid = 0;
    if (grid == 0) {
        int dev = 0, cus = 0, per_cu = 0;
        if (n_in != 22 || ws_size < WS_END) { fprintf(stderr, "kernel_launch: unexpected n_in %d / ws_size %zu (need %zu)\n", n_in, ws_size, (size_t)WS_END); }
        if (hipGetDevice(&dev) != hipSuccess || hipDeviceGetAttribute(&cus, hipDeviceAttributeMultiprocessorCount, dev) != hipSuccess) { fprintf(stderr, "kernel_launch: device query failed\n"); grid = -1; return; }
        if (hipFuncSetAttribute((const void*)mk_fwd, hipFuncAttributeMaxDynamicSharedMemorySize, LDS_BYTES) != hipSuccess) { fprintf(stderr, "kernel_launch: hipFuncSetAttribute failed\n"); grid = -1; return; }
        if (hipOccupancyMaxActiveBlocksPerMultiprocessor(&per_cu, (const void*)mk_fwd, NTHR, LDS_BYTES) != hipSuccess || per_cu < 1) fprintf(stderr, "kernel_launch: occupancy query reports %d\n", per_cu);
        (void)hipGetLastError();
        grid = cus;
    }
    if (grid < 0) return;
    (void)hipMemsetAsync((char*)d_ws + WS_CTL, 0, CTL_BYTES, stream);
    Args a{};
    for (int i = 0; i < 22; ++i) a.in[i] = (const float*)d_in[i];
    a.out = (float*)d_out; a.ws = (unsigned char*)d_ws; a.pad = 0;
#if MK_SPLIT
    for (int p = 0; p < NPHASE; ++p) { a.lo = p; a.hi = p + 1; a.li = 0; hipLaunchKernelGGL(mk_fwd, dim3(grid), dim3(NTHR), LDS_BYTES, stream, a); }
#else
    a.lo = 0; a.hi = NPHASE; a.li = 0;
    hipLaunchKernelGGL(mk_fwd, dim3(grid), dim3(NTHR), LDS_BYTES, stream, a);
#endif
}
```

```cpp
#include <hip/hip_runtime.h>
#include <cstdio>
#include <cstdint>
namespace pg8 {
#define PG8_LAS __attribute__((address_space(3)))
typedef unsigned short bf16_t;
typedef short bf16x8 __attribute__((ext_vector_type(8)));
typedef float f32x4 __attribute__((ext_vector_type(4)));
typedef unsigned u32x4 __attribute__((ext_vector_type(4)));
constexpr int BM = 256, BK = 64, HALF = 128, HTB = HALF * BK * 2  , STAGE_BYTES = 8 * HTB, NXCD = 8, WGM = 4;

__host__ __device__ __forceinline__ int lds_byte(int r, int c) { const int st = (r >> 4) * 2 + (c >> 5), rr = r & 15, cc = c & 31, ob = rr * 64 + cc * 2; return st * 1024 + (ob ^ (((ob >> 9) & 1) << 5)); }
__host__ __device__ __forceinline__ void stage_rc(int b, int& R, int& C) { const int st = b / 1024, sb = b % 1024, swz = sb ^ (((sb >> 9) & 1) << 5); R = (st >> 1) * 16 + swz / 64; C = (st & 1) * 32 + (swz % 64) / 2; }
__host__ __device__ __forceinline__ int perm32(int rho) { const int n = rho >> 4, i = rho & 15; return 8 * (i >> 2) + 4 * n + (i & 3); }

struct Unit { int pm, pn; };
struct Gemm { const bf16_t* A; const bf16_t* Bt; int M, N, K; };

struct StaticOrder {
    int nM, nN, nwg, G, c;
    __host__ __device__ void init(int M, int N, int G_, int c_) { nM = M / BM; nN = N / BM; nwg = nM * nN; G = G_; c = c_; }
    __host__ __device__ bool next(int i, Unit& u) const {
        const long L = (long)i * G + c; if (L >= nwg) return false;
        int wgid = (int)L; { const int q = nwg / NXCD, r = nwg % NXCD, xcd = wgid % NXCD, off = wgid / NXCD; wgid = (xcd < r ? xcd * (q + 1) : r * (q + 1) + (xcd - r) * q) + off; }
        const int nig = WGM * nN, gid = wgid / nig, fm = gid * WGM, gsz = (nM - fm) < WGM ? (nM - fm) : WGM;
        u.pm = fm + ((wgid % nig) % gsz); u.pn = (wgid % nig) / gsz; return true;
    }
    __device__ __forceinline__ void a_ready(const Unit&) const {}
    __device__ __forceinline__ void done(const Unit&) const {}
};

template <class Epi, class Sched, bool ALIGN_EPI = false, bool SP2 = false>
__device__ __forceinline__ void gemm_phase(PG8_LAS unsigned char* lds, const Gemm g, const Sched& S, const Epi& E) {
    const int tid = threadIdx.x, wid = __builtin_amdgcn_readfirstlane(tid >> 6), lane = tid & 63, wr = wid >> 2, wc = wid & 3, fr = lane & 15, fq = lane >> 4;
    const int K = g.K, nt = K / BK;
    unsigned voffA[2], voffB[2];
#pragma unroll
    for (int i = 0; i < 2; ++i) { int R, C; stage_rc(tid * 16 + i * 8192, R, C); const int Rb = Epi::PERM ? ((R & ~31) + perm32(R & 31)) : R;
        voffA[i] = (unsigned)(R * K + C) * 2u; voffB[i] = (unsigned)(Rb * K + C) * 2u; }
    const size_t kstep = (size_t)(BK * 2);
    const size_t hstep = (size_t)HALF * K * 2;
    const size_t tstep = 2 * hstep;
    const unsigned ldsw = (unsigned)wid * 1024u;
    const int aoff = lds_byte(wr * 64 + fr, fq * 8), boff = lds_byte(wc * 32 + fr, fq * 8);
#define PG8_SA(b, h) (((b) * 2 + (h)) * HTB)
#define PG8_SB(b, h) ((4 + (b) * 2 + (h)) * HTB)
#define PG8_STAGE(bufoff, gbase, voff) do { _Pragma("unroll") for (int _i = 0; _i < 2; ++_i) \
        __builtin_amdgcn_global_load_lds((const unsigned*)((const char*)(gbase) + (voff)[_i]), (PG8_LAS unsigned*)(lds + (bufoff) + ldsw + _i * 8192), 16, 0, 0); } while (0)
#define PG8_LDA(dst, b, h) do { _Pragma("unroll") for (int m = 0; m < 4; ++m) _Pragma("unroll") for (int k = 0; k < 2; ++k) dst[m][k] = *(const PG8_LAS bf16x8*)(lds + PG8_SA(b, h) + aoff + m * 2048 + k * 1024); } while (0)
#define PG8_LDB(dst, b, h) do { _Pragma("unroll") for (int n = 0; n < 2; ++n) _Pragma("unroll") for (int k = 0; k < 2; ++k) dst[n][k] = *(const PG8_LAS bf16x8*)(lds + PG8_SB(b, h) + boff + n * 2048 + k * 1024); } while (0)
#define PG8_MMA(ai, bj, At, Bt) do { __builtin_amdgcn_s_setprio(1); _Pragma("unroll") for (int m = 0; m < 4; ++m) _Pragma("unroll") for (int n = 0; n < 2; ++n) _Pragma("unroll") for (int k = 0; k < 2; ++k) \
        acc[ai][bj][m][n] = __builtin_amdgcn_mfma_f32_16x16x32_bf16(Bt[n][k], At[m][k], acc[ai][bj][m][n], 0, 0, 0); __builtin_amdgcn_s_setprio(0); } while (0)
#define PG8_WAIT_V(n) asm volatile("s_waitcnt vmcnt(" #n ")" ::: "memory")
#define PG8_WAIT_L(n) asm volatile("s_waitcnt lgkmcnt(" #n ")" ::: "memory")
#define PG8_BAR __builtin_amdgcn_s_barrier()
#define PG8_SCHED __builtin_amdgcn_sched_barrier(0)
    Unit cur, nxt; int ui = 0;
    if (!S.next(0, cur)) return;
    f32x4 acc[2][2][4][2];
#pragma unroll
    for (int a = 0; a < 2; ++a)
#pragma unroll
        for (int b = 0; b < 2; ++b)
#pragma unroll
            for (int m = 0; m < 4; ++m)
#pragma unroll
                for (int n = 0; n < 2; ++n) acc[a][b][m][n] = (f32x4){0.f, 0.f, 0.f, 0.f};
    bf16x8 At[4][2], B0[2][2], B1[2][2];
    const char* cA = (const char*)g.A + (size_t)cur.pm * tstep; const char* cB = (const char*)g.Bt + (size_t)cur.pn * tstep;
    S.a_ready(cur);
    if constexpr (SP2) {
        PG8_STAGE(PG8_SB(0, 0), cB, voffB); PG8_STAGE(PG8_SB(0, 1), cB + hstep, voffB); PG8_STAGE(PG8_SA(0, 0), cA, voffA); PG8_STAGE(PG8_SA(0, 1), cA + hstep, voffA);
        if (wr == 1) PG8_BAR;
        PG8_WAIT_V(2); PG8_BAR;
        PG8_STAGE(PG8_SB(1, 0), cB + kstep, voffB); PG8_STAGE(PG8_SA(1, 0), cA + kstep, voffA); PG8_STAGE(PG8_SB(1, 1), cB + hstep + kstep, voffB);
        PG8_WAIT_V(6); PG8_BAR;
    } else {
        PG8_STAGE(PG8_SB(0, 0), cB, voffB); PG8_STAGE(PG8_SA(0, 0), cA, voffA); PG8_STAGE(PG8_SB(0, 1), cB + hstep, voffB); PG8_STAGE(PG8_SA(0, 1), cA + hstep, voffA);
        if (wr == 1) PG8_BAR;
        PG8_WAIT_V(4); PG8_BAR;
        PG8_STAGE(PG8_SB(1, 0), cB + kstep, voffB); PG8_STAGE(PG8_SA(1, 0), cA + kstep, voffA); PG8_STAGE(PG8_SB(1, 1), cB + hstep + kstep, voffB);
        PG8_WAIT_V(6); PG8_BAR;
    }
    for (;;) {
        const bool has_next = S.next(ui + 1, nxt);
        const char* nA = has_next ? (const char*)g.A + (size_t)nxt.pm * tstep : cA; const char* nB = has_next ? (const char*)g.Bt + (size_t)nxt.pn * tstep : cB;
        for (int t = 0; t < nt; t += 2) {
            const bool last = (t == nt - 2);
            const char* a1 = cA + (size_t)(t + 1) * kstep;
            const char* a2 = last ? nA : cA + (size_t)(t + 2) * kstep; const char* b2 = last ? nB : cB + (size_t)(t + 2) * kstep;
            const char* a3 = a2 + kstep; const char* b3 = b2 + kstep;
            if (last && has_next) S.a_ready(nxt);
            if constexpr (SP2) {
            PG8_LDB(B0, 0, 0); PG8_LDB(B1, 0, 1); PG8_SCHED; PG8_LDA(At, 0, 0); PG8_STAGE(PG8_SA(1, 1), a1 + hstep, voffA);
            PG8_WAIT_V(8); PG8_WAIT_L(0); PG8_BAR; PG8_MMA(0, 0, At, B0); PG8_MMA(0, 1, At, B1); PG8_BAR; PG8_SCHED;
            PG8_LDA(At, 0, 1); PG8_STAGE(PG8_SB(0, 0), b2, voffB); PG8_STAGE(PG8_SB(0, 1), b2 + hstep, voffB); PG8_STAGE(PG8_SA(0, 0), a2, voffA);
            PG8_WAIT_V(8); PG8_WAIT_L(0); PG8_BAR; PG8_MMA(1, 0, At, B0); PG8_MMA(1, 1, At, B1); PG8_BAR; PG8_SCHED;
            PG8_LDB(B0, 1, 0); PG8_LDB(B1, 1, 1); PG8_SCHED; PG8_LDA(At, 1, 0); PG8_STAGE(PG8_SA(0, 1), a2 + hstep, voffA);
            PG8_WAIT_V(8); PG8_WAIT_L(0); PG8_BAR; PG8_MMA(0, 0, At, B0); PG8_MMA(0, 1, At, B1); PG8_BAR; PG8_SCHED;
            PG8_LDA(At, 1, 1); PG8_STAGE(PG8_SB(1, 0), b3, voffB); PG8_STAGE(PG8_SB(1, 1), b3 + hstep, voffB); PG8_STAGE(PG8_SA(1, 0), a3, voffA);
            PG8_WAIT_V(8); PG8_WAIT_L(0); PG8_BAR; PG8_MMA(1, 0, At, B0); PG8_MMA(1, 1, At, B1); PG8_BAR; PG8_SCHED;
            } else {
            PG8_LDB(B0, 0, 0); PG8_SCHED; PG8_LDA(At, 0, 0); PG8_STAGE(PG8_SA(1, 1), a1 + hstep, voffA);
            PG8_WAIT_L(8); PG8_BAR; PG8_WAIT_L(0); PG8_MMA(0, 0, At, B0); PG8_BAR; PG8_SCHED;
            PG8_LDB(B1, 0, 1); PG8_STAGE(PG8_SB(0, 0), b2, voffB);
            PG8_BAR; PG8_WAIT_L(0); PG8_MMA(0, 1, At, B1); PG8_BAR;
            PG8_LDA(At, 0, 1); PG8_STAGE(PG8_SA(0, 0), a2, voffA);
            PG8_BAR; PG8_WAIT_L(0); PG8_MMA(1, 0, At, B0); PG8_BAR; PG8_SCHED;
            PG8_STAGE(PG8_SB(0, 1), b2 + hstep, voffB);
            PG8_WAIT_V(6); PG8_BAR; PG8_MMA(1, 1, At, B1); PG8_BAR;
            PG8_LDB(B0, 1, 0); PG8_SCHED; PG8_LDA(At, 1, 0); PG8_STAGE(PG8_SA(0, 1), a2 + hstep, voffA);
            PG8_WAIT_L(8); PG8_BAR; PG8_WAIT_L(0); PG8_MMA(0, 0, At, B0); PG8_BAR; PG8_SCHED;
            PG8_LDB(B1, 1, 1); PG8_STAGE(PG8_SB(1, 0), b3, voffB);
            PG8_BAR; PG8_WAIT_L(0); PG8_MMA(0, 1, At, B1); PG8_BAR;
            PG8_LDA(At, 1, 1); PG8_STAGE(PG8_SA(1, 0), a3, voffA);
            PG8_BAR; PG8_WAIT_L(0); PG8_MMA(1, 0, At, B0); PG8_BAR; PG8_SCHED;
            PG8_STAGE(PG8_SB(1, 1), b3 + hstep, voffB);
            PG8_WAIT_V(6); PG8_BAR; PG8_MMA(1, 1, At, B1); PG8_BAR;
            }
        }
        if constexpr (ALIGN_EPI) { if (wr == 0) PG8_BAR; }
        bool keep = false;
        if constexpr (Epi::MIDK) { keep = E.is_mid(cur); if (keep) E.mid(acc, cur, wr, wc, fr, fq); else E(acc, cur, wr, wc, fr, fq); S.done(cur); }
        else if constexpr (!Epi::AFTER_DRAIN) { E(acc, cur, wr, wc, fr, fq); S.done(cur); }
        if (!has_next) break;
        if (!keep) {
#pragma unroll
        for (int a = 0; a < 2; ++a)
#pragma unroll
            for (int b = 0; b < 2; ++b)
#pragma unroll
                for (int m = 0; m < 4; ++m)
#pragma unroll
                    for (int n = 0; n < 2; ++n) acc[a][b][m][n] = (f32x4){0.f, 0.f, 0.f, 0.f};
        }
        cur = nxt; cA = nA; cB = nB; ++ui;
        if constexpr (ALIGN_EPI) { if (wr == 1) PG8_BAR; }
    }
    PG8_WAIT_V(0);
    if constexpr (!ALIGN_EPI) { if (wr == 0) PG8_BAR; }
    PG8_BAR;
    if constexpr (Epi::AFTER_DRAIN) { E.fused(acc, cur, wr, wc, fr, fq, lds, wid, lane); S.done(cur); }
#undef PG8_SA
#undef PG8_SB
#undef PG8_STAGE
#undef PG8_LDA
#undef PG8_LDB
#undef PG8_MMA
#undef PG8_WAIT_V
#undef PG8_WAIT_L
#undef PG8_BAR
#undef PG8_SCHED
}
}
#define LAS __attribute__((address_space(3)))
#define XB_TMO      128
#define XB_XCNT(j)  (256  + 64 * (j))
#define XB_XSUB(j)  (1280 + 64 * (j))
#define XB_XGEN(j)  (2304 + 64 * (j))
#define XB_TOP      3328
#define XB_TOPGEN   3392
#define XCD_BAR_WORDS 3456
#define XB_SPIN_CAP (1u << 22)

__device__ __forceinline__ unsigned xb_ld(unsigned* p)              { return __hip_atomic_load(p, __ATOMIC_RELAXED, __HIP_MEMORY_SCOPE_AGENT); }
__device__ __forceinline__ unsigned xb_add(unsigned* p, unsigned v) { return __hip_atomic_fetch_add(p, v, __ATOMIC_RELAXED, __HIP_MEMORY_SCOPE_AGENT); }
__device__ __forceinline__ unsigned xb_xcc_id() { return (unsigned)__builtin_amdgcn_s_getreg((3 << 11) | 20) & 0xFu; }
#define XB_SPIN(cond, bar) do { unsigned _sp = 0; while (cond) { __builtin_amdgcn_s_sleep(1); \
    if ((++_sp & 255u) == 0u) { if (xb_ld(&(bar)[XB_TMO])) break; if (_sp > XB_SPIN_CAP) { atomicAdd(&(bar)[XB_TMO], 1u); break; } } } } while (0)

struct XcdBarrier {
    unsigned* bar; unsigned x;
    volatile LAS unsigned* st;
};

__device__ __forceinline__ XcdBarrier xcd_barrier_post(unsigned* bar, volatile LAS unsigned* st) {
    XcdBarrier b; b.bar = bar; b.x = xb_xcc_id(); b.st = st;
    if (threadIdx.x == 0) (void)xb_add(&bar[XB_XCNT(b.x)], 1u);
    return b;
}
__device__ __forceinline__ void xcd_barrier_complete(unsigned* bar, unsigned x, unsigned& nloc, unsigned& nx) {
    const unsigned G = gridDim.x * gridDim.y * gridDim.z;
    unsigned sum, cnt, mine, sp = 0u;
    for (;;) {
        sum = 0u; cnt = 0u; mine = 0u;
#pragma unroll
        for (unsigned j = 0; j < 16; ++j) { const unsigned c = xb_ld(&bar[XB_XCNT(j)]); sum += c; cnt += (c > 0u) ? 1u : 0u; mine = (j == x) ? c : mine; }
        if (sum == G) break;
        __builtin_amdgcn_s_sleep(1);
        if ((++sp & 255u) == 0u) { if (xb_ld(&bar[XB_TMO])) break; if (sp > XB_SPIN_CAP) { atomicAdd(&bar[XB_TMO], 1u); break; } }
    }
    nloc = mine > 0u ? mine : 1u; nx = cnt > 0u ? cnt : 1u;
}

__device__ __forceinline__ void xcd_barrier(const XcdBarrier& b) {
    asm volatile("s_waitcnt vmcnt(0)" ::: "memory");
    __syncthreads();
    if (threadIdx.x == 0) {
        unsigned* bar = b.bar;
        __builtin_amdgcn_s_waitcnt(0);
        unsigned nloc = b.st[0], nx = b.st[1];
        if (nloc == 0u) { xcd_barrier_complete(bar, b.x, nloc, nx); b.st[0] = nloc; b.st[1] = nx; }
        const unsigned old = xb_add(&bar[XB_XSUB(b.x)], 1u);
        const unsigned gen = old / nloc;
        if (old + 1u == (gen + 1u) * nloc) {
            __builtin_amdgcn_fence(__ATOMIC_RELEASE, "agent");
            asm volatile("s_waitcnt vmcnt(0)" ::: "memory");
            const unsigned og = xb_add(&bar[XB_TOP], 1u);
            const unsigned tg = og / nx;
            if (og + 1u == (tg + 1u) * nx) xb_add(&bar[XB_TOPGEN], 1u);
            else XB_SPIN(xb_ld(&bar[XB_TOPGEN]) == tg, bar);
            __builtin_amdgcn_fence(__ATOMIC_ACQUIRE, "agent");
            xb_add(&bar[XB_XGEN(b.x)], 1u);
            asm volatile("s_waitcnt vmcnt(0)" ::: "memory");
        } else {
            XB_SPIN(xb_ld(&bar[XB_XGEN(b.x)]) == gen, bar);
            __builtin_amdgcn_fence(__ATOMIC_ACQUIRE, "agent");
            asm volatile("s_waitcnt vmcnt(0)" ::: "memory");
        }
    }
    __syncthreads();
}

#ifndef MK_PROBE
#define MK_PROBE 0
#endif
#if MK_PROBE >= 30
#define RPROBE(i) do { const unsigned long long _n = __builtin_amdgcn_s_memrealtime(); if ((i) == MK_PROBE - 30 + 1) tacc_ += _n - tq_; tq_ = _n; } while (0)
#endif
#if MK_PROBE >= 40 && MK_PROBE < 50
#define IPROBE(i) do { const unsigned long long _n = __builtin_amdgcn_s_memrealtime(); if ((i) == MK_PROBE - 40 + 1) tacc_ += _n - tq_; tq_ = _n; } while (0)
#endif
#if MK_PROBE >= 100 && MK_PROBE < 110
#define APROBE(i) do { const unsigned long long _n = __builtin_amdgcn_s_memrealtime(); if ((i) == MK_PROBE - 100 + 1) tacc_ += _n - tq_; tq_ = _n; } while (0)
#endif
namespace mk {
using pg8::bf16_t; using pg8::bf16x8; using pg8::f32x4; using pg8::u32x4;

#define GAS __attribute__((address_space(1)))
typedef float f32x2 __attribute__((ext_vector_type(2)));
typedef float f32x16 __attribute__((ext_vector_type(16)));
typedef unsigned u32x2 __attribute__((ext_vector_type(2)));
typedef short s16x4 __attribute__((ext_vector_type(4)));
typedef __bf16 bf16x2_t __attribute__((ext_vector_type(2)));
typedef unsigned char uchar;

constexpr int S = 8192, D = 2048, NH = 8, HD = 128, CKV = 256, IH = 16, IDM = 64, TOPK = 256;
constexpr int GW = 1024, CHUNK = 128, NGRP = 8;
constexpr int NSRC = 8528, NPROJ = 8704;
constexpr int NE = 64, FF = 512;
constexpr float EPS = 1e-6f, LOG2E = 1.4426950408889634f;
constexpr int NTHR = 512, NWAVE = 8;
constexpr int MAXROWS = 32768;

constexpr size_t MiB = 1u << 20;
constexpr size_t WS_CTL = 0, CTL_BYTES = 1 * MiB;
constexpr size_t WS_WINT = 1 * MiB, WS_WAT = 35 * MiB, WS_WBT = 39 * MiB, WS_WOT = 43 * MiB, WS_WUK = 51 * MiB, WS_WUV = 51 * MiB + 512 * 1024, WS_WSM = 52 * MiB;
constexpr size_t WS_LIST = 53 * MiB;
constexpr size_t WS_CWT = 55 * MiB;
constexpr size_t WS_WRT = 56 * MiB;
constexpr size_t WS_HID = 57 * MiB;
constexpr size_t WS_Y = 85 * MiB;
constexpr size_t WS_CKV8 = 87 * MiB;
constexpr size_t WS_N1 = 437 * MiB;
constexpr size_t WS_Q = 469 * MiB, WS_CKVF = 485 * MiB, WS_CKV = 493 * MiB, WS_QI = 497 * MiB, WS_KIDX = 513 * MiB, WS_WIDX = 514 * MiB;
constexpr size_t WS_UV = 515 * MiB;
constexpr size_t WS_LNS = 547 * MiB, WS_GATE = 548 * MiB;
constexpr size_t WS_QABS = 612 * MiB, WS_OB = 644 * MiB;
constexpr size_t WS_MB = 676 * MiB, WS_IDX = 692 * MiB, WS_AB = 700 * MiB, WS_ROUTE = 716 * MiB;
constexpr size_t WS_SC = 717 * MiB;
constexpr size_t WS_END = 973 * MiB;
constexpr size_t RT_EID = 0, RT_POS = 65536, RT_WGT = 131072, RT_ROW = 196608, RT_CW = 262144;
constexpr int CW_BAR = 4096, CW_CNT = 65536, CW_ABRDY = 3072, CW_OBRDY = 3200, CW_SPX = 3328, CW_SPT = 3520, CW_SPF = 3584, CW_SQX = 3600, CW_SQT = 3744, CW_SQF = 3776, CW_SRX = 3800, CW_SRT = 3936, CW_SRF = 3968, CW_STX = 2560, CW_STT = 2700, CW_STF = 2720;

constexpr int LDS_BYTES = 155648;
constexpr int LDS_X = 131072;
constexpr int LDS_MISC = LDS_BYTES - 256;

#define LDS_BARRIER() do { asm volatile("s_waitcnt lgkmcnt(0)" ::: "memory"); __builtin_amdgcn_s_barrier(); asm volatile("" ::: "memory"); } while (0)
__device__ __forceinline__ unsigned pk2(float lo, float hi) { f32x2 v = {lo, hi}; return __builtin_bit_cast(unsigned, __builtin_convertvector(v, bf16x2_t)); }
__device__ __forceinline__ void st16_wt(void* p, u32x4 v) { asm volatile("global_store_dwordx4 %0, %1, off sc1\n\ts_nop 1" :: "v"(p), "v"(v) : "memory"); }
__device__ __forceinline__ float bf_lo(unsigned u) { return __uint_as_float(u << 16); }
__device__ __forceinline__ float bf_hi(unsigned u) { return __uint_as_float(u & 0xffff0000u); }
__device__ __forceinline__ float bf1(bf16_t b) { return __uint_as_float(((unsigned)b) << 16); }
__device__ __forceinline__ float wave_sum(float v) {
#pragma unroll
    for (int o = 1; o < 64; o <<= 1) v += __shfl_xor(v, o);
    return v;
}
__device__ __forceinline__ float ex2(float x) { return __builtin_amdgcn_exp2f(x); }
__device__ __forceinline__ float sigm(float x) { return __builtin_amdgcn_rcpf(1.f + ex2(-x * LOG2E)); }
__device__ __forceinline__ float gelu_t(float x) { const float u = 0.7978845608028654f * (x + 0.044715f * x * x * x); return x * __builtin_amdgcn_rcpf(1.f + ex2(-2.f * LOG2E * u)); }
__device__ __forceinline__ float silu_(float x) { return x * sigm(x); }

struct Ctx {
    LAS uchar* lds; int tid, lane, wave, G, bid;
    const float* in[22]; float* out; uchar* ws;
};
#define WSP(T, off) ((T*)(C.ws + (off)))
enum { I_X = 0, I_N1G, I_WIN, I_KVG, I_WUK, I_WUV, I_GWS, I_GBS, I_LNG, I_LNB, I_WBA, I_WBG, I_WOUT, I_N2G, I_WGRP, I_BGRP, I_WRT, I_BRT, I_WEG, I_WEU, I_WED, I_NFG };

__device__ __forceinline__ int proj_src_col(int n) {
    if (n < 2304) return n;
    if (n < 8448) return n + 80;
    if (n < 8528) return n - 8448 + 2304;
    return -1;
}
struct TcItem { const float* W; size_t ldw; int srccol; bf16_t* WT; size_t K; int dstrow0, k0; };
__device__ __forceinline__ TcItem tc_params(const Ctx& C, int it, int lane) {
    constexpr int I_IN = (NPROJ / 32) * (D / 64), I_BA = (D / 32) * (1024 / 64);
    TcItem t; int r = it;
    if (r < I_IN) { const int nb = r % (NPROJ / 32), kb = r / (NPROJ / 32); t = TcItem{C.in[I_WIN], (size_t)NSRC, proj_src_col(32 * nb + (lane & 31)), WSP(bf16_t, WS_WINT), (size_t)D, 32 * nb, 64 * kb}; return t; } r -= I_IN;
    if (r < I_BA) { const int nb = r % 64, kb = r / 64; t = TcItem{C.in[I_WBA], (size_t)D, 32 * nb + (lane & 31), WSP(bf16_t, WS_WAT), (size_t)1024, 32 * nb, 64 * kb}; return t; } r -= I_BA;
    if (r < I_BA) { const int nb = r % 64, kb = r / 64; t = TcItem{C.in[I_WBG], (size_t)D, 32 * nb + (lane & 31), WSP(bf16_t, WS_WBT), (size_t)1024, 32 * nb, 64 * kb}; return t; } r -= I_BA;
    { const int nb = r % 64, kb = r / 64; t = TcItem{C.in[I_WOUT], (size_t)D, 32 * nb + (lane & 31), WSP(bf16_t, WS_WOT), (size_t)D, 32 * nb, 64 * kb}; return t; }
}
#define TC_LOAD(T, tv) do { _Pragma("unroll") for (int i = 0; i < 32; ++i) { const int kk = 2 * i + (lane >> 5); tv[i] = (T).srccol >= 0 ? (T).W[(size_t)((T).k0 + kk) * (T).ldw + (T).srccol] : 0.f; } } while (0)
__device__ __forceinline__ void tc_finish(const TcItem& T, const float (&tv)[32], LAS float* scr, int lane) {
#pragma unroll
    for (int i = 0; i < 32; ++i) { const int kk = 2 * i + (lane >> 5); scr[kk * 33 + (lane & 31)] = tv[i]; }
    asm volatile("s_waitcnt lgkmcnt(0)" ::: "memory");
    const int c = lane & 7;
#pragma unroll
    for (int j = 0; j < 4; ++j) { const int n = (lane >> 3) + 8 * j; const LAS float* s = scr + (8 * c) * 33 + n;
        u32x4 o; o.x = pk2(s[0 * 33], s[1 * 33]); o.y = pk2(s[2 * 33], s[3 * 33]); o.z = pk2(s[4 * 33], s[5 * 33]); o.w = pk2(s[6 * 33], s[7 * 33]);
        *(u32x4*)(T.WT + (size_t)(T.dstrow0 + n) * T.K + T.k0 + 8 * c) = o; }
    asm volatile("s_waitcnt lgkmcnt(0)" ::: "memory");
}
__device__ __forceinline__ void tc_range(const Ctx& C, int lo, int hi, LAS float* scr) {
    const int gw = C.bid * NWAVE + C.wave, NGW = C.G * NWAVE, lane = C.lane;
    if (lo + gw < hi) {
        TcItem cur = tc_params(C, lo + gw, lane); float tv[32]; TC_LOAD(cur, tv);
#pragma unroll 1
        for (int it = lo + gw; it < hi; it += NGW) {
            const int itn = (it + NGW < hi) ? it + NGW : it;
            const TcItem nxt = tc_params(C, itn, lane); float tn[32]; TC_LOAD(nxt, tn);
            __builtin_amdgcn_sched_barrier(0);
            tc_finish(cur, tv, scr, lane);
#pragma unroll
            for (int i = 0; i < 32; ++i) tv[i] = tn[i];
            cur = nxt;
        }
    }
}
__device__ __forceinline__ void p0_late(const Ctx& C) {
    constexpr int I_IN = (NPROJ / 32) * (D / 64), NITEMS = I_IN + 2 * (D / 32) * (1024 / 64) + (D / 32) * (D / 64);
    tc_range(C, I_IN, NITEMS, (LAS float*)(C.lds + C.wave * 16384));
    __syncthreads();
}
__device__ __forceinline__ void p0_prologue(const Ctx& C, int part = 0) {
    LAS float* scr = (LAS float*)(C.lds + C.wave * 16384);
    const int gw = C.bid * NWAVE + C.wave, NGW = C.G * NWAVE, lane = C.lane;
    if (part != 2) tc_range(C, 0, (NPROJ / 32) * (D / 64), scr);
    const int gt = C.bid * NTHR + C.tid, NGT = C.G * NTHR;
    if (part != 1) {
    for (int i = gt; i < 262144 / 4; i += NGT) {
        const f32x4 a = ((const f32x4*)C.in[I_WUK])[i], b = ((const f32x4*)C.in[I_WUV])[i];
        u32x2 oa, ob; oa.x = pk2(a.x, a.y); oa.y = pk2(a.z, a.w); ob.x = pk2(b.x, b.y); ob.y = pk2(b.z, b.w);
        WSP(u32x2, WS_WUK)[i] = oa; WSP(u32x2, WS_WUV)[i] = ob;
    }
    for (int i = gt; i < 131072 / 4; i += NGT) {
        const f32x4 a = ((const f32x4*)C.in[I_GWS])[i]; const int e = 4 * i, s0 = e & 127, t = (e >> 7) & 127;
        u32x2 o; o.x = pk2(s0 <= t ? a.x : 0.f, s0 + 1 <= t ? a.y : 0.f); o.y = pk2(s0 + 2 <= t ? a.z : 0.f, s0 + 3 <= t ? a.w : 0.f);
        WSP(u32x2, WS_WSM)[i] = o;
    }
    for (int i = gt; i < 512 * 5 * 64; i += NGT) { const int ln = i & 63, cb = (i >> 6) % 5, ks = i / 320, k = 4 * ks + (ln >> 4), c = ln & 15;
        const float g2 = C.in[I_N2G][k]; float v;
        if (cb == 0) v = (c < 8) ? C.in[I_WGRP][(size_t)k * 8 + c] * g2 : 0.f; else v = C.in[I_WRT][(size_t)k * 64 + (cb - 1) * 16 + c] * g2;
        WSP(float, WS_WRT)[i] = v; }
    }
    if (part == 2) return;
    for (int m = gw; m < S; m += 2 * NGW) {
        const int m2 = (m + NGW < S) ? m + NGW : m;
        const f32x4* xr = (const f32x4*)(C.in[I_X] + (size_t)m * D) + lane; const f32x4* xr2 = (const f32x4*)(C.in[I_X] + (size_t)m2 * D) + lane; const f32x4* gr = (const f32x4*)C.in[I_N1G] + lane;
        f32x4 v[8], v2[8]; float ss = 0.f, ss2 = 0.f;
#pragma unroll
        for (int j = 0; j < 8; ++j) { v[j] = xr[64 * j]; v2[j] = xr2[64 * j]; }
        f32x4 gq[8];
#pragma unroll
        for (int j = 0; j < 8; ++j) gq[j] = gr[64 * j];
#pragma unroll
        for (int j = 0; j < 8; ++j) { ss += (v[j].x * v[j].x + v[j].y * v[j].y) + (v[j].z * v[j].z + v[j].w * v[j].w); ss2 += (v2[j].x * v2[j].x + v2[j].y * v2[j].y) + (v2[j].z * v2[j].z + v2[j].w * v2[j].w); }
        const float rstd = 1.0f / sqrtf(wave_sum(ss) * (1.f / D) + EPS), rstd2 = 1.0f / sqrtf(wave_sum(ss2) * (1.f / D) + EPS);
        u32x2* o = WSP(u32x2, WS_N1) + (size_t)m * (D / 4) + lane; u32x2* o2 = WSP(u32x2, WS_N1) + (size_t)m2 * (D / 4) + lane;
#pragma unroll
        for (int j = 0; j < 8; ++j) { const f32x4 g = gq[j]; u32x2 w; w.x = pk2(v[j].x * rstd * g.x, v[j].y * rstd * g.y); w.y = pk2(v[j].z * rstd * g.z, v[j].w * rstd * g.w); o[64 * j] = w;
            u32x2 w2; w2.x = pk2(v2[j].x * rstd2 * g.x, v2[j].y * rstd2 * g.y); w2.y = pk2(v2[j].z * rstd2 * g.z, v2[j].w * rstd2 * g.w); o2[64 * j] = w2; }
    }
}

struct EpiProj {
    static constexpr bool PERM = true, AFTER_DRAIN = false, MIDK = false;
    bf16_t *Q, *QI, *UV, *GATE, *KIDX; float *CKVF, *LNS, *WIDX;
    template <int ACT> __device__ __forceinline__ void st_bf16(const f32x4 (&acc)[2][2][4][2], bf16_t* base, int ld, int row0, int col0, float sc) const {
#pragma unroll
        for (int ai = 0; ai < 2; ++ai)
#pragma unroll
            for (int m = 0; m < 4; ++m) { bf16_t* rowp = base + (size_t)(row0 + ai * 128 + m * 16) * ld + col0;
#pragma unroll
                for (int bj = 0; bj < 2; ++bj) { f32x4 v0 = acc[ai][bj][m][0], v1 = acc[ai][bj][m][1];
                    if (ACT == 0) { v0 *= sc; v1 *= sc; }
                    if (ACT == 1) {
#pragma unroll
                        for (int j = 0; j < 4; ++j) { v0[j] = gelu_t(v0[j]); v1[j] = gelu_t(v1[j]); } }
                    if (ACT == 2) {
#pragma unroll
                        for (int j = 0; j < 4; ++j) { v0[j] = sigm(v0[j]); v1[j] = sigm(v1[j]); } }
                    u32x4 w; w.x = pk2(v0[0], v0[1]); w.y = pk2(v0[2], v0[3]); w.z = pk2(v1[0], v1[1]); w.w = pk2(v1[2], v1[3]);
                    *(u32x4*)(rowp + bj * 128) = w; } }
    }
    __device__ __forceinline__ void operator()(const f32x4 (&acc)[2][2][4][2], const pg8::Unit& u, int wr, int wc, int fr, int fq) const {
        const int pn = u.pn, row0 = u.pm * 256 + wr * 64 + fr, cl = wc * 32 + 8 * fq;
        if (pn < 4) st_bf16<0>(acc, Q, 1024, row0, pn * 256 + cl, 1.f);
        else if (pn == 4) {
#pragma unroll
            for (int ai = 0; ai < 2; ++ai)
#pragma unroll
                for (int m = 0; m < 4; ++m) { float* rowp = CKVF + (size_t)(row0 + ai * 128 + m * 16) * 256 + cl;
#pragma unroll
                    for (int bj = 0; bj < 2; ++bj) { *(f32x4*)(rowp + bj * 128) = acc[ai][bj][m][0]; *(f32x4*)(rowp + bj * 128 + 4) = acc[ai][bj][m][1]; } }
        }
        else if (pn < 9) st_bf16<0>(acc, QI, 1024, row0, (pn - 5) * 256 + cl, 0.125f);
        else if (pn < 13) st_bf16<1>(acc, UV, 2048, row0, (pn - 9) * 256 + cl, 1.f);
        else if (pn < 17) {
#pragma unroll
            for (int ai = 0; ai < 2; ++ai)
#pragma unroll
                for (int m = 0; m < 4; ++m) { const int row = row0 + ai * 128 + m * 16; bf16_t* rowp = UV + (size_t)row * 2048 + (pn - 9) * 256 + cl; float s = 0.f, ss = 0.f;
#pragma unroll
                    for (int bj = 0; bj < 2; ++bj) { f32x4 v0 = acc[ai][bj][m][0], v1 = acc[ai][bj][m][1];
#pragma unroll
                        for (int j = 0; j < 4; ++j) { v0[j] = gelu_t(v0[j]); v1[j] = gelu_t(v1[j]); s += v0[j] + v1[j]; ss += v0[j] * v0[j] + v1[j] * v1[j]; }
                        u32x4 w; w.x = pk2(v0[0], v0[1]); w.y = pk2(v0[2], v0[3]); w.z = pk2(v1[0], v1[1]); w.w = pk2(v1[2], v1[3]);
                        *(u32x4*)(rowp + bj * 128) = w; }
                    s += __shfl_xor(s, 16); s += __shfl_xor(s, 32); ss += __shfl_xor(ss, 16); ss += __shfl_xor(ss, 32);
                    if (fq == 0) *(f32x2*)(LNS + (size_t)row * 32 + ((pn - 13) * 4 + wc) * 2) = (f32x2){s, ss}; }
        }
        else if (pn < 33) st_bf16<2>(acc, GATE, 4096, row0, (pn - 17) * 256 + cl, 1.f);
        else {
#pragma unroll
            for (int ai = 0; ai < 2; ++ai)
#pragma unroll
                for (int m = 0; m < 4; ++m) { const int row = row0 + ai * 128 + m * 16; const f32x4 v0 = acc[ai][0][m][0], v1 = acc[ai][0][m][1];
                    if (wc < 2) { u32x4 w; w.x = pk2(v0[0], v0[1]); w.y = pk2(v0[2], v0[3]); w.z = pk2(v1[0], v1[1]); w.w = pk2(v1[2], v1[3]); *(u32x4*)(KIDX + (size_t)row * 64 + cl) = w; }
                    else if (wc == 2 && fq < 2) { float* p = WIDX + (size_t)row * 16 + 8 * fq; *(f32x4*)p = v0 * 0.25f; *(f32x4*)(p + 4) = v1 * 0.25f; } }
        }
    }
};

struct ProjOrderA : pg8::StaticOrder {
    __device__ __forceinline__ bool next(int i, pg8::Unit& u) const { if (!pg8::StaticOrder::next(i, u)) return false; if (u.pn == 31) u.pn = 33; return true; }
};
struct ProjOrderB { int j;
    __device__ __forceinline__ bool next(int i, pg8::Unit& u) const { if (i != 0) return false; u.pm = j & 31; u.pn = 31 + (j >> 5); return true; }
    __device__ __forceinline__ void a_ready(const pg8::Unit&) const {}
    __device__ __forceinline__ void done(const pg8::Unit&) const {}
};
struct ProjOrderC { int G, c;
    __device__ __forceinline__ bool next(int i, pg8::Unit& u) const { const int j = i * G + c; if (j >= 64) return false; u.pm = j & 31; u.pn = 31 + (j >> 5); return true; }
    __device__ __forceinline__ void a_ready(const pg8::Unit&) const {}
    __device__ __forceinline__ void done(const pg8::Unit&) const {}
};
__device__ __forceinline__ unsigned imgb_off(unsigned row, unsigned ch) { return 256u * row + 16u * (ch ^ (((row & 3u) << 2) | ((row >> 2) & 3u))); }
__device__ __forceinline__ unsigned imgb_row16(unsigned lane, unsigned rb, unsigned s) { return imgb_off((lane & 15u) + 16u * rb, 4u * s + (lane >> 4)); }
__device__ __forceinline__ unsigned imgb_tr16(unsigned lane, unsigned c, unsigned ks, unsigned t) { const unsigned g = lane >> 4, q = (lane & 15u) >> 2, p = lane & 3u; return imgb_off(32u * ks + 8u * g + 4u * t + q, 2u * c + (p >> 1)) + 8u * (p & 1u); }
__device__ __forceinline__ bf16x8 trrd8(LAS uchar* p0, LAS uchar* p1) {
    const s16x4 b0 = __builtin_amdgcn_ds_read_tr16_b64_v4i16((LAS s16x4*)p0), b1 = __builtin_amdgcn_ds_read_tr16_b64_v4i16((LAS s16x4*)p1);
    return __builtin_shufflevector(b0, b1, 0, 1, 2, 3, 4, 5, 6, 7);
}
#define MFMA16(a, b, c) __builtin_amdgcn_mfma_f32_16x16x32_bf16((a), (b), (c), 0, 0, 0)
__device__ __forceinline__ void img128_ld(u32x4 (&v)[4], const bf16_t* src, size_t ld, int tid) {
#pragma unroll
    for (int i = 0; i < 4; ++i) { const int q = tid + NTHR * i, row = q >> 4, ch = q & 15; v[i] = *(const u32x4*)(src + (size_t)row * ld + ch * 8); }
}
__device__ __forceinline__ void img128_st(LAS uchar* img, const u32x4 (&v)[4], int tid) {
#pragma unroll
    for (int i = 0; i < 4; ++i) { const int q = tid + NTHR * i, row = q >> 4, ch = q & 15; *(LAS u32x4*)(img + imgb_off(row, ch)) = v[i]; }
}
__device__ __forceinline__ void load_img128(LAS uchar* img, const bf16_t* src, size_t ld, int tid) { u32x4 v[4]; img128_ld(v, src, ld, tid); __builtin_amdgcn_sched_barrier(0); img128_st(img, v, tid); }
__device__ __forceinline__ void trgemm(LAS uchar* imgA, LAS uchar* imgB, int lane, int w, f32x4 (&acc)[8]) {
    bf16x8 af[2], bfr[2][8];
#define TRG_LD(ks, buf) do { af[buf] = *(LAS bf16x8*)(imgA + imgb_row16(lane, w, (ks))); _Pragma("unroll") for (int c = 0; c < 8; ++c) bfr[buf][c] = trrd8(imgB + imgb_tr16(lane, c, (ks), 0), imgB + imgb_tr16(lane, c, (ks), 1)); } while (0)
    TRG_LD(0, 0);
#pragma unroll
    for (int ks = 0; ks < 4; ++ks) {
        if (ks < 3) TRG_LD(ks + 1, (ks + 1) & 1);
        __builtin_amdgcn_sched_barrier(0);
#pragma unroll
        for (int c = 0; c < 8; ++c) acc[c] = MFMA16(af[ks & 1], bfr[ks & 1][c], acc[c]);
        __builtin_amdgcn_sched_barrier(0);
    }
#undef TRG_LD
}
constexpr int STG_LD = 132;
__device__ __forceinline__ void stage_acc(LAS float* stg, const f32x4 (&acc)[8], int lane) {
    const int col = lane & 15, g = lane >> 4;
#pragma unroll
    for (int c = 0; c < 8; ++c)
#pragma unroll
        for (int r = 0; r < 4; ++r) stg[(4 * g + r) * STG_LD + 16 * c + col] = acc[c][r];
}
template <bool WT = false> __device__ __forceinline__ void stage_store_bf16(LAS float* stg, const f32x4 (&acc)[8], bf16_t* orow, size_t ld, int lane) {
    stage_acc(stg, acc, lane);
#pragma unroll
    for (int i = 0; i < 4; ++i) { const int q = lane + 64 * i, row = q >> 4, ch = q & 15; const LAS float* s = stg + row * STG_LD + 8 * ch;
        u32x4 o; o.x = pk2(s[0], s[1]); o.y = pk2(s[2], s[3]); o.z = pk2(s[4], s[5]); o.w = pk2(s[6], s[7]);
        if (WT) st16_wt(orow + (size_t)row * ld + 8 * ch, o); else *(u32x4*)(orow + (size_t)row * ld + 8 * ch) = o; }
}
#define ZERO8(a) do { _Pragma("unroll") for (int _c = 0; _c < 8; ++_c) a[_c] = (f32x4){0.f, 0.f, 0.f, 0.f}; } while (0)

__device__ __forceinline__ void p2_ckv_norm(const Ctx& C) {
    const int gw = C.bid * NWAVE + C.wave, NGW = C.G * NWAVE, lane = C.lane;
    const f32x4 g = ((const f32x4*)C.in[I_KVG])[lane];
    for (int m0 = gw; m0 < S; m0 += 4 * NGW) {
        f32x4 v[4];
#pragma unroll
        for (int q = 0; q < 4; ++q) { const int m = (m0 + q * NGW < S) ? m0 + q * NGW : m0; v[q] = ((const f32x4*)(WSP(float, WS_CKVF) + (size_t)m * CKV))[lane]; }
#pragma unroll
        for (int q = 0; q < 4; ++q) { const int m = m0 + q * NGW; if (m < S) {
            const float ss = wave_sum((v[q].x * v[q].x + v[q].y * v[q].y) + (v[q].z * v[q].z + v[q].w * v[q].w));
            const float rstd = 1.0f / sqrtf(ss * (1.f / CKV) + EPS);
            u32x2 o; o.x = pk2(v[q].x * rstd * g.x, v[q].y * rstd * g.y); o.y = pk2(v[q].z * rstd * g.z, v[q].w * rstd * g.w);
            (WSP(u32x2, WS_CKV) + (size_t)m * (CKV / 4))[lane] = o; } }
    }
}
__device__ __forceinline__ void p2_qabs(const Ctx& C) {
    LAS uchar* imgA = C.lds; LAS uchar* imgB = C.lds + 32768;
    LAS float* stg = (LAS float*)(C.lds) + C.wave * 16 * STG_LD;
    const int lane = C.lane, w = C.wave;
#pragma unroll 1
    for (int u = C.bid; u < 64 * NH * 2; u += C.G) {
        const int half = u & 1, h = (u >> 1) & 7, t0 = (u >> 4) * 128;
        __syncthreads();
        { u32x4 va[4], vb[4];
          img128_ld(va, WSP(bf16_t, WS_Q) + (size_t)t0 * 1024 + h * 128, 1024, C.tid);
          img128_ld(vb, WSP(bf16_t, WS_WUK) + (size_t)h * 128 * 256 + half * 128, 256, C.tid);
          __builtin_amdgcn_sched_barrier(0);
          img128_st(imgA, va, C.tid); img128_st(imgB, vb, C.tid); }
        __syncthreads();
        f32x4 acc[8]; ZERO8(acc);
        trgemm(imgA, imgB, lane, w, acc);
        __syncthreads();
        stage_store_bf16(stg, acc, WSP(bf16_t, WS_QABS) + (size_t)(t0 + 16 * w) * 2048 + h * 256 + half * 128, 2048, lane);
    }
    __syncthreads();
}
__device__ __forceinline__ void p2_gmlp(const Ctx& C) {
    LAS uchar* imgA = C.lds; LAS uchar* imgB = C.lds + 32768; LAS f32x2* stat = (LAS f32x2*)(C.lds + 65536);
    LAS float* stg = (LAS float*)(C.lds) + C.wave * 16 * STG_LD;
    const int lane = C.lane, w = C.wave, tid = C.tid;
    const bf16_t* UV = WSP(bf16_t, WS_UV);
    for (int u = C.bid; u < 64 * NGRP; u += C.G) {
        const int g = u & 7, t0 = (u >> 3) * 128;
        __syncthreads();
        if (tid < 128) { const float* p = WSP(float, WS_LNS) + (size_t)(t0 + tid) * 32; float s = 0.f, ss = 0.f;
#pragma unroll
            for (int j = 0; j < 16; ++j) { s += p[2 * j]; ss += p[2 * j + 1]; }
            const float mean = s * (1.f / GW), var = fmaxf(ss * (1.f / GW) - mean * mean, 0.f);
            stat[tid] = (f32x2){mean, 1.0f / sqrtf(var + EPS)}; }
        load_img128(imgA, WSP(bf16_t, WS_WSM) + (size_t)g * 128 * 128, 128, tid);
        __syncthreads();
        u32x4 vq[4];
#pragma unroll
        for (int i = 0; i < 4; ++i) { const int q = tid + NTHR * i, row = q >> 4, ch = q & 15; vq[i] = *(const u32x4*)(UV + (size_t)(t0 + row) * 2048 + 1024 + g * 128 + ch * 8); }
        __builtin_amdgcn_sched_barrier(0);
#pragma unroll
        for (int i = 0; i < 4; ++i) { const int q = tid + NTHR * i, row = q >> 4, ch = q & 15; const f32x2 st = stat[row];
            const u32x4 v = vq[i];
            const float* lg = C.in[I_LNG] + g * 128 + ch * 8; const float* lb = C.in[I_LNB] + g * 128 + ch * 8;
            const unsigned vv[4] = {v.x, v.y, v.z, v.w}; unsigned o[4];
#pragma unroll
            for (int j = 0; j < 4; ++j) { const float a = (bf_lo(vv[j]) - st.x) * st.y * lg[2 * j] + lb[2 * j], b = (bf_hi(vv[j]) - st.x) * st.y * lg[2 * j + 1] + lb[2 * j + 1]; o[j] = pk2(a, b); }
            *(LAS u32x4*)(imgB + imgb_off(row, ch)) = (u32x4){o[0], o[1], o[2], o[3]}; }
        __syncthreads();
        f32x4 acc[8]; ZERO8(acc);
        trgemm(imgA, imgB, lane, w, acc);
        __syncthreads();
        stage_acc(stg, acc, lane);
        u32x4 uq[4]; float bq[4];
#pragma unroll
        for (int i = 0; i < 4; ++i) { const int q = lane + 64 * i, row = q >> 4, ch = q & 15, tl = 16 * w + row; bq[i] = C.in[I_GBS][g * 128 + tl]; uq[i] = *(const u32x4*)(UV + (size_t)(t0 + tl) * 2048 + g * 128 + ch * 8); }
        __builtin_amdgcn_sched_barrier(0);
#pragma unroll
        for (int i = 0; i < 4; ++i) { const int q = lane + 64 * i, row = q >> 4, ch = q & 15; const LAS float* s = stg + row * STG_LD + 8 * ch;
            const int tl = 16 * w + row; const float bias = bq[i];
            const u32x4 uu = uq[i];
            u32x4 o; o.x = pk2(bf_lo(uu.x) * (s[0] + bias), bf_hi(uu.x) * (s[1] + bias)); o.y = pk2(bf_lo(uu.y) * (s[2] + bias), bf_hi(uu.y) * (s[3] + bias));
            o.z = pk2(bf_lo(uu.z) * (s[4] + bias), bf_hi(uu.z) * (s[5] + bias)); o.w = pk2(bf_lo(uu.w) * (s[6] + bias), bf_hi(uu.w) * (s[7] + bias));
            *(u32x4*)(WSP(bf16_t, WS_MB) + (size_t)(t0 + tl) * 1024 + g * 128 + ch * 8) = o; }
    }
    __syncthreads();
}

#define MFMA32(a, b, c) __builtin_amdgcn_mfma_f32_32x32x16_bf16((a), (b), (c), 0, 0, 0)
__device__ __forceinline__ float relu_i(float x) { const int b = __float_as_int(x); return __int_as_float(b > 0 ? b : 0); }
__device__ __forceinline__ unsigned f2key(float x) { const unsigned u = __float_as_uint(x); return (u & 0x80000000u) ? ~u : (u | 0x80000000u); }
__device__ __forceinline__ int sbucket(float x) { float f = __builtin_fmaf(x, 64.f, 512.f); f = fminf(fmaxf(f, 0.f), 1023.f); return (int)f; }
__device__ __forceinline__ unsigned scode(float x) { return (unsigned)__builtin_amdgcn_fmed3f(__builtin_fmaf(x, 4096.f, 32768.f), 0.f, 65535.f); }
__device__ __forceinline__ unsigned sc_code_at(const unsigned* row, int i) { const unsigned w = row[((i >> 7) << 6) + (((i >> 6) & 1) << 5) + (i & 31)]; return ((i >> 5) & 1) ? (w >> 16) : (w & 0xffffu); }
__device__ __forceinline__ void lds_add(LAS unsigned* p, unsigned v) { (void)__hip_atomic_fetch_add(p, v, __ATOMIC_RELAXED, __HIP_MEMORY_SCOPE_WORKGROUP); }
__device__ __forceinline__ unsigned suffix_incl(unsigned v, int lane) {
#pragma unroll
    for (int o = 1; o < 64; o <<= 1) { const unsigned x = __shfl_down(v, o); if (lane + o < 64) v += x; }
    return v;
}
__device__ __forceinline__ void select_row_radix(const Ctx& C, int t, LAS unsigned* hist) {
    const int lane = C.lane, n = t + 1; int* out = WSP(int, WS_IDX) + (size_t)t * TOPK;
    const unsigned* row = WSP(unsigned, WS_SC) + (size_t)t * (S / 2);
    unsigned prefix = 0u, krem = (unsigned)TOPK;
#pragma unroll 1
    for (int pass = 0; pass < 2; ++pass) {
        const int shift = 8 - 8 * pass;
#pragma unroll
        for (int i = 0; i < 4; ++i) hist[lane + 64 * i] = 0u;
        for (int i = lane; i < n; i += 64) { const unsigned key = sc_code_at(row, i); if (pass == 0 || (key >> 8) == (prefix >> 8)) lds_add(&hist[(key >> shift) & 255u], 1u); }
        unsigned h4[4]; unsigned tt = 0;
#pragma unroll
        for (int j = 0; j < 4; ++j) { h4[j] = hist[4 * lane + j]; tt += h4[j]; }
        const unsigned in2 = suffix_incl(tt, lane), ab2 = in2 - tt;
        const bool m2 = ab2 < krem && in2 >= krem;
        int d = 0; unsigned nk = 0;
        if (m2) { unsigned cum = ab2;
#pragma unroll
            for (int j = 3; j >= 0; --j) { if (nk == 0u) { if (cum + h4[j] >= krem) { d = 4 * lane + j; nk = krem - cum; } else cum += h4[j]; } } }
        const unsigned long long mk = __ballot(m2); const int src = __ffsll((long long)mk) - 1; d = __shfl(d, src); krem = __shfl(nk, src);
        prefix |= (unsigned)d << shift;
    }
    const unsigned long long lt = (1ull << lane) - 1ull;
    unsigned cnt = 0, eqc = 0;
    for (int base = 0; base < n; base += 64) { const int i = base + lane; const bool valid = i < n; const unsigned key = valid ? sc_code_at(row, i) : 0u;
        const bool gt = valid && key > prefix, eq = valid && key == prefix;
        const unsigned long long em = __ballot(eq); const unsigned rank = eqc + (unsigned)__popcll(em & lt);
        const bool take = gt || (eq && rank < krem);
        const unsigned long long tm = __ballot(take); const unsigned pos = cnt + (unsigned)__popcll(tm & lt);
        if (take && pos < (unsigned)TOPK) out[pos] = i;
        cnt += (unsigned)__popcll(tm); eqc += (unsigned)__popcll(em); }
}
constexpr int CAND_CAP = 256;
__device__ __forceinline__ unsigned wave_incl_scan(unsigned v) {
    v += (unsigned)__builtin_amdgcn_update_dpp(0, (int)v, 0x111, 0xf, 0xf, true);
    v += (unsigned)__builtin_amdgcn_update_dpp(0, (int)v, 0x112, 0xf, 0xf, true);
    v += (unsigned)__builtin_amdgcn_update_dpp(0, (int)v, 0x114, 0xf, 0xf, true);
    v += (unsigned)__builtin_amdgcn_update_dpp(0, (int)v, 0x118, 0xf, 0xf, true);
    v += (unsigned)__builtin_amdgcn_update_dpp(0, (int)v, 0x142, 0xa, 0xf, false);
    v += (unsigned)__builtin_amdgcn_update_dpp(0, (int)v, 0x143, 0xc, 0xf, false);
    return v;
}
__device__ __forceinline__ void select_row(const Ctx& C, int t, const LAS unsigned* h, LAS unsigned* cand) {
    const int lane = C.lane, n = t + 1; int* out = WSP(int, WS_IDX) + (size_t)t * TOPK;
    if (n <= TOPK) { for (int j = lane; j < TOPK; j += 64) out[j] = j < n ? j : -1; return; }
    const unsigned* row = WSP(unsigned, WS_SC) + (size_t)t * (S / 2);
    unsigned wd[8]; unsigned tot = 0;
#pragma unroll
    for (int j = 0; j < 8; ++j) { wd[j] = h[8 * lane + j]; tot += (wd[j] & 0xffffu) + (wd[j] >> 16); }
    const unsigned incl = suffix_incl(tot, lane), above = incl - tot;
    const bool mine = above < (unsigned)TOPK && incl >= (unsigned)TOPK;
    int bstar = 0; unsigned krem = 0;
    if (mine) { unsigned cum = above;
#pragma unroll
        for (int b = 15; b >= 0; --b) { if (krem == 0u) { const unsigned c = (wd[b >> 1] >> (16 * (b & 1))) & 0xffffu; if (cum + c >= (unsigned)TOPK) { bstar = 16 * lane + b; krem = (unsigned)TOPK - cum; } else cum += c; } } }
    { const unsigned long long mk = __ballot(mine); const int src = __ffsll((long long)mk) - 1; bstar = __shfl(bstar, src); krem = __shfl(krem, src); }
    const unsigned ngt = (unsigned)TOPK - krem;
    const unsigned clo = 64u * (unsigned)bstar, chi = clo + 64u;
    const unsigned long long lt = (1ull << lane) - 1ull;
    unsigned cnt = 0, cc = 0;
    const int nw = ((n + 127) >> 7) << 6;
    u32x4 rr[8];
#pragma unroll
    for (int q = 0; q < 8; ++q) { int ii = 256 * q + 4 * lane; ii = ii < S / 2 - 4 ? ii : S / 2 - 4; rr[q] = *(const u32x4*)(row + ii); }
    for (int base = 0; base < nw; base += 2048) {
#pragma unroll
        for (int q = 0; q < 8; ++q) {
            const int w0 = base + 256 * q + 4 * lane; const u32x4 cur = rr[q];
            { int ii = w0 + 2048; ii = ii < S / 2 - 4 ? ii : S / 2 - 4; rr[q] = *(const u32x4*)(row + ii); }
            const int k0 = ((w0 >> 6) << 7) + (((w0 >> 5) & 1) << 6) + (w0 & 31);
            unsigned gtm = 0u, eqm = 0u;
#pragma unroll
            for (int j = 0; j < 4; ++j)
#pragma unroll
                for (int hf = 0; hf < 2; ++hf) { const int key = k0 + j + 32 * hf; const unsigned code = hf ? (cur[j] >> 16) : (cur[j] & 0xffffu);
                    const bool valid = key < n;
                    gtm |= (valid && code >= chi) ? (1u << (2 * j + hf)) : 0u; eqm |= (valid && code >= clo && code < chi) ? (1u << (2 * j + hf)) : 0u; }
            const unsigned ng = (unsigned)__popc(gtm);
            const unsigned incl = wave_incl_scan(ng);
            unsigned pos = cnt + incl - ng;
            cnt += (unsigned)__builtin_amdgcn_readlane((int)incl, 63);
            if (gtm) {
#pragma unroll
                for (int e = 0; e < 8; ++e) { if ((gtm >> e) & 1u) { if (pos < (unsigned)TOPK) out[pos] = k0 + (e >> 1) + 32 * (e & 1); ++pos; } } }
            if (__ballot(eqm != 0u)) {
#pragma unroll
                for (int e = 0; e < 8; ++e) { const bool eq = (eqm >> e) & 1u; const unsigned long long me = __ballot(eq);
                    if (me) { if (eq) { const unsigned p = cc + (unsigned)__popcll(me & lt); if (p < (unsigned)CAND_CAP) { const unsigned wv = cur[e >> 1]; cand[2 * p] = (e & 1) ? (wv >> 16) : (wv & 0xffffu); cand[2 * p + 1] = (unsigned)(k0 + (e >> 1) + 32 * (e & 1)); } } cc += (unsigned)__popcll(me); } } }
        }
    }
    asm volatile("s_waitcnt vmcnt(0)" ::: "memory");
    if (cc <= (unsigned)CAND_CAP) {
        for (unsigned ci = lane; ci < cc; ci += 64) { const unsigned key = cand[2 * ci], idx = cand[2 * ci + 1]; unsigned rank = 0;
            for (unsigned j = 0; j < cc; ++j) { const unsigned kj = cand[2 * j], ij = cand[2 * j + 1]; rank += (kj > key || (kj == key && ij < idx)) ? 1u : 0u; }
            if (rank < krem) out[ngt + rank] = (int)idx; }
    } else select_row_radix(C, t, cand);
}
#ifndef IPROBE
#define IPROBE(i) ((void)0)
#endif
constexpr int KT_LD = 144;
__device__ __forceinline__ void idx_set(const Ctx& C, int tb16, unsigned long long& tacc_) {
    unsigned long long tq_ = 0ull; (void)tq_; (void)tacc_;
    LAS uchar* kb = C.lds;
    LAS unsigned* hist = (LAS unsigned*)(C.lds + 36864);
    int tid = C.tid; asm volatile("" : "+v"(tid));
    const int lane = tid & 63, w = __builtin_amdgcn_readfirstlane(tid >> 6), r = lane & 31, hh = lane >> 5;
    const int tau = (r >> 2) & 1, eta = (r & 3) + 4 * (r >> 3);
    const bf16_t* QI = WSP(bf16_t, WS_QI); const bf16_t* KI = WSP(bf16_t, WS_KIDX); const float* WI = WSP(float, WS_WIDX);
    unsigned* scw = WSP(unsigned, WS_SC);
    LAS unsigned* cand = (LAS unsigned*)(C.lds + 36864 + 32768) + w * (2 * CAND_CAP + 8);
    __syncthreads();
    IPROBE(0);
    { LAS u32x4* hz = (LAS u32x4*)hist + tid;
#pragma unroll
      for (int j = 0; j < 4; ++j) hz[NTHR * j] = (u32x4){0u, 0u, 0u, 0u}; }
    const int tb1 = tb16 + 2 * w, tmax1 = tb16 + 15;
    bf16x8 a1[4]; f32x4 w1[4];
#pragma unroll
    for (int ks = 0; ks < 4; ++ks) a1[ks] = *(const bf16x8*)(QI + (size_t)(tb1 + tau) * 1024 + eta * 64 + 16 * ks + 8 * hh);
#pragma unroll
    for (int q = 0; q < 4; ++q) w1[q] = *(const f32x4*)(WI + (size_t)(tb1 + hh) * 16 + 4 * q);
    const int ntile = (tmax1 >> 7) + 1;
#pragma unroll
    for (int ks = 0; ks < 4; ++ks) asm volatile("" :: "v"(a1[ks]), "v"(w1[ks]));
    const int kr0 = tid >> 3, kc = tid & 7;
    u32x4 pre0 = *(const u32x4*)(KI + (size_t)kr0 * 64 + kc * 8), pre1 = *(const u32x4*)(KI + (size_t)(kr0 + 64) * 64 + kc * 8);
    unsigned vc[2] = {0u, 0u};
    __builtin_amdgcn_sched_barrier(0);
#pragma unroll
    for (int p = 0; p < 2; ++p) scw[(size_t)(tb1 + hh) * (S / 2) + 32 * p + r] = 0u;
    __builtin_amdgcn_sched_barrier(0);
#pragma unroll 1
    for (int kt = 0; kt < ntile; ++kt) {
        LAS uchar* buf = kb + (kt & 1) * 18432;
        *(LAS u32x4*)(buf + kr0 * KT_LD + kc * 16) = pre0; *(LAS u32x4*)(buf + (kr0 + 64) * KT_LD + kc * 16) = pre1;
        LDS_BARRIER();
        { const int kn = (kt + 1 < ntile) ? kt + 1 : kt; const bf16_t* kp = KI + (size_t)(128 * kn) * 64; pre0 = *(const u32x4*)(kp + (size_t)kr0 * 64 + kc * 8); pre1 = *(const u32x4*)(kp + (size_t)(kr0 + 64) * 64 + kc * 8); }
#define IDX_LDB(B, sub) do { _Pragma("unroll") for (int ks = 0; ks < 4; ++ks) B[ks] = *(const LAS bf16x8*)(buf + (32 * (sub) + r) * KT_LD + (2 * ks + hh) * 16); } while (0)
#define IDX_MMA(ACC, B) do { _Pragma("unroll") for (int q = 0; q < 16; ++q) ACC[q] = 0.f; _Pragma("unroll") for (int ks = 0; ks < 4; ++ks) ACC = MFMA32(a1[ks], B[ks], ACC); } while (0)
        bf16x8 bfr[2][4]; f32x16 accs[2];
        IDX_LDB(bfr[0], 0); IDX_LDB(bfr[1], 1);
        IDX_MMA(accs[0], bfr[0]);
#pragma unroll
        for (int sub = 0; sub < 4; ++sub) { const int s = 128 * kt + 32 * sub + r;
            if (sub + 2 < 4) IDX_LDB(bfr[sub & 1], sub + 2);
            if (sub + 1 < 4) IDX_MMA(accs[(sub + 1) & 1], bfr[(sub + 1) & 1]);
            float v4_[4] = {0.f, 0.f, 0.f, 0.f};
#pragma unroll
            for (int q = 0; q < 16; ++q) v4_[q & 3] += w1[q >> 2][q & 3] * relu_i(accs[sub & 1][q]);
            const float v = (v4_[0] + v4_[1]) + (v4_[2] + v4_[3]);
            const unsigned code = scode(v);
            vc[sub >> 1] = (sub & 1) ? (vc[sub >> 1] | (code << 16)) : code;
            { const unsigned bk = code >> 6; lds_add(hist + (2 * w + hh) * 512 + (bk >> 1), (s <= tb1 + hh) ? (1u << (16 * (bk & 1))) : 0u); }
            __builtin_amdgcn_sched_barrier(0); }
#undef IDX_LDB
#undef IDX_MMA
#pragma unroll
        for (int p = 0; p < 2; ++p) scw[(size_t)(tb1 + hh) * (S / 2) + 64 * kt + 32 * p + r] = vc[p];
    }
    asm volatile("s_waitcnt vmcnt(0) lgkmcnt(0)" ::: "memory");
    IPROBE(1);
    select_row(C, tb1, hist + (2 * w) * 512, cand); select_row(C, tb1 + 1, hist + (2 * w + 1) * 512, cand);
    IPROBE(2);
}

#ifndef APROBE
#define APROBE(i) ((void)0)
#endif
__device__ __forceinline__ float rows_max(float x) {
    { const auto r = __builtin_amdgcn_permlane16_swap(__float_as_uint(x), __float_as_uint(x), false, false); float a = __uint_as_float(r[0]), b = __uint_as_float(r[1]); asm("v_max_f32 %0, %1, %2" : "=v"(x) : "v"(a), "v"(b)); }
    { const auto r = __builtin_amdgcn_permlane32_swap(__float_as_uint(x), __float_as_uint(x), false, false); float a = __uint_as_float(r[0]), b = __uint_as_float(r[1]); asm("v_max_f32 %0, %1, %2" : "=v"(x) : "v"(a), "v"(b)); }
    return x;
}
__device__ __forceinline__ float rows_sum(float x) {
    { const auto r = __builtin_amdgcn_permlane16_swap(__float_as_uint(x), __float_as_uint(x), false, false); x = __uint_as_float(r[0]) + __uint_as_float(r[1]); }
    { const auto r = __builtin_amdgcn_permlane32_swap(__float_as_uint(x), __float_as_uint(x), false, false); x = __uint_as_float(r[0]) + __uint_as_float(r[1]); }
    return x;
}
__device__ __forceinline__ void p3_attention(const Ctx& C, int tbase0, int ntok, unsigned long long& tacc_) {
    unsigned long long tq_ = 0ull; (void)tq_; (void)tacc_;
    int tid_ = C.tid; asm volatile("" : "+v"(tid_));
    const int lane = tid_ & 63, w = __builtin_amdgcn_readfirstlane(tid_ >> 6), g = lane >> 4, h = lane & 15;
    LAS uchar* img = C.lds;
    LAS float* mx = (LAS float*)(C.lds + LDS_X);
    LAS float* ls = mx + 128;
    LAS uchar* pf = C.lds + LDS_X + 1024;
    LAS bf16_t* obuf = (LAS bf16_t*)(C.lds + LDS_X + 10240);
    const bf16_t* CK = WSP(bf16_t, WS_CKV);
    const float scale = 0.08838834764831845f;
    const int tstep = 1, niter = ntok, tbase = tbase0, tlast = tbase + (niter - 1) * tstep;
    __syncthreads();
    const int* IDXp = WSP(int, WS_IDX) + 32 * w + (lane & 31);
    int myidx = IDXp[(size_t)tbase * TOPK];
    int idx1 = IDXp[(size_t)(tbase + tstep <= tlast ? tbase + tstep : tlast) * TOPK];
    int tprev = -1;
    bf16x8 bq[8];
    const bf16_t* qzero = WSP(bf16_t, WS_CTL + 512 * 1024) + 8 * g;
    { const bf16_t* qa = (h < 8) ? WSP(bf16_t, WS_QABS) + (size_t)tbase * 2048 + h * 256 + 8 * g : qzero;
#pragma unroll
      for (int kc = 0; kc < 8; ++kc) bq[kc] = *(const bf16x8*)(qa + 32 * kc); }
    u32x4 gv[16];
#pragma unroll
    for (int i = 0; i < 16; ++i) { const int rl = 2 * i + (lane >> 5); const int key = __shfl(myidx, rl); const int kk = (key < 0 || key > tbase) ? 0 : key; gv[i] = *(const u32x4*)(CK + (size_t)kk * CKV + (lane & 31) * 8); }
#pragma unroll 1
    for (int it = 0; it < niter; ++it) {
        const int t = tbase + it * tstep;
        APROBE(0);
        const int t1 = (t + tstep <= tlast) ? t + tstep : tlast, t2 = (t + 2 * tstep <= tlast) ? t + 2 * tstep : tlast;
#pragma unroll
        for (int i = 0; i < 16; ++i) { const int rl = 2 * i + (lane >> 5), ch32 = lane & 31; *(LAS u32x4*)(img + (ch32 >> 4) * 65536 + imgb_off(32 * w + rl, ch32 & 15)) = gv[i]; }
        APROBE(1);
        if (tprev >= 0 && tid_ < 256) st16_wt(WSP(bf16_t, WS_OB) + (size_t)tprev * 2048 + tid_ * 8, *(const LAS u32x4*)(obuf + tid_ * 8));
        f32x4 x0 = {0.f, 0.f, 0.f, 0.f}, x1 = {0.f, 0.f, 0.f, 0.f};
        const unsigned rho0 = 32u * w + 8u * (h >> 2) + (h & 3);
        { bf16x8 qa0[8], qa1[8];
#pragma unroll
          for (int kc = 0; kc < 8; ++kc) { const unsigned ch = (4u * kc + g) & 15u; LAS uchar* ib = img + (kc >> 2) * 65536;
              qa0[kc] = *(LAS bf16x8*)(ib + imgb_off(rho0, ch)); qa1[kc] = *(LAS bf16x8*)(ib + imgb_off(rho0 + 4u, ch)); }
          __builtin_amdgcn_sched_barrier(0);
#pragma unroll
          for (int kc = 0; kc < 8; ++kc) { x0 = MFMA16(qa0[kc], bq[kc], x0); x1 = MFMA16(qa1[kc], bq[kc], x1); } }
        __builtin_amdgcn_sched_barrier(0);
        const int idx2 = IDXp[(size_t)t2 * TOPK];
#pragma unroll
        for (int i = 0; i < 16; ++i) { const int rl = 2 * i + (lane >> 5); const int key = __shfl(idx1, rl); const int kk = (key < 0 || key > t1) ? 0 : key; gv[i] = *(const u32x4*)(CK + (size_t)kk * CKV + (lane & 31) * 8); }
        __builtin_amdgcn_sched_barrier(0);
        const unsigned vmask = (unsigned)__ballot(myidx >= 0 && myidx <= t);
        float lg[8]; float m = -1e30f;
#pragma unroll
        for (int r = 0; r < 4; ++r) { const bool v0 = (vmask >> (8 * g + r)) & 1u, v1 = (vmask >> (8 * g + 4 + r)) & 1u;
            lg[r] = v0 ? x0[r] * scale : -1e30f; lg[4 + r] = v1 ? x1[r] * scale : -1e30f; m = fmaxf(m, fmaxf(lg[r], lg[4 + r])); }
        m = rows_max(m);
        if (g == 0) mx[w * 16 + h] = m;
        LDS_BARRIER();
        APROBE(2);
        float M = mx[h];
#pragma unroll
        for (int ww = 1; ww < 8; ++ww) M = fmaxf(M, mx[ww * 16 + h]);
        float p[8], sum = 0.f;
#pragma unroll
        for (int j = 0; j < 8; ++j) { p[j] = ex2((lg[j] - M) * LOG2E); sum += p[j]; }
        sum = rows_sum(sum);
        if (g == 0) ls[w * 16 + h] = sum;
        { u32x4 pk; pk.x = pk2(p[0], p[1]); pk.y = pk2(p[2], p[3]); pk.z = pk2(p[4], p[5]); pk.w = pk2(p[6], p[7]); *(LAS u32x4*)(pf + (w * 64 + lane) * 16) = pk; }
        LDS_BARRIER();
        APROBE(3);
        { const bf16_t* qa = (h < 8) ? WSP(bf16_t, WS_QABS) + (size_t)t1 * 2048 + h * 256 + 8 * g : qzero;
#pragma unroll
          for (int kc = 0; kc < 8; ++kc) bq[kc] = *(const bf16x8*)(qa + 32 * kc); }
        __builtin_amdgcn_sched_barrier(0);
        float L = ls[h];
#pragma unroll
        for (int ww = 1; ww < 8; ++ww) L += ls[ww * 16 + h];
        f32x4 z0 = {0.f, 0.f, 0.f, 0.f}, z1 = {0.f, 0.f, 0.f, 0.f};
#pragma unroll
        for (int ks = 0; ks < 8; ++ks) { const bf16x8 a = *(LAS bf16x8*)(pf + (ks * 64 + lane) * 16);
            { const unsigned cc = 2u * w; LAS uchar* ib = img + (cc >> 3) * 65536; const bf16x8 b = trrd8(ib + imgb_tr16(lane, cc & 7u, ks, 0), ib + imgb_tr16(lane, cc & 7u, ks, 1)); z0 = MFMA16(a, b, z0); }
            { const unsigned cc = 2u * w + 1u; LAS uchar* ib = img + (cc >> 3) * 65536; const bf16x8 b = trrd8(ib + imgb_tr16(lane, cc & 7u, ks, 0), ib + imgb_tr16(lane, cc & 7u, ks, 1)); z1 = MFMA16(a, b, z1); } }
        float rl[4];
#pragma unroll
        for (int r = 0; r < 4; ++r) rl[r] = 1.0f / __shfl(L, (4 * g + r) & 15);
        if (g < 2) {
#pragma unroll
            for (int r = 0; r < 4; ++r) { obuf[(4 * g + r) * 256 + 32 * w + h] = (bf16_t)(pk2(z0[r] * rl[r], 0.f) & 0xffffu); obuf[(4 * g + r) * 256 + 32 * w + 16 + h] = (bf16_t)(pk2(z1[r] * rl[r], 0.f) & 0xffffu); } }
        tprev = t;
        LDS_BARRIER();
        APROBE(4);
        myidx = idx1; idx1 = idx2;
    }
    if (tprev >= 0 && tid_ < 256) st16_wt(WSP(bf16_t, WS_OB) + (size_t)tprev * 2048 + tid_ * 8, *(const LAS u32x4*)(obuf + tid_ * 8));
}
__device__ __forceinline__ void p3_wuv(const Ctx& C) {
    LAS uchar* imgA0 = C.lds; LAS uchar* imgA1 = C.lds + 32768; LAS uchar* imgB0 = C.lds + 65536; LAS uchar* imgB1 = C.lds + 98304;
    LAS float* stg = (LAS float*)(C.lds) + C.wave * 16 * STG_LD;
    const int lane = C.lane, w = C.wave;
    for (int u = C.bid; u < 64 * NH; u += C.G) {
        const int h = u & 7, t0 = (u >> 3) * 128;
        if (C.tid == 0) { unsigned* rdy = WSP(unsigned, WS_CTL) + CW_OBRDY + (u >> 3); unsigned sp = 0u;
            while (xb_ld(rdy) < 8u) { __builtin_amdgcn_s_sleep(1); if (++sp > XB_SPIN_CAP) break; }
            __builtin_amdgcn_fence(__ATOMIC_ACQUIRE, "agent"); asm volatile("s_waitcnt vmcnt(0)" ::: "memory"); }
        __syncthreads();
        { u32x4 va0[4], va1[4], vb0[4], vb1[4];
          img128_ld(va0, WSP(bf16_t, WS_OB) + (size_t)t0 * 2048 + h * 256, 2048, C.tid);
          img128_ld(va1, WSP(bf16_t, WS_OB) + (size_t)t0 * 2048 + h * 256 + 128, 2048, C.tid);
          img128_ld(vb0, WSP(bf16_t, WS_WUV) + (size_t)h * 256 * 128, 128, C.tid);
          img128_ld(vb1, WSP(bf16_t, WS_WUV) + (size_t)h * 256 * 128 + 128 * 128, 128, C.tid);
          __builtin_amdgcn_sched_barrier(0);
          img128_st(imgA0, va0, C.tid); img128_st(imgA1, va1, C.tid); img128_st(imgB0, vb0, C.tid); img128_st(imgB1, vb1, C.tid); }
        __syncthreads();
        f32x4 acc[8]; ZERO8(acc);
        trgemm(imgA0, imgB0, lane, w, acc); trgemm(imgA1, imgB1, lane, w, acc);
        __syncthreads();
        stage_store_bf16<true>(stg, acc, WSP(bf16_t, WS_AB) + (size_t)(t0 + 16 * w) * 1024 + h * 128, 1024, lane);
    }
    __syncthreads();
}

struct EpiGateA {
    static constexpr bool PERM = true, AFTER_DRAIN = false, MIDK = false;
    bf16_t* TMP; const bf16_t* GATE;
    __device__ __forceinline__ void operator()(const f32x4 (&acc)[2][2][4][2], const pg8::Unit& u, int wr, int wc, int fr, int fq) const {
        const int row0 = u.pm * 256 + wr * 64 + fr, col0 = u.pn * 256 + wc * 32 + 8 * fq;
#pragma unroll
        for (int ai = 0; ai < 2; ++ai)
#pragma unroll
            for (int m = 0; m < 4; ++m) { const size_t row = (size_t)(row0 + ai * 128 + m * 16);
#pragma unroll
                for (int bj = 0; bj < 2; ++bj) { const u32x4 gv = *(const u32x4*)(GATE + row * 4096 + col0 + bj * 128); const f32x4 v0 = acc[ai][bj][m][0], v1 = acc[ai][bj][m][1];
                    u32x4 w; w.x = pk2(v0[0] * bf_lo(gv.x), v0[1] * bf_hi(gv.x)); w.y = pk2(v0[2] * bf_lo(gv.y), v0[3] * bf_hi(gv.y));
                    w.z = pk2(v1[0] * bf_lo(gv.z), v1[1] * bf_hi(gv.z)); w.w = pk2(v1[2] * bf_lo(gv.w), v1[3] * bf_hi(gv.w));
                    *(u32x4*)(TMP + row * D + col0 + bj * 128) = w; } }
    }
};
struct EpiGateB {
    static constexpr bool PERM = true, AFTER_DRAIN = false, MIDK = false;
    const bf16_t* TMP; const bf16_t* GATE; bf16_t* MG;
    __device__ __forceinline__ void operator()(const f32x4 (&acc)[2][2][4][2], const pg8::Unit& u, int wr, int wc, int fr, int fq) const {
        const int row0 = u.pm * 256 + wr * 64 + fr, col0 = u.pn * 256 + wc * 32 + 8 * fq;
#pragma unroll
        for (int ai = 0; ai < 2; ++ai)
#pragma unroll
            for (int m = 0; m < 4; ++m) { const size_t row = (size_t)(row0 + ai * 128 + m * 16);
#pragma unroll
                for (int bj = 0; bj < 2; ++bj) { const u32x4 gv = *(const u32x4*)(GATE + row * 4096 + 2048 + col0 + bj * 128); const f32x4 v0 = acc[ai][bj][m][0], v1 = acc[ai][bj][m][1];
                    const u32x4 tv = *(const u32x4*)(TMP + row * D + col0 + bj * 128);
                    u32x4 w; w.x = pk2(bf_lo(tv.x) + v0[0] * bf_lo(gv.x), bf_hi(tv.x) + v0[1] * bf_hi(gv.x)); w.y = pk2(bf_lo(tv.y) + v0[2] * bf_lo(gv.y), bf_hi(tv.y) + v0[3] * bf_hi(gv.y));
                    w.z = pk2(bf_lo(tv.z) + v1[0] * bf_lo(gv.z), bf_hi(tv.z) + v1[1] * bf_hi(gv.z)); w.w = pk2(bf_lo(tv.w) + v1[2] * bf_lo(gv.w), bf_hi(tv.w) + v1[3] * bf_hi(gv.w));
                    *(u32x4*)(MG + row * D + col0 + bj * 128) = w; } }
    }
};
constexpr int GATE_PM_OFF = (int)((WS_AB - WS_MB) / ((size_t)256 * 1024 * 2)), GATE_PN_OFF = (int)((WS_WBT - WS_WAT) / ((size_t)256 * 1024 * 2));
static_assert(WS_AB > WS_MB && (WS_AB - WS_MB) % ((size_t)256 * 1024 * 2) == 0 && WS_WBT > WS_WAT && (WS_WBT - WS_WAT) % ((size_t)256 * 1024 * 2) == 0, "the two segments' operands are addressed as tiles of one matrix");
struct EpiGateFused {
    static constexpr bool PERM = true, AFTER_DRAIN = false, MIDK = true;
    const bf16_t* GATE; bf16_t* MG;
    __device__ __forceinline__ bool is_mid(const pg8::Unit& u) const { return u.pn >= GATE_PN_OFF; }
    __device__ __forceinline__ void mid(f32x4 (&acc)[2][2][4][2], const pg8::Unit& u, int wr, int wc, int fr, int fq) const {
        const int row0 = u.pm * 256 + wr * 64 + fr, col0 = (u.pn - GATE_PN_OFF) * 256 + wc * 32 + 8 * fq;
#pragma unroll
        for (int ai = 0; ai < 2; ++ai) {
            u32x4 ga[4][2], gb[4][2];
#pragma unroll
            for (int m = 0; m < 4; ++m) { const size_t row = (size_t)(row0 + ai * 128 + m * 16);
#pragma unroll
                for (int bj = 0; bj < 2; ++bj) { ga[m][bj] = *(const u32x4*)(GATE + row * 4096 + col0 + bj * 128); gb[m][bj] = *(const u32x4*)(GATE + row * 4096 + 2048 + col0 + bj * 128); } }
            __builtin_amdgcn_sched_barrier(0);
#pragma unroll
            for (int m = 0; m < 4; ++m)
#pragma unroll
                for (int bj = 0; bj < 2; ++bj) { const u32x4 a = gb[m][bj], b = ga[m][bj];
#define GR_(A, B, H) (bf_##H(A) * __builtin_amdgcn_rcpf(fmaxf(bf_##H(B), 1e-30f)))
                    f32x4 v0 = acc[ai][bj][m][0], v1 = acc[ai][bj][m][1];
                    v0[0] *= GR_(a.x, b.x, lo); v0[1] *= GR_(a.x, b.x, hi); v0[2] *= GR_(a.y, b.y, lo); v0[3] *= GR_(a.y, b.y, hi);
                    v1[0] *= GR_(a.z, b.z, lo); v1[1] *= GR_(a.z, b.z, hi); v1[2] *= GR_(a.w, b.w, lo); v1[3] *= GR_(a.w, b.w, hi);
#undef GR_
                    acc[ai][bj][m][0] = v0; acc[ai][bj][m][1] = v1; }
            __builtin_amdgcn_sched_barrier(0);
        }
    }
    __device__ __forceinline__ void operator()(const f32x4 (&acc)[2][2][4][2], const pg8::Unit& u, int wr, int wc, int fr, int fq) const {
        const int row0 = (u.pm - GATE_PM_OFF) * 256 + wr * 64 + fr, col0 = u.pn * 256 + wc * 32 + 8 * fq;
#pragma unroll
        for (int ai = 0; ai < 2; ++ai) {
            u32x4 gb[4][2];
#pragma unroll
            for (int m = 0; m < 4; ++m) { const size_t row = (size_t)(row0 + ai * 128 + m * 16);
#pragma unroll
                for (int bj = 0; bj < 2; ++bj) gb[m][bj] = *(const u32x4*)(GATE + row * 4096 + col0 + bj * 128); }
            __builtin_amdgcn_sched_barrier(0);
#pragma unroll
            for (int m = 0; m < 4; ++m) { const size_t row = (size_t)(row0 + ai * 128 + m * 16);
#pragma unroll
                for (int bj = 0; bj < 2; ++bj) { const u32x4 gv = gb[m][bj]; const f32x4 v0 = acc[ai][bj][m][0], v1 = acc[ai][bj][m][1];
#define GB_(B, H) fmaxf(bf_##H(B), 1e-30f)
                    u32x4 w; w.x = pk2(v0[0] * GB_(gv.x, lo), v0[1] * GB_(gv.x, hi)); w.y = pk2(v0[2] * GB_(gv.y, lo), v0[3] * GB_(gv.y, hi));
                    w.z = pk2(v1[0] * GB_(gv.z, lo), v1[1] * GB_(gv.z, hi)); w.w = pk2(v1[2] * GB_(gv.w, lo), v1[3] * GB_(gv.w, hi));
#undef GB_
                    *(u32x4*)(MG + row * D + col0 + bj * 128) = w; } }
            __builtin_amdgcn_sched_barrier(0);
        }
    }
};
struct GateOrder {
    pg8::StaticOrder so; unsigned* ready;
    __device__ __forceinline__ bool next(int i, pg8::Unit& u) const { if (!so.next(i >> 1, u)) return false; if (i & 1) u.pm += GATE_PM_OFF; else u.pn += GATE_PN_OFF; return true; }
    __device__ __forceinline__ void a_ready(const pg8::Unit& u) const {
        if (u.pm < GATE_PM_OFF) return;
        if (threadIdx.x == 0) { unsigned sp = 0u; while (xb_ld(&ready[u.pm - GATE_PM_OFF]) < 16u) { __builtin_amdgcn_s_sleep(1); if (++sp > XB_SPIN_CAP) break; }
            __builtin_amdgcn_fence(__ATOMIC_ACQUIRE, "agent"); asm volatile("s_waitcnt vmcnt(0)" ::: "memory"); }
        __builtin_amdgcn_s_barrier();
    }
    __device__ __forceinline__ void done(const pg8::Unit&) const {}
};
struct EpiRes {
    static constexpr bool PERM = true, AFTER_DRAIN = false, MIDK = false;
    const float* X; float* H;
    __device__ __forceinline__ void operator()(const f32x4 (&acc)[2][2][4][2], const pg8::Unit& u, int wr, int wc, int fr, int fq) const {
        const int row0 = u.pm * 256 + wr * 64 + fr, col0 = u.pn * 256 + wc * 32 + 8 * fq;
#pragma unroll
        for (int ai = 0; ai < 2; ++ai) {
            f32x4 xv[4][2][2];
#pragma unroll
            for (int m = 0; m < 4; ++m) { const size_t off = (size_t)(row0 + ai * 128 + m * 16) * D + col0;
#pragma unroll
                for (int bj = 0; bj < 2; ++bj)
#pragma unroll
                    for (int n = 0; n < 2; ++n) xv[m][bj][n] = *(const f32x4*)(X + off + bj * 128 + n * 4); }
            __builtin_amdgcn_sched_barrier(0);
#pragma unroll
            for (int m = 0; m < 4; ++m) { const size_t off = (size_t)(row0 + ai * 128 + m * 16) * D + col0;
#pragma unroll
                for (int bj = 0; bj < 2; ++bj)
#pragma unroll
                    for (int n = 0; n < 2; ++n) *(f32x4*)(H + off + bj * 128 + n * 4) = xv[m][bj][n] + acc[ai][bj][m][n]; }
            __builtin_amdgcn_sched_barrier(0);
        }
    }
};
#ifndef RPROBE
#define RPROBE(i) ((void)0)
#endif
__device__ __forceinline__ void p6_router(const Ctx& C, unsigned long long& tacc_) {
    unsigned long long tq_ = 0ull; (void)tq_; (void)tacc_;
    constexpr int XLD = 68;
    LAS float* part = (LAS float*)C.lds;
    LAS float* xst = (LAS float*)C.lds + C.wave * (2 * 32 * XLD);
    LAS float* rsum = (LAS float*)(C.lds + 139264);
    LAS float* rs = rsum + 256;
    LAS float* lgt = rs + 32;
    const int lane = C.lane, w = C.wave, tid = C.tid;
    const float* H = C.out;
    unsigned* cnt = WSP(unsigned, WS_CTL) + CW_CNT;
#pragma unroll 1
    for (int u = C.bid; u < S / 32; u += C.G) {
        const int t0 = 32 * u;
        __syncthreads();
        RPROBE(0);
        RPROBE(1);
        {   f32x4 acc[2][5];
#pragma unroll
            for (int a = 0; a < 2; ++a)
#pragma unroll
                for (int b = 0; b < 5; ++b) acc[a][b] = (f32x4){0.f, 0.f, 0.f, 0.f};
            const int c = lane & 15, kq = lane >> 4;
            const float* hrow = H + (size_t)(t0 + kq) * D + 256 * w + 4 * c;
            const float* bp = WSP(float, WS_WRT) + (size_t)(64 * w) * 320 + lane;
            f32x4 st[8]; float sq[8];
#pragma unroll
            for (int j = 0; j < 8; ++j) { st[j] = *(const f32x4*)(hrow + (size_t)(4 * j) * D); sq[j] = 0.f; }
            constexpr int NB = 8;
            float cb_[NB][5];
#pragma unroll
            for (int q = 0; q < NB; ++q)
#pragma unroll
                for (int cb = 0; cb < 5; ++cb) cb_[q][cb] = bp[(size_t)(q * 5 + cb) * 64];
#pragma unroll 1
            for (int ch = 0; ch < 4; ++ch) {
                LAS float* xs = xst + (ch & 1) * (32 * XLD);
#pragma unroll
                for (int j = 0; j < 8; ++j) { sq[j] += (st[j].x * st[j].x + st[j].y * st[j].y) + (st[j].z * st[j].z + st[j].w * st[j].w); *(LAS f32x4*)(xs + (4 * j + kq) * XLD + 4 * c) = st[j]; }
                { const int cn = (ch + 1 < 4) ? ch + 1 : ch;
#pragma unroll
                  for (int j = 0; j < 8; ++j) st[j] = *(const f32x4*)(hrow + (size_t)(4 * j) * D + 64 * cn); }
#pragma unroll
                for (int hb = 0; hb < 2; ++hb) {
                    float nb[NB][5];
                    const int bt = 2 * ch + hb, kn = (bt + 1 < 8) ? NB * (bt + 1) : 0;
#pragma unroll
                    for (int q = 0; q < NB; ++q)
#pragma unroll
                        for (int cb = 0; cb < 5; ++cb) nb[q][cb] = bp[(size_t)((kn + q) * 5 + cb) * 64];
                    __builtin_amdgcn_sched_barrier(0);
#pragma unroll
                    for (int q = 0; q < NB; ++q) { const float a0 = xs[c * XLD + 4 * (NB * hb + q) + kq], a1 = xs[(16 + c) * XLD + 4 * (NB * hb + q) + kq];
#pragma unroll
                        for (int cb = 0; cb < 5; ++cb) { acc[0][cb] = __builtin_amdgcn_mfma_f32_16x16x4f32(a0, cb_[q][cb], acc[0][cb], 0, 0, 0); acc[1][cb] = __builtin_amdgcn_mfma_f32_16x16x4f32(a1, cb_[q][cb], acc[1][cb], 0, 0, 0); } }
                    __builtin_amdgcn_sched_barrier(0);
#pragma unroll
                    for (int q = 0; q < NB; ++q)
#pragma unroll
                        for (int cb = 0; cb < 5; ++cb) cb_[q][cb] = nb[q][cb];
                }
            }
#pragma unroll
            for (int j = 0; j < 8; ++j) { float v = sq[j]; v += __shfl_xor(v, 1); v += __shfl_xor(v, 2); v += __shfl_xor(v, 4); v += __shfl_xor(v, 8); if (c == 0) rsum[w * 32 + 4 * j + kq] = v; }
            __syncthreads();
#pragma unroll
            for (int rb = 0; rb < 2; ++rb)
#pragma unroll
                for (int cb = 0; cb < 5; ++cb)
#pragma unroll
                    for (int i = 0; i < 4; ++i) part[(w * 32 + 16 * rb + 4 * kq + i) * 80 + 16 * cb + c] = acc[rb][cb][i];
            if (tid < 32) { float q = 0.f;
#pragma unroll
                for (int ww = 0; ww < 8; ++ww) q += rsum[ww * 32 + tid];
                rs[tid] = 1.0f / sqrtf(q * (1.f / D) + EPS); }
        }
        __syncthreads();
        RPROBE(2);
        for (int o = tid; o < 32 * 80; o += NTHR) { const int tok = o / 80; float s = 0.f;
#pragma unroll
            for (int ww = 0; ww < 8; ++ww) s += part[ww * 2560 + o];
            lgt[o] = s * rs[tok]; }
#pragma unroll 1
        for (int rr = 0; rr < 4; rr += 2) { const int t = t0 + 4 * w + rr;
            const f32x4* hr = (const f32x4*)(H + (size_t)t * D) + lane; const f32x4* gr = (const f32x4*)C.in[I_N2G] + lane;
            f32x4 v[8], v2[8];
#pragma unroll
            for (int j = 0; j < 8; ++j) { v[j] = hr[64 * j]; v2[j] = hr[64 * j + D / 4]; }
            f32x4 gq[8];
#pragma unroll
            for (int j = 0; j < 8; ++j) gq[j] = gr[64 * j];
            const float rstd = rs[4 * w + rr], rstd2 = rs[4 * w + rr + 1];
            u32x2* o = WSP(u32x2, WS_N1) + (size_t)t * (D / 4) + lane;
#pragma unroll
            for (int j = 0; j < 8; ++j) { const f32x4 g = gq[j]; u32x2 ww; ww.x = pk2(v[j].x * rstd * g.x, v[j].y * rstd * g.y); ww.y = pk2(v[j].z * rstd * g.z, v[j].w * rstd * g.w); o[64 * j] = ww;
                u32x2 w2; w2.x = pk2(v2[j].x * rstd2 * g.x, v2[j].y * rstd2 * g.y); w2.y = pk2(v2[j].z * rstd2 * g.z, v2[j].w * rstd2 * g.w); o[64 * j + D / 4] = w2; } }
        __syncthreads();
        if (tid < 32) { const int t = t0 + tid; const LAS float* l = lgt + tid * 80;
            int gi = 0; float gm = l[0] + C.in[I_BGRP][0];
#pragma unroll
            for (int i = 1; i < 8; ++i) { const float v = l[i] + C.in[I_BGRP][i]; if (v > gm) { gm = v; gi = i; } }
            float den = 0.f;
#pragma unroll
            for (int i = 0; i < 8; ++i) den += __expf(l[i] + C.in[I_BGRP][i] - gm);
            const float gval = 1.0f / den;
            const LAS float* el = l + 16 + 8 * gi; const float* be = C.in[I_BRT] + 8 * gi;
            int i0 = 0; float v0 = el[0] + be[0];
#pragma unroll
            for (int i = 1; i < 8; ++i) { const float v = el[i] + be[i]; if (v > v0) { v0 = v; i0 = i; } }
            int i1 = 0; float v1 = -3.0e38f;
#pragma unroll
            for (int i = 0; i < 8; ++i) { const float v = el[i] + be[i]; if (i != i0 && v > v1) { v1 = v; i1 = i; } }
            const float q0 = 1.0f / (1.0f + __expf(v1 - v0)), q1 = 1.0f - q0;
            const int e0 = 8 * gi + i0, e1 = 8 * gi + i1;
            const int p0 = (int)atomicAdd(cnt + 64 * e0, 1u), p1 = (int)atomicAdd(cnt + 64 * e1, 1u);
            int* list = WSP(int, WS_LIST); float* cw = WSP(float, WS_CWT);
            if (p0 < S) list[e0 * S + p0] = 2 * t; if (p1 < S) list[e1 * S + p1] = 2 * t + 1;
            cw[2 * t] = gval * q0; cw[2 * t + 1] = gval * q1; }
        RPROBE(3);
    }
    __syncthreads();
}
template <int MODE, int DBG = 0> __device__ __forceinline__ void moe_phase(const Ctx& C) {
    constexpr int K = (MODE == 1) ? D : FF, NSL = (MODE == 1) ? 8 : 16, NKS = K / 64, BM = 256;
    constexpr int ABYTES = BM * 144, BBYTES = 64 * 256, AOFF = 2 * BBYTES;
    LAS uchar* lds = C.lds; LAS int* ridb = (LAS int*)(lds + AOFF + 2 * ABYTES);
    const int tid = C.tid, lane = C.lane, w = C.wave, g = lane >> 4, c16 = lane & 15, wr = w >> 1, wc = w & 1;
    const unsigned* cnt = WSP(unsigned, WS_CTL) + CW_CNT; const int* list = WSP(int, WS_LIST);
    const bf16_t* N2 = WSP(bf16_t, WS_N1); bf16_t* HID = WSP(bf16_t, DBG ? WS_SC : WS_HID); bf16_t* Y = WSP(bf16_t, DBG ? WS_SC : WS_Y); const bf16_t* HIDR = WSP(bf16_t, WS_HID);
    const int n4 = 4 * (tid & 31), kr = tid >> 5;
    const unsigned bw_off = imgb_off((unsigned)kr, (unsigned)(n4 >> 3)) + 8u * ((n4 >> 2) & 1);
    const unsigned aw_off = (unsigned)((tid >> 3) * 144 + (tid & 7) * 16);
    LAS int* pfx = (LAS int*)(lds + AOFF + 2 * ABYTES + 2048);
    LAS float* cwl = (LAS float*)(lds + AOFF + 2 * ABYTES + 3072);
    __syncthreads();
    LAS int* mel = pfx + 128;
    if (tid < 64) {
        int c = (int)cnt[64 * (tid < NE ? tid : NE - 1)]; if (c > S) c = S; if (tid >= NE) c = 0;
        const unsigned gq = (unsigned)((c + BM - 1) / BM), incl = wave_incl_scan(gq);
        if (tid < NE) { mel[tid] = c; pfx[tid] = (int)(incl - gq); }
        if (tid == 63) pfx[NE] = (int)incl; }
    __syncthreads();
    const int ngroups = pfx[NE];
    const bool xdeal = (C.G % 8) == 0 && ((C.G >> 3) % NSL) == 0;
    const int y = C.bid >> 3, slots = xdeal ? (C.G >> 3) / NSL : 1;
    const int g0 = xdeal ? slots * (C.bid & 7) + (y / NSL) : C.bid / NSL, gstep = xdeal ? 8 * slots : (C.G / NSL > 0 ? C.G / NSL : 1);
    const int sl = xdeal ? y % NSL : C.bid % NSL;
    const size_t ldb = (MODE == 1) ? FF : D;
    if (g0 < ngroups && (xdeal || C.bid < (C.G / NSL) * NSL)) {
        int gi = g0, e = 0;
        while (pfx[e + 1] <= gi) ++e;
        int m0 = (gi - pfx[e]) * BM, Me = mel[e];
        { const int r = m0 + (tid & (BM - 1)); ridb[tid & (BM - 1)] = list[e * S + (r < Me ? r : Me - 1)]; }
        __syncthreads();
        int cur = 0;
        const float* bsrc;
        { const int eb = (DBG == 2) ? 0 : e;
          const float* weg_ = C.in[I_WEG]; const float* weu_ = C.in[I_WEU];
          if (MODE == 1) bsrc = ((n4 & 32) == 0 ? weg_ : weu_) + (size_t)eb * D * FF + sl * 64 + 32 * (n4 >> 6) + (n4 & 31);
          else bsrc = C.in[I_WED] + (size_t)eb * FF * D + sl * 128 + n4;
          bsrc += (size_t)kr * ldb; }
        const bf16_t* ap[4];
#define MOE_AP(RID) do { _Pragma("unroll") for (int j = 0; j < 4; ++j) { const int id = (DBG == 3) ? 0 : (RID)[(tid >> 3) + 64 * j]; ap[j] = ((MODE == 1) ? N2 + (size_t)(id >> 1) * D : HIDR + (size_t)id * FF) + (tid & 7) * 8; } } while (0)
        MOE_AP(ridb);
        u32x4 ra0[4], ra1[4]; f32x4 rb0[4], rb1[4];
#define MOE_LOAD(RA, RB, step) do { _Pragma("unroll") for (int j = 0; j < 4; ++j) { RA[j] = *(const u32x4*)(ap[j] + 64 * (step)); RB[j] = *(const f32x4*)(bsrc + (size_t)(64 * (step) + 16 * j) * ldb); } } while (0)
#define MOE_WRITE(RA, RB, bi) do { _Pragma("unroll") for (int j = 0; j < 4; ++j) { *(LAS u32x4*)(lds + AOFF + (bi) * ABYTES + aw_off + 9216 * j) = RA[j]; \
            *(LAS u32x2*)(lds + (bi) * BBYTES + bw_off + 4096 * j) = (u32x2){pk2(RB[j].x, RB[j].y), pk2(RB[j].z, RB[j].w)}; } } while (0)
#define MOE_COMPUTE(bi) do { _Pragma("unroll") for (int s = 0; s < 2; ++s) { \
            bf16x8 af[4]; _Pragma("unroll") for (int rbk = 0; rbk < 4; ++rbk) af[rbk] = *(const LAS bf16x8*)(lds + AOFF + (bi) * ABYTES + (64 * wr + 16 * rbk + c16) * 144 + (4 * s + g) * 16); \
            bf16x8 bf[4]; _Pragma("unroll") for (int c = 0; c < 4; ++c) bf[c] = trrd8(lds + (bi) * BBYTES + imgb_tr16(lane, 4 * wc + c, s, 0), lds + (bi) * BBYTES + imgb_tr16(lane, 4 * wc + c, s, 1)); \
            __builtin_amdgcn_s_setprio(1); _Pragma("unroll") for (int rbk = 0; rbk < 4; ++rbk) { _Pragma("unroll") for (int c = 0; c < 4; ++c) acc[rbk][c] = MFMA16(af[rbk], bf[c], acc[rbk][c]); } __builtin_amdgcn_s_setprio(0); } } while (0)
        MOE_LOAD(ra0, rb0, 0);
        __builtin_amdgcn_sched_barrier(0);
        MOE_LOAD(ra1, rb1, 1);
        __builtin_amdgcn_sched_barrier(0);
        {
            bf16_t* dummy0 = WSP(bf16_t, WS_SC) + (size_t)(64 << 20) + (size_t)C.bid * 65536 + tid * 8;
#pragma unroll
            for (int i = 0; i < ((MODE == 1) ? 4 : 8); ++i) *(u32x4*)(dummy0 + 4096 * i) = (u32x4){0u, 0u, 0u, 0u};
        }
        __builtin_amdgcn_sched_barrier(0);
#pragma unroll 1
        for (;;) {
            LAS int* rid = ridb + 256 * cur; LAS int* ridn = ridb + 256 * (cur ^ 1);
            const int gin = gi + gstep; const bool hn = gin < ngroups;
            int en = e; if (hn) { while (pfx[en + 1] <= gin) ++en; }
            int m0n = m0, Men = Me; if (hn) { m0n = (gin - pfx[en]) * BM; Men = mel[en]; }
            int ridv; { const int r = m0n + (tid & (BM - 1)); ridv = list[en * S + (r < Men ? r : Men - 1)]; }
            float cwv = 0.f; if (MODE == 1) cwv = WSP(float, WS_CWT)[rid[tid & (BM - 1)]];
            MOE_WRITE(ra0, rb0, 0);
            __syncthreads();
            f32x4 acc[4][4];
#pragma unroll
            for (int a = 0; a < 4; ++a)
#pragma unroll
                for (int b = 0; b < 4; ++b) acc[a][b] = (f32x4){0.f, 0.f, 0.f, 0.f};
#pragma unroll 1
            for (int ks = 0; ks < NKS - 2; ks += 2) {
                MOE_LOAD(ra0, rb0, ks + 2);
                __builtin_amdgcn_sched_barrier(0);
                MOE_COMPUTE(0);
                MOE_WRITE(ra1, rb1, 1);
                __syncthreads();
                MOE_LOAD(ra1, rb1, ks + 3);
                __builtin_amdgcn_sched_barrier(0);
                MOE_COMPUTE(1);
                MOE_WRITE(ra0, rb0, 0);
                __syncthreads();
            }
            MOE_COMPUTE(0);
            MOE_WRITE(ra1, rb1, 1);
            ridn[tid & (BM - 1)] = ridv;
            if (MODE == 1) cwl[tid & (BM - 1)] = cwv;
            __syncthreads();
            MOE_AP(ridn);
            { const int eb = (DBG == 2) ? 0 : (en - e); bsrc += (size_t)eb * ((MODE == 1) ? (size_t)D * FF : (size_t)FF * D); }
            MOE_LOAD(ra0, rb0, 0);
            __builtin_amdgcn_sched_barrier(0);
            MOE_LOAD(ra1, rb1, 1);
            __builtin_amdgcn_sched_barrier(0);
            MOE_COMPUTE(1);
            LDS_BARRIER();
            int tid_e = tid; asm volatile("" : "+v"(tid_e));
            const int lane_e = tid_e & 63, w_e = tid_e >> 6, g_e = lane_e >> 4, c16_e = lane_e & 15, wr_e = w_e >> 1, wc_e = w_e & 1;
            LAS bf16_t* stg = (LAS bf16_t*)(lds + w_e * 8192);
            bf16_t* dummy = WSP(bf16_t, WS_SC) + (size_t)(64 << 20) + (size_t)C.bid * 65536 + tid_e * 8;
            if (MODE == 1) {
#pragma unroll
                for (int rbk = 0; rbk < 4; ++rbk)
#pragma unroll
                    for (int r = 0; r < 4; ++r) { const int rowl = 16 * rbk + 4 * g_e + r; const float cw = cwl[64 * wr_e + rowl];
#pragma unroll
                        for (int c = 0; c < 2; ++c) stg[rowl * 32 + 16 * c + c16_e] = (bf16_t)(pk2(silu_(acc[rbk][c][r]) * acc[rbk][c + 2][r] * cw, 0.f) & 0xffffu); }
#pragma unroll
                for (int i = 0; i < 4; ++i) { const int q = lane_e + 64 * i, row = q >> 2, ch = q & 3;
                    bf16_t* dst = (m0 + 64 * wr_e + row < Me) ? HID + (size_t)rid[64 * wr_e + row] * FF + sl * 64 + 32 * wc_e + ch * 8 : dummy;
                    *(u32x4*)dst = *(const LAS u32x4*)(stg + row * 32 + ch * 8); }
            } else {
#pragma unroll
                for (int rbk = 0; rbk < 4; ++rbk)
#pragma unroll
                    for (int r = 0; r < 4; ++r) { const int rowl = 16 * rbk + 4 * g_e + r;
#pragma unroll
                        for (int c = 0; c < 4; ++c) stg[rowl * 64 + 16 * c + c16_e] = (bf16_t)(pk2(acc[rbk][c][r], 0.f) & 0xffffu); }
#pragma unroll
                for (int i = 0; i < 8; ++i) { const int q = lane_e + 64 * i, row = q >> 3, ch = q & 7;
                    bf16_t* dst = (m0 + 64 * wr_e + row < Me) ? Y + (size_t)rid[64 * wr_e + row] * D + sl * 128 + 64 * wc_e + ch * 8 : dummy;
                    *(u32x4*)dst = *(const LAS u32x4*)(stg + row * 64 + ch * 8); }
            }
            if (!hn) break;
            LDS_BARRIER();
            gi = gin; e = en; m0 = m0n; Me = Men; cur ^= 1;
        }
        asm volatile("s_waitcnt vmcnt(0)" ::: "memory");
#undef MOE_AP
#undef MOE_LOAD
#undef MOE_WRITE
#undef MOE_COMPUTE
    }
    __syncthreads();
}
__device__ __forceinline__ void p9_final(const Ctx& C, unsigned* ctl = nullptr, int spf = -1) {
    const int gw = C.bid * NWAVE + C.wave, NGW = C.G * NWAVE, lane = C.lane;
    const bf16_t* Y = WSP(bf16_t, WS_Y);
    f32x4 gv[8];
#pragma unroll
    for (int j = 0; j < 8; ++j) gv[j] = ((const f32x4*)C.in[I_NFG] + lane)[64 * j];
    bool waited = spf < 0;
    for (int t0 = gw; t0 < S; t0 += 2 * NGW) {
        const int tt[2] = {t0, (t0 + NGW < S) ? t0 + NGW : t0};
        f32x4 hv[2][8]; u32x2 ya[2][8], yb[2][8];
#pragma unroll
        for (int q = 0; q < 2; ++q) { const f32x4* hr = (const f32x4*)(C.out + (size_t)tt[q] * D) + lane;
#pragma unroll
            for (int j = 0; j < 8; ++j) hv[q][j] = hr[64 * j]; }
        if (!waited) {
            __builtin_amdgcn_sched_barrier(0);
            if (C.tid == 0) { XB_SPIN(xb_ld(&ctl[spf]) == 0u, ctl + CW_BAR); __builtin_amdgcn_fence(__ATOMIC_ACQUIRE, "agent"); asm volatile("s_waitcnt vmcnt(0)" ::: "memory"); }
            __syncthreads();
            waited = true; }
#pragma unroll
        for (int q = 0; q < 2; ++q) {
            const u32x2* y0 = (const u32x2*)(Y + (size_t)(2 * tt[q]) * D) + lane; const u32x2* y1 = (const u32x2*)(Y + (size_t)(2 * tt[q] + 1) * D) + lane;
#pragma unroll
            for (int j = 0; j < 8; ++j) { ya[q][j] = y0[64 * j]; yb[q][j] = y1[64 * j]; } }
#pragma unroll
        for (int q = 0; q < 2; ++q) { if (q == 1 && tt[1] == tt[0]) break;
            f32x4 v[8]; float ss = 0.f;
#pragma unroll
            for (int j = 0; j < 8; ++j) { const u32x2 a = ya[q][j], b = yb[q][j]; const f32x4 h4 = hv[q][j];
                v[j] = (f32x4){h4.x + (bf_lo(a.x) + bf_lo(b.x)), h4.y + (bf_hi(a.x) + bf_hi(b.x)), h4.z + (bf_lo(a.y) + bf_lo(b.y)), h4.w + (bf_hi(a.y) + bf_hi(b.y))};
                ss += (v[j].x * v[j].x + v[j].y * v[j].y) + (v[j].z * v[j].z + v[j].w * v[j].w); }
            const float rstd = 1.0f / sqrtf(wave_sum(ss) * (1.f / D) + EPS);
            f32x4* hw = (f32x4*)(C.out + (size_t)tt[q] * D) + lane;
#pragma unroll
            for (int j = 0; j < 8; ++j) { const f32x4 g = gv[j]; hw[64 * j] = (f32x4){v[j].x * rstd * g.x, v[j].y * rstd * g.y, v[j].z * rstd * g.z, v[j].w * rstd * g.w}; } }
    }
}

#ifndef MK_PROBE
#define MK_PROBE 0
#endif
struct Args { const float* in[22]; float* out; unsigned char* ws; int lo, hi, li, pad; };
constexpr int NPHASE = 11;
}

__device__ __forceinline__ void split_arrive(const XcdBarrier& b, unsigned* ctl, int spx, int spt, int spf) {
    asm volatile("s_waitcnt vmcnt(0)" ::: "memory");
    __syncthreads();
    if (threadIdx.x == 0) {
        __builtin_amdgcn_s_waitcnt(0);
        unsigned nloc = b.st[0], nx = b.st[1];
        if (nloc == 0u) { xcd_barrier_complete(b.bar, b.x, nloc, nx); b.st[0] = nloc; b.st[1] = nx; }
        const unsigned old = xb_add(&ctl[spx + 8 * b.x], 1u);
        if (old + 1u == nloc) {
            __builtin_amdgcn_fence(__ATOMIC_RELEASE, "agent"); asm volatile("s_waitcnt vmcnt(0)" ::: "memory");
            const unsigned og = xb_add(&ctl[spt], 1u);
            if (og + 1u == nx) (void)xb_add(&ctl[spf], 1u);
        }
    }
}
__device__ __forceinline__ void split_wait(unsigned* ctl, int spf) {
    if (threadIdx.x == 0) { XB_SPIN(xb_ld(&ctl[spf]) == 0u, ctl + mk::CW_BAR);
        __builtin_amdgcn_fence(__ATOMIC_ACQUIRE, "agent"); asm volatile("s_waitcnt vmcnt(0)" ::: "memory"); }
    __syncthreads();
}

__global__ void __launch_bounds__(512, 2) mk_fwd(mk::Args a) {
    using namespace mk;
    extern __shared__ __attribute__((aligned(16))) unsigned char lds_raw[];
    Ctx C; C.lds = (LAS uchar*)lds_raw; C.tid = threadIdx.x; C.lane = C.tid & 63; C.wave = __builtin_amdgcn_readfirstlane(C.tid >> 6); C.G = gridDim.x; C.bid = blockIdx.x;
#pragma unroll
    for (int i = 0; i < 22; ++i) C.in[i] = a.in[i];
    C.out = a.out; C.ws = a.ws;
    volatile LAS unsigned* misc = (volatile LAS unsigned*)(C.lds + LDS_MISC);
    if (C.tid < 64) misc[C.tid] = 0u;
    __syncthreads();
    XcdBarrier bar = xcd_barrier_post((unsigned*)(C.ws + WS_CTL) + CW_BAR + a.li * XCD_BAR_WORDS, misc + 8);
    const int lo = a.lo, hi = a.hi;
#define IN(k) (lo <= (k) && (k) < hi)
#if MK_PROBE >= 20
    unsigned long long tacc = 0ull, tq0 = 0ull; (void)tq0;
#define TICK() (tq0 = __builtin_amdgcn_s_memrealtime())
#define TOCK() (tacc += __builtin_amdgcn_s_memrealtime() - tq0)
#else
#define TICK() ((void)0)
#define TOCK() ((void)0)
#endif
#if MK_PROBE >= 50 && MK_PROBE < 60
#define SEAM_MASK ((MK_PROBE == 50) ? 0x003 : (MK_PROBE == 51) ? 0x00c : (MK_PROBE == 52) ? 0x070 : 0x380)
#define SEAM(k) do { if (IN(k) && IN((k) + 1)) { if ((SEAM_MASK >> (k)) & 1) { TICK(); xcd_barrier(bar); TOCK(); } else xcd_barrier(bar); } } while (0)
#elif MK_PROBE == 20
#define SEAM(k) do { if (IN(k) && IN((k) + 1)) { TICK(); xcd_barrier(bar); TOCK(); } } while (0)
#else
#if MK_PROBE == 19
#define SEAM(k) do { if (IN(k) && IN((k) + 1)) { xcd_barrier(bar); xcd_barrier(bar); } } while (0)
#else
#define SEAM(k) do { if (IN(k) && IN((k) + 1)) xcd_barrier(bar); } while (0)
#endif
#endif
    LAS unsigned char* stage = (LAS unsigned char*)lds_raw;

#if MK_PROBE == 80
    TICK();
#endif
    if (IN(0)) { p0_prologue(C, (IN(0) && IN(1)) ? 1 : 0);
#if MK_PROBE == 1
        p0_prologue(C);
#endif
    }
#if MK_PROBE == 80
    TOCK();
#endif
    if (IN(0) && IN(1)) { split_arrive(bar, WSP(unsigned, WS_CTL), CW_STX, CW_STT, CW_STF); p0_prologue(C, 2); split_wait(WSP(unsigned, WS_CTL), CW_STF); }
#if MK_PROBE == 81
    TICK();
#endif
    if (IN(1)) {
        pg8::Gemm g{WSP(bf16_t, WS_N1), WSP(bf16_t, WS_WINT), S, NPROJ, D}; ProjOrderA so; so.init(S, 32 * 256, C.G, C.bid);
        EpiProj E{WSP(bf16_t, WS_Q), WSP(bf16_t, WS_QI), WSP(bf16_t, WS_UV), WSP(bf16_t, WS_GATE), WSP(bf16_t, WS_KIDX), WSP(float, WS_CKVF), WSP(float, WS_LNS), WSP(float, WS_WIDX)};
        pg8::gemm_phase<EpiProj, ProjOrderA, true, true>(stage, g, so, E);
    }
#if MK_PROBE == 81
    TOCK();
#endif
    if (IN(1) && IN(2)) split_arrive(bar, WSP(unsigned, WS_CTL), CW_SQX, CW_SQT, CW_SQF);
    if (IN(2)) {
        const bool split = (C.G % 4) == 0 && C.G / 4 >= 64;
        if (split && (C.bid & 3) == 0 && (C.bid >> 2) < 64) {
            pg8::Gemm g{WSP(bf16_t, WS_N1), WSP(bf16_t, WS_WINT), S, NPROJ, D}; ProjOrderB so; so.j = C.bid >> 2;
            EpiProj E{WSP(bf16_t, WS_Q), WSP(bf16_t, WS_QI), WSP(bf16_t, WS_UV), WSP(bf16_t, WS_GATE), WSP(bf16_t, WS_KIDX), WSP(float, WS_CKVF), WSP(float, WS_LNS), WSP(float, WS_WIDX)};
            pg8::gemm_phase<EpiProj, ProjOrderB, true, true>(stage, g, so, E);
            if (IN(1)) split_wait(WSP(unsigned, WS_CTL), CW_SQF);
        } else {
            Ctx C2 = C;
            if (split) { const int q = C.bid >> 2; C2.bid = C.bid - (q < 64 ? q + 1 : 64); C2.G = C.G - 64; }
            else if (C.bid == 0) {   }
            p0_late(C2);
            if (IN(1)) split_wait(WSP(unsigned, WS_CTL), CW_SQF);
            p2_ckv_norm(C2); p2_qabs(C2); p2_gmlp(C2);
        }
        if (!split) {
            pg8::Gemm g{WSP(bf16_t, WS_N1), WSP(bf16_t, WS_WINT), S, NPROJ, D}; ProjOrderC so; so.G = C.G; so.c = C.bid;
            EpiProj E{WSP(bf16_t, WS_Q), WSP(bf16_t, WS_QI), WSP(bf16_t, WS_UV), WSP(bf16_t, WS_GATE), WSP(bf16_t, WS_KIDX), WSP(float, WS_CKVF), WSP(float, WS_LNS), WSP(float, WS_WIDX)};
            __syncthreads();
            pg8::gemm_phase<EpiProj, ProjOrderC, true, true>(stage, g, so, E);
        }
    }
    if (IN(2) && IN(3)) split_arrive(bar, WSP(unsigned, WS_CTL), CW_SPX, CW_SPT, CW_SPF);
#if MK_PROBE == 83
    TICK();
#endif
    if (IN(3)) {
        unsigned long long ia_ = 0ull, aa_ = 0ull;
#pragma unroll 1
        for (int j = 2 * C.bid; j < 512; j += (j & 1) ? 2 * C.G - 1 : 1) { const int set = (j & 1) ? 511 - (j >> 1) : (j >> 1); idx_set(C, 16 * set, ia_); }
        if (IN(2)) split_wait(WSP(unsigned, WS_CTL), CW_SPF); else __syncthreads();
#pragma unroll 1
        for (int j = 2 * C.bid; j < 512; j += (j & 1) ? 2 * C.G - 1 : 1) { const int set = (j & 1) ? 511 - (j >> 1) : (j >> 1); p3_attention(C, 16 * set, 16, aa_); asm volatile("s_waitcnt vmcnt(0)" ::: "memory"); __syncthreads(); if (C.tid == 0) (void)xb_add(WSP(unsigned, WS_CTL) + CW_OBRDY + (set >> 3), 1u); }
#if MK_PROBE >= 40 && MK_PROBE < 50
        tacc += ia_;
#endif
#if MK_PROBE >= 100 && MK_PROBE < 110
        tacc += aa_;
#endif
    }
#if MK_PROBE == 83
    TOCK();
#endif
    if (IN(4)) { p3_wuv(C);
        asm volatile("s_waitcnt vmcnt(0)" ::: "memory");
        __syncthreads();
        if (C.tid == 0) { unsigned* rdy = WSP(unsigned, WS_CTL) + CW_ABRDY; for (int u = C.bid; u < 64 * NH; u += C.G) (void)xb_add(&rdy[u >> 4], 1u); }
#if MK_PROBE == 11
        p3_wuv(C);
#endif
    }
    if (IN(5)) {
        { pg8::Gemm g{WSP(bf16_t, WS_MB), WSP(bf16_t, WS_WAT), S, D, 1024}; GateOrder go; go.so.init(S, D, C.G, C.bid); go.ready = WSP(unsigned, WS_CTL) + CW_ABRDY;
          EpiGateFused E{WSP(bf16_t, WS_GATE), WSP(bf16_t, WS_N1)};
          pg8::gemm_phase<EpiGateFused, GateOrder, true, true>(stage, g, go, E); }
#if MK_PROBE == 6
        __syncthreads();
        { pg8::Gemm g{WSP(bf16_t, WS_AB), WSP(bf16_t, WS_WAT), S, D, 1024}; pg8::StaticOrder so; so.init(S, D, C.G, C.bid);
          EpiGateA E{WSP(bf16_t, WS_QABS), WSP(bf16_t, WS_GATE)};
          pg8::gemm_phase<EpiGateA, pg8::StaticOrder, true, true>(stage, g, so, E); }
        __syncthreads();
        { pg8::Gemm g{WSP(bf16_t, WS_MB), WSP(bf16_t, WS_WBT), S, D, 1024}; pg8::StaticOrder so; so.init(S, D, C.G, C.bid);
          EpiGateB E{WSP(bf16_t, WS_QABS), WSP(bf16_t, WS_GATE), WSP(bf16_t, WS_N1)};
          pg8::gemm_phase<EpiGateB, pg8::StaticOrder, true, true>(stage, g, so, E); }
#endif
    }
    SEAM(5);
    if (IN(6))
#if MK_PROBE == 7
    for (int rep = 0; rep < 2; ++rep)
#endif
    {
        pg8::Gemm g{WSP(bf16_t, WS_N1), WSP(bf16_t, WS_WOT), S, D, D}; pg8::StaticOrder so; so.init(S, D, C.G, C.bid);
        EpiRes E{C.in[I_X], C.out};
        pg8::gemm_phase<EpiRes, pg8::StaticOrder, true, true>(stage, g, so, E);
    }
    SEAM(6);
#if MK_PROBE == 21
    TICK();
#endif
    { unsigned long long rt_acc = 0ull; if (IN(7)) p6_router(C, rt_acc);
#if MK_PROBE >= 30
      tacc += rt_acc;
#endif
    }
#if MK_PROBE == 21
    TOCK();
#endif
    SEAM(7);
#if MK_PROBE == 88
    TICK();
#endif
    if (IN(8)) { moe_phase<1>(C);
#if MK_PROBE == 8
        moe_phase<1>(C);
#endif
#if MK_PROBE >= 61 && MK_PROBE <= 63
        moe_phase<1, MK_PROBE - 60>(C);
#endif
    }
#if MK_PROBE == 88
    TOCK();
#endif
    SEAM(8);
#if MK_PROBE == 89
    TICK();
#endif
    if (IN(9)) { moe_phase<2>(C);
#if MK_PROBE == 9
        moe_phase<2>(C);
#endif
#if MK_PROBE >= 71 && MK_PROBE <= 73
        moe_phase<2, MK_PROBE - 70>(C);
#endif
    }
#if MK_PROBE == 89
    TOCK();
#endif
    if (IN(9) && IN(10)) split_arrive(bar, WSP(unsigned, WS_CTL), CW_SRX, CW_SRT, CW_SRF);
#if MK_PROBE == 22
    TICK();
#endif
    if (IN(10)) { p9_final(C, WSP(unsigned, WS_CTL), IN(9) ? CW_SRF : -1);
#if MK_PROBE == 22
    TOCK();
#endif
#if MK_PROBE == 10
        p9_final(C);
#endif
    }
#if MK_PROBE >= 20
    if (C.bid == 0) { const unsigned long long te = __builtin_amdgcn_s_memrealtime(); while (__builtin_amdgcn_s_memrealtime() - te < 4ull * tacc) __builtin_amdgcn_s_sleep(8); }
#endif
#undef IN
#undef SEAM
}

#ifndef MK_SPLIT
#define MK_SPLIT 0
#endif
extern "C" void kernel_launch(void* const* d_in, const int* in_sizes, int n_in, void* d_out, int out_size, void* d_ws, size_t ws_size, hipStream_t stream) {
    using namespace mk;
    static int grid = 0;
    if (grid == 0) {
        int dev = 0, cus = 0, per_cu = 0;
        if (n_in != 22 || ws_size < WS_END) { fprintf(stderr, "kernel_launch: unexpected n_in %d / ws_size %zu (need %zu)\n", n_in, ws_size, (size_t)WS_END); }
        if (hipGetDevice(&dev) != hipSuccess || hipDeviceGetAttribute(&cus, hipDeviceAttributeMultiprocessorCount, dev) != hipSuccess) { fprintf(stderr, "kernel_launch: device query failed\n"); grid = -1; return; }
        if (hipFuncSetAttribute((const void*)mk_fwd, hipFuncAttributeMaxDynamicSharedMemorySize, LDS_BYTES) != hipSuccess) { fprintf(stderr, "kernel_launch: hipFuncSetAttribute failed\n"); grid = -1; return; }
        if (hipOccupancyMaxActiveBlocksPerMultiprocessor(&per_cu, (const void*)mk_fwd, NTHR, LDS_BYTES) != hipSuccess || per_cu < 1) fprintf(stderr, "kernel_launch: occupancy query reports %d\n", per_cu);
        (void)hipGetLastError();
        grid = cus;
    }
    if (grid < 0) return;
    (void)hipMemsetAsync((char*)d_ws + WS_CTL, 0, CTL_BYTES, stream);
    Args a{};
    for (int i = 0; i < 22; ++i) a.in[i] = (const float*)d_in[i];
    a.out = (float*)d_out; a.ws = (unsigned char*)d_ws; a.pad = 0;
#if MK_SPLIT
    for (int p = 0; p < NPHASE; ++p) { a.lo = p; a.hi = p + 1; a.li = 0; hipLaunchKernelGGL(mk_fwd, dim3(grid), dim3(NTHR), LDS_BYTES, stream, a); }
#else
    a.lo = 0; a.hi = NPHASE; a.li = 0;
    hipLaunchKernelGGL(mk_fwd, dim3(grid), dim3(NTHR), LDS_BYTES, stream, a);
#endif
}
```
